# Optimizing an MI355X kernel written in HIP

```python
import jax
import jax.numpy as jnp
from jax import lax
import numpy as np

D_MODEL = 1024
BATCH = 8
SEQ = 8192
DEPTH = 1

ROPE_THETA = 500000.0
NORM_EPS = 1e-6
MLA_HEADS = 8
MLA_NOPE = 64
MLA_ROPE = 32
MLA_V = 64
KV_LORA = 4 * MLA_V
Q_LORA = 3 * KV_LORA
ATTN_Q_BLOCK = 128
MOBA_HEADS = 8
MOBA_HD = 64
MOBA_ROT = MOBA_HD // 4
MOBA_BLOCK = 256
MOBA_TOPK = 3
MOBA_Q_CHUNK = 32
N_GROUPS = 4
EXPERTS_PER_GROUP = 8
N_EXPERTS = N_GROUPS * EXPERTS_PER_GROUP
EXPERT_TOPK = 2
EXPERT_FF = 256
EXPERT_BLOCK = 256
IN_SPLITS = (Q_LORA, KV_LORA, MLA_ROPE,
             MOBA_HEADS * MOBA_HD, MOBA_HEADS * MOBA_HD, MOBA_HEADS * MOBA_HD,
             D_MODEL, D_MODEL)
IN_WIDTH = sum(IN_SPLITS)

kernel_name = 'hybrid_mla_moba_hmoe_block'


def rmsnorm(x, g):
    xf = x.astype(jnp.float32)
    y = xf * lax.rsqrt(jnp.mean(xf * xf, axis=-1, keepdims=True) + NORM_EPS)
    return (y * g.astype(jnp.float32)).astype(x.dtype)


def rope_tables(seq, rot_dim):
    half = rot_dim // 2
    inv_freq = jnp.power(ROPE_THETA, -jnp.arange(half, dtype=jnp.float32) / half)
    ang = jnp.arange(seq, dtype=jnp.float32)[:, None] * inv_freq[None, :]
    return jnp.cos(ang), jnp.sin(ang)


def apply_rope(x, cos, sin):
    half = x.shape[-1] // 2
    xf = x.astype(jnp.float32)
    x1, x2 = xf[..., :half], xf[..., half:]
    c = cos[None, :, None, :]
    s = sin[None, :, None, :]
    return jnp.concatenate([x1 * c - x2 * s, x2 * c + x1 * s], axis=-1).astype(x.dtype)


def causal_dense_attention(q, k, v):
    B, S, H, Dq = q.shape
    Dv = v.shape[-1]
    scale = Dq ** -0.5
    nqb = S // ATTN_Q_BLOCK
    q_blocks = q.reshape(B, nqb, ATTN_Q_BLOCK, H, Dq).transpose(1, 0, 2, 3, 4)
    kpos = jnp.arange(S)

    def block(args):
        qi, i = args
        s = jnp.einsum('bqhd,bkhd->bhqk', qi, k).astype(jnp.float32) * scale
        qpos = i * ATTN_Q_BLOCK + jnp.arange(ATTN_Q_BLOCK)
        s = jnp.where(kpos[None, :] <= qpos[:, None], s, -jnp.inf)
        p = jax.nn.softmax(s, axis=-1).astype(v.dtype)
        return jnp.einsum('bhqk,bkhd->bqhd', p, v)

    o = lax.map(block, (q_blocks, jnp.arange(nqb)))
    return o.transpose(1, 0, 2, 3, 4).reshape(B, S, H * Dv)


def mla_attention(c_q, c_kv, k_r, q_norm, w_uq, kv_norm, w_ukv, cos, sin):
    B, S, _ = c_q.shape
    q = (rmsnorm(c_q, q_norm) @ w_uq).reshape(B, S, MLA_HEADS, MLA_NOPE + MLA_ROPE)
    q = jnp.concatenate([q[..., :MLA_NOPE], apply_rope(q[..., MLA_NOPE:], cos, sin)], axis=-1)
    kv = (rmsnorm(c_kv, kv_norm) @ w_ukv).reshape(B, S, MLA_HEADS, MLA_NOPE + MLA_V)
    k_nope, v = kv[..., :MLA_NOPE], kv[..., MLA_NOPE:]
    k_rope = apply_rope(k_r[:, :, None, :], cos, sin)
    k = jnp.concatenate([k_nope, jnp.broadcast_to(k_rope, (B, S, MLA_HEADS, MLA_ROPE))], axis=-1)
    return causal_dense_attention(q, k, v)


def moba_attention(q, k, v, cos, sin):
    B, S, H, dh = q.shape
    scale = dh ** -0.5
    q = jnp.concatenate([apply_rope(q[..., :MOBA_ROT], cos, sin), q[..., MOBA_ROT:]], axis=-1)
    k = jnp.concatenate([apply_rope(k[..., :MOBA_ROT], cos, sin), k[..., MOBA_ROT:]], axis=-1)
    nb = -(-S // MOBA_BLOCK)
    pad = nb * MOBA_BLOCK - S
    kp = jnp.pad(k, ((0, 0), (0, pad), (0, 0), (0, 0)))
    vp = jnp.pad(v, ((0, 0), (0, pad), (0, 0), (0, 0)))
    k_blocks = kp.reshape(B, nb, MOBA_BLOCK, H, dh).transpose(0, 3, 1, 2, 4)
    v_blocks = vp.reshape(B, nb, MOBA_BLOCK, H, dh).transpose(0, 3, 1, 2, 4)
    k_mean = jnp.mean(k_blocks.astype(jnp.float32), axis=3)
    n_sel = min(MOBA_TOPK, nb)
    gather = jax.vmap(jax.vmap(lambda blocks, idx: blocks[idx]))
    nqc = S // MOBA_Q_CHUNK
    q_chunks = q.reshape(B, nqc, MOBA_Q_CHUNK, H, dh).transpose(1, 0, 3, 2, 4)
    blk_ids = jnp.arange(nb)
    sel_ids = jnp.arange(n_sel)

    def chunk(args):
        qc, c = args
        q0 = c * MOBA_Q_CHUNK
        own = q0 // MOBA_BLOCK
        qpos = q0 + jnp.arange(MOBA_Q_CHUNK)
        gate = jnp.einsum('bhqd,bhnd->bhqn', qc.astype(jnp.float32), k_mean)
        gate = jnp.where(blk_ids < own, gate, -jnp.inf)
        _, idx = lax.top_k(gate, n_sel)
        valid = sel_ids < own
        k_sel = gather(k_blocks, idx)
        v_sel = gather(v_blocks, idx)
        s_sel = jnp.einsum('bhqd,bhqjkd->bhqjk', qc, k_sel).astype(jnp.float32) * scale
        s_sel = jnp.where(valid[:, None], s_sel, -jnp.inf).reshape(B, H, MOBA_Q_CHUNK, n_sel * MOBA_BLOCK)
        k_own = lax.dynamic_index_in_dim(k_blocks, own, axis=2, keepdims=False)
        v_own = lax.dynamic_index_in_dim(v_blocks, own, axis=2, keepdims=False)
        kpos = own * MOBA_BLOCK + jnp.arange(MOBA_BLOCK)
        s_own = jnp.einsum('bhqd,bhkd->bhqk', qc, k_own).astype(jnp.float32) * scale
        s_own = jnp.where(kpos[None, :] <= qpos[:, None], s_own, -jnp.inf)
        p = jax.nn.softmax(jnp.concatenate([s_own, s_sel], axis=-1), axis=-1).astype(v.dtype)
        p_own = p[..., :MOBA_BLOCK]
        p_sel = p[..., MOBA_BLOCK:].reshape(B, H, MOBA_Q_CHUNK, n_sel, MOBA_BLOCK)
        return (jnp.einsum('bhqk,bhkd->bhqd', p_own, v_own)
                + jnp.einsum('bhqjk,bhqjkd->bhqd', p_sel, v_sel))

    o = lax.map(chunk, (q_chunks, jnp.arange(nqc)))
    return o.transpose(1, 0, 3, 2, 4).reshape(B, S, H * dh)


def hierarchical_moe(h, w_rg, b_rg, w_re, b_re, w_g, w_u, w_d):
    B, S, D = h.shape
    T = B * S
    hf = h.reshape(T, D)
    g_logits = (hf @ w_rg + b_rg).astype(jnp.float32)
    g_sel = jnp.argmax(g_logits, axis=-1).astype(jnp.int32)
    p_group = jnp.take_along_axis(jax.nn.softmax(g_logits, axis=-1), g_sel[:, None], axis=1)
    e_logits = (jnp.einsum('td,gde->tge', hf, w_re) + b_re).astype(jnp.float32)
    e_in = jnp.take_along_axis(e_logits, g_sel[:, None, None], axis=1)[:, 0]
    top_vals, top_idx = lax.top_k(e_in, EXPERT_TOPK)
    weight = p_group * jax.nn.softmax(top_vals, axis=-1)
    expert_id = g_sel[:, None] * EXPERTS_PER_GROUP + top_idx.astype(jnp.int32)

    A = T * EXPERT_TOPK
    eid = expert_id.reshape(A)
    w_flat = weight.reshape(A)
    tok = jnp.repeat(jnp.arange(T, dtype=jnp.int32), EXPERT_TOPK)
    order = jnp.argsort(eid, stable=True)
    se = eid[order]
    counts = jnp.bincount(eid, length=N_EXPERTS).astype(jnp.int32)
    padded = (counts + EXPERT_BLOCK - 1) // EXPERT_BLOCK * EXPERT_BLOCK
    start = jnp.cumsum(counts) - counts
    pend = jnp.cumsum(padded)
    pstart = pend - padded
    dest = pstart[se] + jnp.arange(A, dtype=jnp.int32) - start[se]
    n_slots = (-(-A // EXPERT_BLOCK) + N_EXPERTS) * EXPERT_BLOCK
    slot_tok = jnp.zeros((n_slots,), jnp.int32).at[dest].set(tok[order])
    slot_w = jnp.zeros((n_slots,), h.dtype).at[dest].set(w_flat[order].astype(h.dtype))
    n_blocks = n_slots // EXPERT_BLOCK
    blk_e = jnp.minimum(jnp.searchsorted(pend, jnp.arange(n_blocks, dtype=jnp.int32) * EXPERT_BLOCK,
                                         side='right'), N_EXPERTS - 1)
    xs = hf[slot_tok].reshape(n_blocks, EXPERT_BLOCK, D)

    def expert_block(args):
        xb, e = args
        return (jax.nn.silu(xb @ w_g[e]) * (xb @ w_u[e])) @ w_d[e]

    ys = lax.map(expert_block, (xs, blk_e)).reshape(n_slots, D)
    out = jnp.zeros((T, D), h.dtype).at[slot_tok].add(ys * slot_w[:, None])
    return out.reshape(B, S, D)


def setup_inputs(seed: int = 0) -> dict:
    key = jax.random.key(seed)
    ks = jax.random.split(key, 20)
    f32 = jnp.float32
    L = DEPTH

    def dense(k, shape, fan_in):
        return jax.random.normal(k, shape, f32) * fan_in ** -0.5

    def gain(k, shape):
        return 1.0 + 0.02 * jax.random.normal(k, shape, f32)

    return {
        'x': jax.random.normal(ks[0], (BATCH, SEQ, D_MODEL), f32),
        'attn_norm': gain(ks[1], (L, D_MODEL)),
        'w_in': dense(ks[2], (L, D_MODEL, IN_WIDTH), D_MODEL),
        'q_norm': gain(ks[3], (L, Q_LORA)),
        'w_uq': dense(ks[4], (L, Q_LORA, MLA_HEADS * (MLA_NOPE + MLA_ROPE)), Q_LORA),
        'kv_norm': gain(ks[5], (L, KV_LORA)),
        'w_ukv': dense(ks[6], (L, KV_LORA, MLA_HEADS * (MLA_NOPE + MLA_V)), KV_LORA),
        'w_o_mla': dense(ks[7], (L, MLA_HEADS * MLA_V, D_MODEL), MLA_HEADS * MLA_V),
        'w_o_moba': dense(ks[8], (L, MOBA_HEADS * MOBA_HD, D_MODEL), MOBA_HEADS * MOBA_HD),
        'w_out': dense(ks[9], (L, D_MODEL, D_MODEL), D_MODEL),
        'ffn_norm': gain(ks[10], (L, D_MODEL)),
        'w_router_group': dense(ks[11], (L, D_MODEL, N_GROUPS), D_MODEL),
        'b_router_group': 0.01 * jax.random.normal(ks[12], (L, N_GROUPS), f32),
        'w_router_expert': dense(ks[13], (L, N_GROUPS, D_MODEL, EXPERTS_PER_GROUP), D_MODEL),
        'b_router_expert': 0.01 * jax.random.normal(ks[14], (L, N_GROUPS, EXPERTS_PER_GROUP), f32),
        'w_exp_gate': dense(ks[15], (L, N_EXPERTS, D_MODEL, EXPERT_FF), D_MODEL),
        'w_exp_up': dense(ks[16], (L, N_EXPERTS, D_MODEL, EXPERT_FF), D_MODEL),
        'w_exp_down': dense(ks[17], (L, N_EXPERTS, EXPERT_FF, D_MODEL), EXPERT_FF),
        'final_norm': gain(ks[18], (D_MODEL,)),
    }


def reference(x, attn_norm, w_in, q_norm, w_uq, kv_norm, w_ukv, w_o_mla, w_o_moba, w_out,
              ffn_norm, w_router_group, b_router_group, w_router_expert, b_router_expert,
              w_exp_gate, w_exp_up, w_exp_down, final_norm):
    B, S, _ = x.shape
    cos_mla, sin_mla = rope_tables(S, MLA_ROPE)
    cos_moba, sin_moba = rope_tables(S, MOBA_ROT)
    split_at = [int(i) for i in np.cumsum(IN_SPLITS)[:-1]]
    for l in range(DEPTH):
        h = rmsnorm(x, attn_norm[l])
        proj = h @ w_in[l]
        c_q, c_kv, k_r, q_b, k_b, v_b, gate_a, gate_b = jnp.split(proj, split_at, axis=-1)
        o_a = mla_attention(c_q, c_kv, k_r, q_norm[l], w_uq[l], kv_norm[l], w_ukv[l], cos_mla, sin_mla)
        o_b = moba_attention(q_b.reshape(B, S, MOBA_HEADS, MOBA_HD),
                             k_b.reshape(B, S, MOBA_HEADS, MOBA_HD),
                             v_b.reshape(B, S, MOBA_HEADS, MOBA_HD), cos_moba, sin_moba)
        mixed = (jax.nn.sigmoid(gate_a) * (o_a @ w_o_mla[l])
                 + jax.nn.sigmoid(gate_b) * (o_b @ w_o_moba[l]))
        x = x + mixed @ w_out[l]
        x = x + hierarchical_moe(rmsnorm(x, ffn_norm[l]), w_router_group[l], b_router_group[l],
                                 w_router_expert[l], b_router_expert[l],
                                 w_exp_gate[l], w_exp_up[l], w_exp_down[l])
    return rmsnorm(x, final_norm)
```

```cpp
#include <hip/hip_runtime.h>
#include <hip/hip_bf16.h>
#include <cstdio>
#include <cstdint>

#define LAS __attribute__((address_space(3)))
#define GAS __attribute__((address_space(1)))

constexpr int BATCH = 8, SEQ = 8192, DM = 1024, M = BATCH * SEQ;
constexpr int QL = 768, KVL = 256;
constexpr int NPROJ = 4864;
constexpr int NEXP = 32, EFF = 256, LCAP = 131072;
constexpr float EPS = 1e-6f;
constexpr float LOG2E = 1.4426950408889634f;
constexpr float C2A = 0.10206207261596575f * LOG2E;
constexpr float C2B = 0.125f * LOG2E;
constexpr int NWAVES = 8;

constexpr size_t MiB = 1u << 20;
constexpr size_t WS_CTL = 0, CTL_ZERO_BYTES = 1 * MiB;
constexpr size_t WS_COSA = 1 * MiB, WS_SINA = WS_COSA + 512 * 1024, WS_COSB = 2 * MiB, WS_SINB = WS_COSB + 256 * 1024;
constexpr size_t WS_SSQQ = 3 * MiB, WS_SSQKV = 6 * MiB, WS_SSQX = 7 * MiB, WS_KSUM = 11 * MiB, WS_TOKW = 12 * MiB, WS_RS = 13 * MiB;
constexpr size_t WS_WIN = 16 * MiB, WS_WUQ = 26 * MiB, WS_WUKV = 28 * MiB, WS_WO = 29 * MiB, WS_WOUT = 31 * MiB, WS_WGU = 33 * MiB, WS_WD = 65 * MiB;
constexpr size_t WS_R1 = 96 * MiB, WS_R2 = 224 * MiB, WS_R3 = 352 * MiB;
constexpr size_t WS_KR = 480 * MiB, WS_SEL = 484 * MiB, WS_LIST = 486 * MiB, WS_SLOTA = 502 * MiB, WS_SLOTRS = 503 * MiB, WS_SLOTTOK = 504 * MiB;
constexpr size_t WS_R4 = 512 * MiB, WS_LISTQ = 960 * MiB, WS_PML = 976 * MiB, WS_END = 994 * MiB;
constexpr int LQ_PER_BH = 126976;
constexpr size_t WS_XN = WS_R1, WS_QA = WS_R1, WS_MIX = WS_R1, WS_Y = WS_R1;
constexpr size_t WS_CQ = WS_R2, WS_CKV = WS_R2 + 96 * MiB, WS_OAB = WS_R2;
constexpr size_t WS_KV = WS_R3, WS_X2B = WS_R3;
constexpr size_t WS_QB = WS_R4, WS_KB = WS_R4 + 64 * MiB, WS_VB = WS_R4 + 128 * MiB, WS_SA = WS_R4 + 192 * MiB, WS_SB = WS_R4 + 320 * MiB;
constexpr size_t WS_XG = WS_R4, WS_X2L = WS_R4, WS_H = WS_R4 + 272 * MiB;
constexpr int MAXSLOT = 139264;
constexpr int CW_BAR = 4096;
constexpr int CW_CNT = 16384;
constexpr int CW_MCNT = 24576;
constexpr int CW_TICKET = 28672;
#ifndef CHECK
#define CHECK 0
#endif
#ifndef CHK_GAIN
#define CHK_GAIN 4.0f
#endif
#ifndef CHK_GROUPS
#define CHK_GROUPS 0xffff
#endif
constexpr int CW_ERR = 20000;
#ifndef REPMASK
#define REPMASK 0
#endif
#define NREP(k) (1 + ((REPMASK >> (k)) & 1))
#ifndef MLA_TUNED
#define MLA_TUNED 1
#endif
#ifndef REP_MOBA_A
#define REP_MOBA_A 1
#endif
#ifndef REP_MOBA_B
#define REP_MOBA_B 1
#endif
#ifndef WGM_P1
#define WGM_P1 4
#endif
#ifndef WGM_O
#define WGM_O 8
#endif
#ifndef RES_BF16
#define RES_BF16 1
#endif
#ifndef MLA_PRIO
#define MLA_PRIO 1
#endif
#ifndef MOBA_PRIO
#define MOBA_PRIO 3
#endif
#ifndef REP_MLA
#define REP_MLA 1
#endif
#ifndef REP_MOBA
#define REP_MOBA 1
#endif

constexpr int RING_BYTES = 131072;
constexpr int LDSCTL_OFF = RING_BYTES, MISC_OFF = LDSCTL_OFF + 320;
constexpr int LDS_BYTES = 147456;
constexpr int MI_TS = 16, MI_HIST = 64, MI_BASE = 96;

typedef unsigned short bf16;
typedef unsigned v4u __attribute__((ext_vector_type(4)));
typedef float f32x4 __attribute__((ext_vector_type(4)));
typedef float f32x16 __attribute__((ext_vector_type(16)));
typedef short bf16x8 __attribute__((ext_vector_type(8)));
typedef short s16x4 __attribute__((ext_vector_type(4)));
typedef GAS unsigned gu32;
#define RLX_AGENT __ATOMIC_RELAXED, __HIP_MEMORY_SCOPE_AGENT
#define LDS_WAIT() asm volatile("s_waitcnt lgkmcnt(0)" ::: "memory")
#define VM_WAIT() asm volatile("s_waitcnt vmcnt(0)" ::: "memory")

__device__ __forceinline__ int lane_id() { int l; asm volatile("v_mbcnt_lo_u32_b32 %0, -1, 0\n\tv_mbcnt_hi_u32_b32 %0, -1, %0" : "=v"(l)); return l; }
__device__ __forceinline__ unsigned f2bf(float f) { unsigned u = __builtin_bit_cast(unsigned, f); return (u + 0x7fffu + ((u >> 16) & 1u)) >> 16; }
__device__ __forceinline__ unsigned pk2(float lo, float hi) { return f2bf(lo) | (f2bf(hi) << 16); }
__device__ __forceinline__ unsigned cvt_pk_bf16(float lo, float hi) { unsigned r; asm volatile("v_cvt_pk_bf16_f32 %0, %1, %2" : "=v"(r) : "v"(lo), "v"(hi)); return r; }
__device__ __forceinline__ float bflo(unsigned w) { return __builtin_bit_cast(float, w << 16); }
__device__ __forceinline__ float bfhi(unsigned w) { return __builtin_bit_cast(float, w & 0xffff0000u); }
__device__ __forceinline__ float fsigmoid(float v) { return __builtin_amdgcn_rcpf(1.f + __builtin_amdgcn_exp2f(-v * LOG2E)); }
__device__ __forceinline__ float dot4(const f32x4 v) { return (v[0] * v[0] + v[1] * v[1]) + (v[2] * v[2] + v[3] * v[3]); }

namespace pg8 {
typedef unsigned short bf16_t;
constexpr int BM = 256, BK = 64, HALF = 128, HTB = HALF * BK * 2, STAGE_BYTES = 8 * HTB, NXCD = 8;
__host__ __device__ __forceinline__ int lds_byte(int r, int c) { const int st = (r >> 4) * 2 + (c >> 5), rr = r & 15, cc = c & 31, ob = rr * 64 + cc * 2; return st * 1024 + (ob ^ (((ob >> 9) & 1) << 5)); }
__host__ __device__ __forceinline__ void stage_rc(int b, int& R, int& C) { const int st = b / 1024, sb = b % 1024, swz = sb ^ (((sb >> 9) & 1) << 5); R = (st >> 1) * 16 + swz / 64; C = (st & 1) * 32 + (swz % 64) / 2; }
__host__ __device__ __forceinline__ int perm32(int rho) { const int n = rho >> 4, i = rho & 15; return 8 * (i >> 2) + 4 * n + (i & 3); }

struct Unit { int pm, pn, aux, pad; long aoff, boff; };
struct Gemm { const bf16_t* A; const bf16_t* Bt; int K, lda, ldb, pad; };

struct SchedGrid {
    int nM, nN, nwg, G, c, rep, WGM; long ta, tb;
    __device__ void init(int nM_, int nN_, int G_, int c_, int lda, int ldb, int rep_ = 1, int wgm_ = 8) { nM = nM_; nN = nN_; nwg = nM * nN; G = G_; c = c_; rep = rep_; WGM = wgm_; ta = 256L * lda * 2; tb = 256L * ldb * 2; }
    __device__ __forceinline__ bool tile(long L, Unit& u) const {
        if (L >= (long)nwg * rep) return false;
        if (L >= nwg) L -= nwg;
        int wgid = (int)L; { const int q = nwg / NXCD, r = nwg % NXCD, xcd = wgid % NXCD, off = wgid / NXCD; wgid = (xcd < r ? xcd * (q + 1) : r * (q + 1) + (xcd - r) * q) + off; }
        const int nig = WGM * nN, gid = wgid / nig, fm = gid * WGM, gsz = (nM - fm) < WGM ? (nM - fm) : WGM;
        u.pm = fm + ((wgid % nig) % gsz); u.pn = (wgid % nig) / gsz; u.aux = 0; u.pad = 0; u.aoff = u.pm * ta; u.boff = u.pn * tb; return true;
    }
    __device__ __forceinline__ bool next(int i, Unit& u) const { return tile((long)i * G + c, u); }
};
struct SchedMix {
    SchedGrid g;
    __device__ __forceinline__ bool next(int i, Unit& u) const { if (!g.tile((long)(i >> 1) * g.G + g.c, u)) return false; u.aux = i & 1; u.aoff += (i & 1) * 1024; u.boff += (i & 1) * 1024; return true; }
};
struct SchedMoE {
    const volatile LAS int* TS; int npn, G, c; long ta, tbe, tbn; int rep;
    __device__ __forceinline__ bool next(int i, Unit& u) const {
        long L = (long)i * G + c; const int ntile = TS[32]; if (L >= (long)ntile * npn * rep) return false; if (L >= (long)ntile * npn) L -= (long)ntile * npn;
        const int st = (int)(L / npn), pn = (int)(L % npn); int e = 0;
        for (int k = 1; k < 32; ++k) e += (st >= TS[k]) ? 1 : 0;
        u.pm = st; u.pn = pn; u.aux = e; u.pad = 0; u.aoff = st * ta; u.boff = e * tbe + pn * tbn; return true;
    }
};

template <class Epi, class Sched>
__device__ __forceinline__ void gemm_phase(LAS unsigned char* lds, const Gemm g, const Sched& S, const Epi& E, const int wave) {
    const int wid = wave, lane = lane_id(), tid = wid * 64 + lane, wr = wid >> 2, wc = wid & 3, fr = lane & 15, fq = lane >> 4;
    const int K = g.K, nt = K / BK;
    unsigned voffA[2], voffB[2];
#pragma unroll
    for (int i = 0; i < 2; ++i) { int R, C; stage_rc(tid * 16 + i * 8192, R, C); const int Rb = (R & ~31) + perm32(R & 31);
        voffA[i] = (unsigned)(R * g.lda + C) * 2u; voffB[i] = (unsigned)(Rb * g.ldb + C) * 2u; }
    const size_t kstep = (size_t)(BK * 2);
    const size_t hsA = (size_t)HALF * g.lda * 2, hsB = (size_t)HALF * g.ldb * 2;
    const unsigned ldsw = (unsigned)wid * 1024u;
    const int aoff = lds_byte(wr * 64 + fr, fq * 8), boff = lds_byte(wc * 32 + fr, fq * 8);
#define PG8_SA(b, h) (((b) * 2 + (h)) * HTB)
#define PG8_SB(b, h) ((4 + (b) * 2 + (h)) * HTB)
#define PG8_STAGE(bufoff, gbase, voff) do { _Pragma("unroll") for (int _i = 0; _i < 2; ++_i) \
        __builtin_amdgcn_global_load_lds((const unsigned*)((const char*)(gbase) + (voff)[_i]), (LAS unsigned*)(lds + (bufoff) + ldsw + _i * 8192), 16, 0, 0); } while (0)
#define PG8_LDA(dst, b, h) do { _Pragma("unroll") for (int m = 0; m < 4; ++m) _Pragma("unroll") for (int k = 0; k < 2; ++k) dst[m][k] = *(const LAS bf16x8*)(lds + PG8_SA(b, h) + aoff + m * 2048 + k * 1024); } while (0)
#define PG8_LDB(dst, b, h) do { _Pragma("unroll") for (int n = 0; n < 2; ++n) _Pragma("unroll") for (int k = 0; k < 2; ++k) dst[n][k] = *(const LAS bf16x8*)(lds + PG8_SB(b, h) + boff + n * 2048 + k * 1024); } while (0)
#define PG8_MMA(ai, bj, At, Bt) do { __builtin_amdgcn_s_setprio(1); _Pragma("unroll") for (int m = 0; m < 4; ++m) _Pragma("unroll") for (int n = 0; n < 2; ++n) _Pragma("unroll") for (int k = 0; k < 2; ++k) \
        acc[ai][bj][m][n] = __builtin_amdgcn_mfma_f32_16x16x32_bf16(Bt[n][k], At[m][k], acc[ai][bj][m][n], 0, 0, 0); __builtin_amdgcn_s_setprio(0); } while (0)
#define PG8_WAIT_V(n) asm volatile("s_waitcnt vmcnt(" #n ")" ::: "memory")
#define PG8_WAIT_L(n) asm volatile("s_waitcnt lgkmcnt(" #n ")" ::: "memory")
#define PG8_BAR __builtin_amdgcn_s_barrier()
#define PG8_SCHED __builtin_amdgcn_sched_barrier(0)
    Unit cur, nxt; int ui = 0;
    if (!S.next(0, cur)) return;
    f32x4 acc[2][2][4][2];
#pragma unroll
    for (int a = 0; a < 2; ++a)
#pragma unroll
        for (int b = 0; b < 2; ++b)
#pragma unroll
            for (int m = 0; m < 4; ++m)
#pragma unroll
                for (int n = 0; n < 2; ++n) acc[a][b][m][n] = (f32x4){0.f, 0.f, 0.f, 0.f};
    bf16x8 At[4][2], B0[2][2], B1[2][2];
    const char* cA = (const char*)g.A + cur.aoff; const char* cB = (const char*)g.Bt + cur.boff;
    PG8_STAGE(PG8_SB(0, 0), cB, voffB); PG8_STAGE(PG8_SB(0, 1), cB + hsB, voffB); PG8_STAGE(PG8_SA(0, 0), cA, voffA); PG8_STAGE(PG8_SA(0, 1), cA + hsA, voffA);
    if (wr == 1) PG8_BAR;
    PG8_WAIT_V(2); PG8_BAR;
    PG8_STAGE(PG8_SB(1, 0), cB + kstep, voffB); PG8_STAGE(PG8_SA(1, 0), cA + kstep, voffA); PG8_STAGE(PG8_SB(1, 1), cB + hsB + kstep, voffB);
    PG8_WAIT_V(6); PG8_BAR;
    for (;;) {
        const bool has_next = S.next(ui + 1, nxt);
        const char* nA = has_next ? (const char*)g.A + nxt.aoff : cA; const char* nB = has_next ? (const char*)g.Bt + nxt.boff : cB;
        for (int t = 0; t < nt; t += 2) {
            const bool last = (t == nt - 2);
            const char* a1 = cA + (size_t)(t + 1) * kstep;
            const char* a2 = last ? nA : cA + (size_t)(t + 2) * kstep; const char* b2 = last ? nB : cB + (size_t)(t + 2) * kstep;
            const char* a3 = a2 + kstep; const char* b3 = b2 + kstep;
            PG8_LDB(B0, 0, 0); PG8_LDB(B1, 0, 1); PG8_SCHED; PG8_LDA(At, 0, 0); PG8_STAGE(PG8_SA(1, 1), a1 + hsA, voffA);
            PG8_WAIT_V(8); PG8_WAIT_L(0); PG8_BAR; PG8_MMA(0, 0, At, B0); PG8_MMA(0, 1, At, B1); PG8_BAR; PG8_SCHED;
            PG8_LDA(At, 0, 1); PG8_STAGE(PG8_SB(0, 0), b2, voffB); PG8_STAGE(PG8_SB(0, 1), b2 + hsB, voffB); PG8_STAGE(PG8_SA(0, 0), a2, voffA);
            PG8_WAIT_V(8); PG8_WAIT_L(0); PG8_BAR; PG8_MMA(1, 0, At, B0); PG8_MMA(1, 1, At, B1); PG8_BAR; PG8_SCHED;
            PG8_LDB(B0, 1, 0); PG8_LDB(B1, 1, 1); PG8_SCHED; PG8_LDA(At, 1, 0); PG8_STAGE(PG8_SA(0, 1), a2 + hsA, voffA);
            PG8_WAIT_V(8); PG8_WAIT_L(0); PG8_BAR; PG8_MMA(0, 0, At, B0); PG8_MMA(0, 1, At, B1); PG8_BAR; PG8_SCHED;
            PG8_LDA(At, 1, 1); PG8_STAGE(PG8_SB(1, 0), b3, voffB); PG8_STAGE(PG8_SB(1, 1), b3 + hsB, voffB); PG8_STAGE(PG8_SA(1, 0), a3, voffA);
            PG8_WAIT_V(8); PG8_WAIT_L(0); PG8_BAR; PG8_MMA(1, 0, At, B0); PG8_MMA(1, 1, At, B1); PG8_BAR; PG8_SCHED;
        }
        if (wr == 0) PG8_BAR;
        const bool keep = E(acc, cur, wr, wc, fr, fq);
        if (!has_next) break;
        if (!keep) {
#pragma unroll
            for (int a = 0; a < 2; ++a)
#pragma unroll
                for (int b = 0; b < 2; ++b)
#pragma unroll
                    for (int m = 0; m < 4; ++m)
#pragma unroll
                        for (int n = 0; n < 2; ++n) acc[a][b][m][n] = (f32x4){0.f, 0.f, 0.f, 0.f};
        }
        cur = nxt; cA = nA; cB = nB; ++ui;
        if (wr == 1) PG8_BAR;
    }
    PG8_WAIT_V(0);
    PG8_BAR;
#undef PG8_SA
#undef PG8_SB
#undef PG8_STAGE
#undef PG8_LDA
#undef PG8_LDB
#undef PG8_MMA
#undef PG8_WAIT_V
#undef PG8_WAIT_L
#undef PG8_BAR
#undef PG8_SCHED
}

template <class Epi, class Sched>
__device__ __forceinline__ void gemm_phase_g(LAS unsigned char* lds, const Gemm g, const Sched& S, const Epi& E, const int wave, const int* ROWS) {
    const int wid = wave, lane = lane_id(), tid = wid * 64 + lane, wr = wid >> 2, wc = wid & 3, fr = lane & 15, fq = lane >> 4;
    const int K = g.K, nt = K / BK;
    unsigned voffB[2]; int RA[2]; unsigned CA2[2];
#pragma unroll
    for (int i = 0; i < 2; ++i) { int R, C; stage_rc(tid * 16 + i * 8192, R, C); const int Rb = (R & ~31) + perm32(R & 31);
        RA[i] = R; CA2[i] = (unsigned)C * 2u; voffB[i] = (unsigned)(Rb * g.ldb + C) * 2u; }
    const unsigned rowb = (unsigned)g.lda * 2u;
    unsigned vcur[2][2], vnxt[2][2];
#define PG8_ROWS(dst, u) do { _Pragma("unroll") for (int h_ = 0; h_ < 2; ++h_) _Pragma("unroll") for (int i_ = 0; i_ < 2; ++i_) { const int t_ = ROWS[(u).pm * 256 + h_ * 128 + RA[i_]]; dst[h_][i_] = (unsigned)(t_ < 0 ? 0 : t_) * rowb + CA2[i_]; } } while (0)
    const size_t kstep = (size_t)(BK * 2);
    const size_t hsA = (size_t)HALF * g.lda * 2, hsB = (size_t)HALF * g.ldb * 2;
    const unsigned ldsw = (unsigned)wid * 1024u;
    const int aoff = lds_byte(wr * 64 + fr, fq * 8), boff = lds_byte(wc * 32 + fr, fq * 8);
#define PG8_SA(b, h) (((b) * 2 + (h)) * HTB)
#define PG8_SB(b, h) ((4 + (b) * 2 + (h)) * HTB)
#define PG8_STAGE(bufoff, gbase, voff) do { _Pragma("unroll") for (int _i = 0; _i < 2; ++_i) \
        __builtin_amdgcn_global_load_lds((const unsigned*)((const char*)(gbase) + (voff)[_i]), (LAS unsigned*)(lds + (bufoff) + ldsw + _i * 8192), 16, 0, 0); } while (0)
#define PG8_LDA(dst, b, h) do { _Pragma("unroll") for (int m = 0; m < 4; ++m) _Pragma("unroll") for (int k = 0; k < 2; ++k) dst[m][k] = *(const LAS bf16x8*)(lds + PG8_SA(b, h) + aoff + m * 2048 + k * 1024); } while (0)
#define PG8_LDB(dst, b, h) do { _Pragma("unroll") for (int n = 0; n < 2; ++n) _Pragma("unroll") for (int k = 0; k < 2; ++k) dst[n][k] = *(const LAS bf16x8*)(lds + PG8_SB(b, h) + boff + n * 2048 + k * 1024); } while (0)
#define PG8_MMA(ai, bj, At, Bt) do { __builtin_amdgcn_s_setprio(1); _Pragma("unroll") for (int m = 0; m < 4; ++m) _Pragma("unroll") for (int n = 0; n < 2; ++n) _Pragma("unroll") for (int k = 0; k < 2; ++k) \
        acc[ai][bj][m][n] = __builtin_amdgcn_mfma_f32_16x16x32_bf16(Bt[n][k], At[m][k], acc[ai][bj][m][n], 0, 0, 0); __builtin_amdgcn_s_setprio(0); } while (0)
#define PG8_WAIT_V(n) asm volatile("s_waitcnt vmcnt(" #n ")" ::: "memory")
#define PG8_WAIT_L(n) asm volatile("s_waitcnt lgkmcnt(" #n ")" ::: "memory")
#define PG8_BAR __builtin_amdgcn_s_barrier()
#define PG8_SCHED __builtin_amdgcn_sched_barrier(0)
    Unit cur, nxt, nn; int ui = 0;
    if (!S.next(0, cur)) return;
    bool has_next = S.next(1, nxt);
    PG8_ROWS(vcur, cur); if (has_next) { PG8_ROWS(vnxt, nxt); } else { _Pragma("unroll") for (int h_ = 0; h_ < 2; ++h_) _Pragma("unroll") for (int i_ = 0; i_ < 2; ++i_) vnxt[h_][i_] = vcur[h_][i_]; }
    f32x4 acc[2][2][4][2];
#pragma unroll
    for (int a = 0; a < 2; ++a)
#pragma unroll
        for (int b = 0; b < 2; ++b)
#pragma unroll
            for (int m = 0; m < 4; ++m)
#pragma unroll
                for (int n = 0; n < 2; ++n) acc[a][b][m][n] = (f32x4){0.f, 0.f, 0.f, 0.f};
    bf16x8 At[4][2], B0[2][2], B1[2][2];
    const char* cA = (const char*)g.A; const char* cB = (const char*)g.Bt + cur.boff;
    PG8_STAGE(PG8_SB(0, 0), cB, voffB); PG8_STAGE(PG8_SB(0, 1), cB + hsB, voffB); PG8_STAGE(PG8_SA(0, 0), cA, vcur[0]); PG8_STAGE(PG8_SA(0, 1), cA, vcur[1]);
    if (wr == 1) PG8_BAR;
    PG8_WAIT_V(2); PG8_BAR;
    PG8_STAGE(PG8_SB(1, 0), cB + kstep, voffB); PG8_STAGE(PG8_SA(1, 0), cA + kstep, vcur[0]); PG8_STAGE(PG8_SB(1, 1), cB + hsB + kstep, voffB);
    PG8_WAIT_V(6); PG8_BAR;
    for (;;) {
        const bool has_nn = has_next && S.next(ui + 2, nn);
        const char* nB = has_next ? (const char*)g.Bt + nxt.boff : cB;
        for (int t = 0; t < nt; t += 2) {
            const bool last = (t == nt - 2);
            const char* a1 = cA + (size_t)(t + 1) * kstep;
            const char* a2 = last ? cA : cA + (size_t)(t + 2) * kstep; const char* b2 = last ? nB : cB + (size_t)(t + 2) * kstep;
            unsigned v2[2][2];
#pragma unroll
            for (int h_ = 0; h_ < 2; ++h_)
#pragma unroll
                for (int i_ = 0; i_ < 2; ++i_) v2[h_][i_] = last ? vnxt[h_][i_] : vcur[h_][i_];
            const char* a3 = a2 + kstep; const char* b3 = b2 + kstep;
            PG8_LDB(B0, 0, 0); PG8_LDB(B1, 0, 1); PG8_SCHED; PG8_LDA(At, 0, 0); PG8_STAGE(PG8_SA(1, 1), a1, vcur[1]);
            PG8_WAIT_V(8); PG8_WAIT_L(0); PG8_BAR; PG8_MMA(0, 0, At, B0); PG8_MMA(0, 1, At, B1); PG8_BAR; PG8_SCHED;
            PG8_LDA(At, 0, 1); PG8_STAGE(PG8_SB(0, 0), b2, voffB); PG8_STAGE(PG8_SB(0, 1), b2 + hsB, voffB); PG8_STAGE(PG8_SA(0, 0), a2, v2[0]);
            PG8_WAIT_V(8); PG8_WAIT_L(0); PG8_BAR; PG8_MMA(1, 0, At, B0); PG8_MMA(1, 1, At, B1); PG8_BAR; PG8_SCHED;
            PG8_LDB(B0, 1, 0); PG8_LDB(B1, 1, 1); PG8_SCHED; PG8_LDA(At, 1, 0); PG8_STAGE(PG8_SA(0, 1), a2, v2[1]);
            PG8_WAIT_V(8); PG8_WAIT_L(0); PG8_BAR; PG8_MMA(0, 0, At, B0); PG8_MMA(0, 1, At, B1); PG8_BAR; PG8_SCHED;
            PG8_LDA(At, 1, 1); PG8_STAGE(PG8_SB(1, 0), b3, voffB); PG8_STAGE(PG8_SB(1, 1), b3 + hsB, voffB); PG8_STAGE(PG8_SA(1, 0), a3, v2[0]);
            PG8_WAIT_V(8); PG8_WAIT_L(0); PG8_BAR; PG8_MMA(1, 0, At, B0); PG8_MMA(1, 1, At, B1); PG8_BAR; PG8_SCHED;
        }
        if (wr == 0) PG8_BAR;
        unsigned vnn[2][2];
        if (has_nn) { PG8_ROWS(vnn, nn); } else { _Pragma("unroll") for (int h_ = 0; h_ < 2; ++h_) _Pragma("unroll") for (int i_ = 0; i_ < 2; ++i_) vnn[h_][i_] = vnxt[h_][i_]; }
        const bool keep = E(acc, cur, wr, wc, fr, fq);
        if (!has_next) break;
        if (!keep) {
#pragma unroll
            for (int a = 0; a < 2; ++a)
#pragma unroll
                for (int b = 0; b < 2; ++b)
#pragma unroll
                    for (int m = 0; m < 4; ++m)
#pragma unroll
                        for (int n = 0; n < 2; ++n) acc[a][b][m][n] = (f32x4){0.f, 0.f, 0.f, 0.f};
        }
        cur = nxt; nxt = nn; cB = nB; ++ui; has_next = has_nn;
#pragma unroll
        for (int h_ = 0; h_ < 2; ++h_)
#pragma unroll
            for (int i_ = 0; i_ < 2; ++i_) { vcur[h_][i_] = vnxt[h_][i_]; vnxt[h_][i_] = vnn[h_][i_]; }
        if (wr == 1) PG8_BAR;
    }
    PG8_WAIT_V(0);
    PG8_BAR;
#undef PG8_SA
#undef PG8_SB
#undef PG8_STAGE
#undef PG8_ROWS
#undef PG8_LDA
#undef PG8_LDB
#undef PG8_MMA
#undef PG8_WAIT_V
#undef PG8_WAIT_L
#undef PG8_BAR
#undef PG8_SCHED
}

__device__ __forceinline__ v4u pack8(const f32x4 v0, const f32x4 v1) { v4u w; w.x = cvt_pk_bf16(v0[0], v0[1]); w.y = cvt_pk_bf16(v0[2], v0[3]); w.z = cvt_pk_bf16(v1[0], v1[1]); w.w = cvt_pk_bf16(v1[2], v1[3]); return w; }
__device__ __forceinline__ void rot2(float& a, float& b, float c, float s) { const float x = a * c - b * s, y = b * c + a * s; a = x; b = y; }
__device__ __forceinline__ void rope8(f32x4& v0, f32x4& v1, const f32x4 c4, const f32x4 s4) {
    float a0 = v0[0], b0 = v0[1], a1 = v0[2], b1 = v0[3], a2 = v1[0], b2 = v1[1], a3 = v1[2], b3 = v1[3];
    rot2(a0, b0, c4[0], s4[0]); rot2(a1, b1, c4[1], s4[1]); rot2(a2, b2, c4[2], s4[2]); rot2(a3, b3, c4[3], s4[3]);
    v0 = (f32x4){a0, b0, a1, b1}; v1 = (f32x4){a2, b2, a3, b3};
}

struct EpiProj {
    bf16_t *CQ, *CKV, *KR, *QB, *KB, *VB, *SA, *SB; float *SSQ_Q, *SSQ_KV, *KSUM; const float *COSA, *SINA, *COSB, *SINB;
    __device__ __forceinline__ bool operator()(f32x4 (&acc)[2][2][4][2], const Unit& u, int wr, int wc, int fr, int fq) const {
        const int pn = u.pn, row0 = u.pm * BM + wr * 64 + fr, ct = wc * 32 + 8 * fq;
        if (pn < 4) {
            bf16_t* O; int ldc, cb, nss, sidx; float* SS;
            if (pn < 3) { O = CQ; ldc = QL; cb = pn * 256; SS = SSQ_Q; nss = 12; sidx = pn * 4 + wc; } else { O = CKV; ldc = KVL; cb = 0; SS = SSQ_KV; nss = 4; sidx = wc; }
#pragma unroll
            for (int ai = 0; ai < 2; ++ai)
#pragma unroll
                for (int m = 0; m < 4; ++m) { const int row = row0 + ai * HALF + m * 16; float s = 0.f;
#pragma unroll
                    for (int bj = 0; bj < 2; ++bj) { const f32x4 v0 = acc[ai][bj][m][0], v1 = acc[ai][bj][m][1]; s += dot4(v0) + dot4(v1);
                        *(v4u*)(O + (size_t)row * ldc + cb + bj * HALF + ct) = pack8(v0, v1); }
                    s += __shfl_xor(s, 16); s += __shfl_xor(s, 32);
                    if (fq == 0) SS[(size_t)row * nss + sidx] = s; }
        } else if (pn < 8) {
            const bool isq = pn < 6; bf16_t* O = isq ? QB : KB; const int cb = (pn - (isq ? 4 : 6)) * 256;
            const bool rope = ((wc & 1) == 0) && (fq < 2); const float sc = isq ? C2B : 1.f;
#pragma unroll
            for (int ai = 0; ai < 2; ++ai)
#pragma unroll
                for (int m = 0; m < 4; ++m) { const int row = row0 + ai * HALF + m * 16, pos = row & (SEQ - 1);
                    f32x4 c4 = (f32x4){1.f, 1.f, 1.f, 1.f}, s4 = (f32x4){0.f, 0.f, 0.f, 0.f};
                    if (rope) { c4 = *(const f32x4*)(COSB + pos * 8 + 4 * fq); s4 = *(const f32x4*)(SINB + pos * 8 + 4 * fq); }
#pragma unroll
                    for (int bj = 0; bj < 2; ++bj) { f32x4 v0 = acc[ai][bj][m][0], v1 = acc[ai][bj][m][1];
                        rope8(v0, v1, c4, s4); v0 = v0 * sc; v1 = v1 * sc;
                        *(v4u*)(O + (size_t)row * 512 + cb + bj * HALF + ct) = pack8(v0, v1); } }
            if (!isq) {
#pragma unroll
                for (int bj = 0; bj < 2; ++bj)
#pragma unroll
                    for (int n = 0; n < 2; ++n) { f32x4 v = (f32x4){0.f, 0.f, 0.f, 0.f};
#pragma unroll
                        for (int ai = 0; ai < 2; ++ai)
#pragma unroll
                            for (int m = 0; m < 4; ++m) { const int pos = (row0 + ai * HALF + m * 16) & (SEQ - 1);
                                float a0 = acc[ai][bj][m][n][0], b0 = acc[ai][bj][m][n][1], a1 = acc[ai][bj][m][n][2], b1 = acc[ai][bj][m][n][3];
                                if (rope) { const float* cp = COSB + pos * 8 + 4 * fq + 2 * n; const float* sp = SINB + pos * 8 + 4 * fq + 2 * n;
                                    rot2(a0, b0, cp[0], sp[0]); rot2(a1, b1, cp[1], sp[1]); }
                                v[0] += a0; v[1] += b0; v[2] += a1; v[3] += b1; }
#pragma unroll
                        for (int o = 1; o < 16; o <<= 1) { v[0] += __shfl_xor(v[0], o); v[1] += __shfl_xor(v[1], o); v[2] += __shfl_xor(v[2], o); v[3] += __shfl_xor(v[3], o); }
                        if (fr == 0) *(f32x4*)(KSUM + ((size_t)(wr * 256 + u.pm)) * 512 + cb + bj * HALF + ct + 4 * n) = v;
                        asm volatile("" ::: "memory"); }
            }
        } else if (pn < 10) {
            const int cb = (pn - 8) * 256;
#pragma unroll
            for (int ai = 0; ai < 2; ++ai)
#pragma unroll
                for (int m = 0; m < 4; ++m) { const int row = row0 + ai * HALF + m * 16;
#pragma unroll
                    for (int bj = 0; bj < 2; ++bj) *(v4u*)(VB + (size_t)row * 512 + cb + bj * HALF + ct) = pack8(acc[ai][bj][m][0], acc[ai][bj][m][1]); }
        } else if (pn < 18) {
            const int cb = (pn - 10) * 128;
#pragma unroll
            for (int ai = 0; ai < 2; ++ai)
#pragma unroll
                for (int m = 0; m < 4; ++m) { const int row = row0 + ai * HALF + m * 16;
                    f32x4 r0, r1, b0, b1;
#pragma unroll
                    for (int j = 0; j < 4; ++j) { const float sa0 = fsigmoid(acc[ai][0][m][0][j]), sa1 = fsigmoid(acc[ai][0][m][1][j]);
                        b0[j] = fmaxf(fsigmoid(acc[ai][1][m][0][j]), 1e-30f); b1[j] = fmaxf(fsigmoid(acc[ai][1][m][1][j]), 1e-30f);
                        r0[j] = sa0 * __builtin_amdgcn_rcpf(b0[j]); r1[j] = sa1 * __builtin_amdgcn_rcpf(b1[j]); }
                    *(v4u*)(SA + (size_t)row * DM + cb + ct) = pack8(r0, r1); *(v4u*)(SB + (size_t)row * DM + cb + ct) = pack8(b0, b1); }
        } else {
            if (wc == 0) {
#pragma unroll
                for (int ai = 0; ai < 2; ++ai)
#pragma unroll
                    for (int m = 0; m < 4; ++m) { const int row = row0 + ai * HALF + m * 16, pos = row & (SEQ - 1);
                        const f32x4 c4 = *(const f32x4*)(COSA + pos * 16 + 4 * fq), s4 = *(const f32x4*)(SINA + pos * 16 + 4 * fq);
                        f32x4 v0 = acc[ai][0][m][0], v1 = acc[ai][0][m][1]; rope8(v0, v1, c4, s4);
                        *(v4u*)(KR + (size_t)row * 32 + 8 * fq) = pack8(v0, v1); }
            }
        }
        return false;
    }
};
struct EpiPlain {
    bf16_t* O;
    __device__ __forceinline__ bool operator()(f32x4 (&acc)[2][2][4][2], const Unit& u, int wr, int wc, int fr, int fq) const {
        const int row0 = (u.pm & 15) * BM + wr * 64 + fr, ct = wc * 32 + 8 * fq;
#pragma unroll
        for (int ai = 0; ai < 2; ++ai)
#pragma unroll
            for (int m = 0; m < 4; ++m) { const int row = row0 + ai * HALF + m * 16;
#pragma unroll
                for (int bj = 0; bj < 2; ++bj) *(v4u*)(O + (size_t)row * NPROJ + u.pn * 256 + bj * HALF + ct) = pack8(acc[ai][bj][m][0], acc[ai][bj][m][1]); }
        return false;
    }
};
struct EpiQ {
    bf16_t* QA; const float *SSQ_Q, *COSA, *SINA;
    __device__ __forceinline__ bool operator()(f32x4 (&acc)[2][2][4][2], const Unit& u, int wr, int wc, int fr, int fq) const {
        const int row0 = u.pm * BM + wr * 64 + fr;
        bool isrope[2];
#pragma unroll
        for (int bj = 0; bj < 2; ++bj) isrope[bj] = (((u.pn * 256 + bj * HALF + wc * 32) >> 5) % 3) == 2;
        const bool anyrope = isrope[0] || isrope[1];
#pragma unroll
        for (int ai = 0; ai < 2; ++ai) { float rs[4]; f32x4 c4[4], s4[4];
            { f32x4 p[4][3];
#pragma unroll
              for (int m = 0; m < 4; ++m) { const size_t row = (size_t)(row0 + ai * HALF + m * 16);
#pragma unroll
                  for (int k = 0; k < 3; ++k) p[m][k] = *(const f32x4*)(SSQ_Q + row * 12 + 4 * k); }
              if (anyrope) {
#pragma unroll
                  for (int m = 0; m < 4; ++m) { const int pos = (row0 + ai * HALF + m * 16) & (SEQ - 1); c4[m] = *(const f32x4*)(COSA + pos * 16 + 4 * fq); s4[m] = *(const f32x4*)(SINA + pos * 16 + 4 * fq); } }
#pragma unroll
              for (int m = 0; m < 4; ++m) { float ss = 0.f;
#pragma unroll
                  for (int k = 0; k < 3; ++k)
#pragma unroll
                      for (int j = 0; j < 4; ++j) ss += p[m][k][j];
                  rs[m] = C2A / sqrtf(ss * (1.f / QL) + EPS); } }
#pragma unroll
            for (int m = 0; m < 4; ++m) { const int row = row0 + ai * HALF + m * 16;
#pragma unroll
                for (int bj = 0; bj < 2; ++bj) { const int cg = u.pn * 256 + bj * HALF + wc * 32;
                    f32x4 v0 = acc[ai][bj][m][0] * rs[m], v1 = acc[ai][bj][m][1] * rs[m];
                    if (isrope[bj]) rope8(v0, v1, c4[m], s4[m]);
                    *(v4u*)(QA + (size_t)row * QL + cg + 8 * fq) = pack8(v0, v1); } }
            asm volatile("" ::: "memory"); }
        return false;
    }
};
struct EpiKV {
    bf16_t* KV; const float* SSQ_KV;
    __device__ __forceinline__ bool operator()(f32x4 (&acc)[2][2][4][2], const Unit& u, int wr, int wc, int fr, int fq) const {
        const int row0 = u.pm * BM + wr * 64 + fr, ct = wc * 32 + 8 * fq;
        f32x4 p[2][4];
#pragma unroll
        for (int ai = 0; ai < 2; ++ai)
#pragma unroll
            for (int m = 0; m < 4; ++m) p[ai][m] = *(const f32x4*)(SSQ_KV + (size_t)(row0 + ai * HALF + m * 16) * 4);
#pragma unroll
        for (int ai = 0; ai < 2; ++ai)
#pragma unroll
            for (int m = 0; m < 4; ++m) { const int row = row0 + ai * HALF + m * 16;
                const float ss = ((p[ai][m][0] + p[ai][m][1]) + p[ai][m][2]) + p[ai][m][3];
                const float rs = 1.f / sqrtf(ss * (1.f / KVL) + EPS);
#pragma unroll
                for (int bj = 0; bj < 2; ++bj) *(v4u*)(KV + (size_t)row * DM + u.pn * 256 + bj * HALF + ct) = pack8(acc[ai][bj][m][0] * rs, acc[ai][bj][m][1] * rs); }
        return false;
    }
};
struct EpiMix {
    bf16_t* MIX; const bf16_t *RA, *SB;
    __device__ __forceinline__ bool operator()(f32x4 (&acc)[2][2][4][2], const Unit& u, int wr, int wc, int fr, int fq) const {
        const int row0 = u.pm * BM + wr * 64 + fr, ct = wc * 32 + 8 * fq; const bool first = (u.aux == 0);
        const bf16_t* G = first ? RA : SB;
        v4u gq[2][4][2];
#pragma unroll
        for (int ai = 0; ai < 2; ++ai)
#pragma unroll
            for (int m = 0; m < 4; ++m)
#pragma unroll
                for (int bj = 0; bj < 2; ++bj) gq[ai][m][bj] = *(const v4u*)(G + (size_t)(row0 + ai * HALF + m * 16) * DM + u.pn * 256 + bj * HALF + ct);
#pragma unroll
        for (int ai = 0; ai < 2; ++ai)
#pragma unroll
            for (int m = 0; m < 4; ++m)
#pragma unroll
                for (int bj = 0; bj < 2; ++bj) { const v4u gv = gq[ai][m][bj];
                    const float gf[8] = {bflo(gv.x), bfhi(gv.x), bflo(gv.y), bfhi(gv.y), bflo(gv.z), bfhi(gv.z), bflo(gv.w), bfhi(gv.w)};
                    f32x4 v0 = acc[ai][bj][m][0], v1 = acc[ai][bj][m][1];
#pragma unroll
                    for (int j = 0; j < 4; ++j) { v0[j] *= gf[j]; v1[j] *= gf[4 + j]; }
                    if (first) { acc[ai][bj][m][0] = v0; acc[ai][bj][m][1] = v1; }
                    else *(v4u*)(MIX + (size_t)(row0 + ai * HALF + m * 16) * DM + u.pn * 256 + bj * HALF + ct) = pack8(v0, v1); }
        return first;
    }
};
struct EpiOut {
    const float* X; bf16_t* X2L; bf16_t* X2B; float* SSQ_X;
    __device__ __forceinline__ bool operator()(f32x4 (&acc)[2][2][4][2], const Unit& u, int wr, int wc, int fr, int fq) const {
        const int row0 = u.pm * BM + wr * 64 + fr, ct = wc * 32 + 8 * fq;
#pragma unroll
        for (int ai = 0; ai < 2; ++ai) { f32x4 xv[4][2][2];
#pragma unroll
            for (int m = 0; m < 4; ++m)
#pragma unroll
                for (int bj = 0; bj < 2; ++bj) { const size_t off = (size_t)(row0 + ai * HALF + m * 16) * DM + u.pn * 256 + bj * HALF + ct; xv[m][bj][0] = *(const f32x4*)(X + off); xv[m][bj][1] = *(const f32x4*)(X + off + 4); }
#pragma unroll
            for (int m = 0; m < 4; ++m) { const int row = row0 + ai * HALF + m * 16; float s = 0.f;
#pragma unroll
                for (int bj = 0; bj < 2; ++bj) { const size_t off = (size_t)row * DM + u.pn * 256 + bj * HALF + ct;
                    const f32x4 v0 = acc[ai][bj][m][0] + xv[m][bj][0], v1 = acc[ai][bj][m][1] + xv[m][bj][1];
                    s += dot4(v0) + dot4(v1);
                    const v4u hp = pack8(v0, v1);
                    const f32x4 l0 = (f32x4){v0[0] - bflo(hp.x), v0[1] - bfhi(hp.x), v0[2] - bflo(hp.y), v0[3] - bfhi(hp.y)}, l1 = (f32x4){v1[0] - bflo(hp.z), v1[1] - bfhi(hp.z), v1[2] - bflo(hp.w), v1[3] - bfhi(hp.w)};
                    *(v4u*)(X2B + off) = hp;
#if !RES_BF16
                    *(v4u*)(X2L + off) = pack8(l0, l1);
#endif
                    }
                s += __shfl_xor(s, 16); s += __shfl_xor(s, 32);
                if (fq == 0) SSQ_X[(size_t)row * 16 + u.pn * 4 + wc] = s; } }
        return false;
    }
};
struct EpiH {
    bf16_t* H; const float* SLOT_RS;
    __device__ __forceinline__ bool operator()(f32x4 (&acc)[2][2][4][2], const Unit& u, int wr, int wc, int fr, int fq) const {
        const int row0 = u.pm * BM + wr * 64 + fr, ct = wc * 32 + 8 * fq;
        float rsv[2][4];
#pragma unroll
        for (int ai = 0; ai < 2; ++ai)
#pragma unroll
            for (int m = 0; m < 4; ++m) rsv[ai][m] = SLOT_RS[row0 + ai * HALF + m * 16];
#pragma unroll
        for (int ai = 0; ai < 2; ++ai)
#pragma unroll
            for (int m = 0; m < 4; ++m) { const int row = row0 + ai * HALF + m * 16; const float rs = rsv[ai][m];
                f32x4 h0, h1;
#pragma unroll
                for (int j = 0; j < 4; ++j) { const float g0 = acc[ai][0][m][0][j] * rs, g1 = acc[ai][0][m][1][j] * rs;
                    h0[j] = g0 * fsigmoid(g0) * (acc[ai][1][m][0][j] * rs); h1[j] = g1 * fsigmoid(g1) * (acc[ai][1][m][1][j] * rs); }
                *(v4u*)(H + (size_t)row * EFF + u.pn * HALF + ct) = pack8(h0, h1); }
        return false;
    }
};
struct EpiY {
    bf16_t* Y; const int* SLOT_A; const float* TOKW;
    __device__ __forceinline__ bool operator()(f32x4 (&acc)[2][2][4][2], const Unit& u, int wr, int wc, int fr, int fq) const {
        const int row0 = u.pm * BM + wr * 64 + fr, ct = wc * 32 + 8 * fq;
#pragma unroll
        for (int ai = 0; ai < 2; ++ai) { int av[4]; float wv[4];
#pragma unroll
            for (int m = 0; m < 4; ++m) av[m] = SLOT_A[row0 + ai * HALF + m * 16];
#pragma unroll
            for (int m = 0; m < 4; ++m) wv[m] = TOKW[av[m] < 0 ? 0 : av[m]];
#pragma unroll
            for (int m = 0; m < 4; ++m) { const int a = av[m];
                if (a >= 0) { const float w = wv[m]; bf16_t* yr = Y + (unsigned)a * (unsigned)DM + (unsigned)(u.pn * 256 + ct);
#pragma unroll
                    for (int bj = 0; bj < 2; ++bj) *(v4u*)(yr + bj * HALF) = pack8(acc[ai][bj][m][0] * w, acc[ai][bj][m][1] * w); } }
            asm volatile("" ::: "memory"); }
        return false;
    }
};
}

namespace at {
constexpr int NW = 8, QBLK = 32, QB = 256, KVBLK = 64;
constexpr int KSLOT = 12288, VSLOT = 8192;
constexpr int LDS_K = 0, LDS_V = 2 * KSLOT, LDS_WS = LDS_V + 2 * VSLOT, LDS_OST = LDS_WS + NW * 64 * 4, LDS_TOTAL = LDS_OST + NW * 4096;
typedef LAS const char* lds_cptr;
__device__ __forceinline__ int crow(int r, int hi) { return (r & 3) + 8 * (r >> 2) + 4 * hi; }
__device__ __forceinline__ void glds16(const void* gsrc, unsigned lds_dst) { unsigned keep;
    asm volatile("s_mov_b32 %0, m0\n\ts_mov_b32 m0, %2\n\ts_nop 0\n\tglobal_load_lds_dwordx4 %1, off\n\ts_mov_b32 m0, %0" : "=&s"(keep) : "v"(gsrc), "s"(lds_dst) : "memory"); }
__device__ __forceinline__ void glds16s(const void* sbase, unsigned voff, unsigned lds_dst) { unsigned keep;
    asm volatile("s_mov_b32 %0, m0\n\ts_mov_b32 m0, %3\n\ts_nop 0\n\tglobal_load_lds_dwordx4 %1, %2\n\ts_mov_b32 m0, %0" : "=&s"(keep) : "v"(voff), "s"(sbase), "s"(lds_dst) : "memory"); }
#define AT_WAIT_BAR0() asm volatile("s_waitcnt vmcnt(0) lgkmcnt(0)\n\ts_barrier" ::: "memory")
__device__ __forceinline__ void cmask(f32x16& p0, f32x16& p1, int jb, int qrel, int hi) {
    const float NEG = -INFINITY; const int qh = qrel - 4 * hi - 64 * jb;
#pragma unroll
    for (int r = 0; r < 16; ++r) { const int c = (r & 3) + 8 * (r >> 2); if (c > qh) p0[r] = NEG; if (c + 32 > qh) p1[r] = NEG; }
}
template <int ND> __device__ __forceinline__ void qkt(f32x16& p0, f32x16& p1, lds_cptr kb, const bf16x8* qr) {
    f32x16 z0 = {}, z1 = {};
#pragma unroll
    for (int d0 = 0; d0 < ND; ++d0) {
        const bf16x8 b0 = *(const LAS bf16x8*)(kb + d0 * 2048), b1 = *(const LAS bf16x8*)(kb + d0 * 2048 + 512);
        z0 = __builtin_amdgcn_mfma_f32_32x32x16_bf16(b0, qr[d0], z0, 0, 0, 0); z1 = __builtin_amdgcn_mfma_f32_32x32x16_bf16(b1, qr[d0], z1, 0, 0, 0); }
    p0 = z0; p1 = z1;
}
__device__ __forceinline__ float rowmax(const f32x16& p0, const f32x16& p1) {
    float a = fmaxf(p0[0], p1[0]);
#pragma unroll
    for (int r = 1; r < 16; ++r) a = fmaxf(a, fmaxf(p0[r], p1[r]));
    auto rr = __builtin_amdgcn_permlane32_swap(__float_as_uint(a), __float_as_uint(a), false, false);
    return fmaxf(__uint_as_float(rr[0]), __uint_as_float(rr[1]));
}
__device__ __forceinline__ void pv(f32x16* o, int vb, bf16x8 pa0, bf16x8 pa1, bf16x8 pa2, bf16x8 pa3) {
#pragma unroll
    for (int d0 = 0; d0 < 2; ++d0) { s16x4 lo[4], hi[4];
#pragma unroll
        for (int ks = 0; ks < 4; ++ks) {
            asm volatile("ds_read_b64_tr_b16 %0,%1 offset:%c2" : "=&v"(lo[ks]) : "v"(vb), "i"(d0 * 4096 + ks * 1024) : "memory");
            asm volatile("ds_read_b64_tr_b16 %0,%1 offset:%c2" : "=&v"(hi[ks]) : "v"(vb), "i"(d0 * 4096 + ks * 1024 + 512) : "memory"); }
        asm volatile("s_waitcnt lgkmcnt(0)" ::: "memory"); __builtin_amdgcn_sched_barrier(0);
#define AT_PK(k) (bf16x8){lo[k][0], lo[k][1], lo[k][2], lo[k][3], hi[k][0], hi[k][1], hi[k][2], hi[k][3]}
        o[d0] = __builtin_amdgcn_mfma_f32_32x32x16_bf16(pa0, AT_PK(0), o[d0], 0, 0, 0);
        o[d0] = __builtin_amdgcn_mfma_f32_32x32x16_bf16(pa1, AT_PK(1), o[d0], 0, 0, 0);
        o[d0] = __builtin_amdgcn_mfma_f32_32x32x16_bf16(pa2, AT_PK(2), o[d0], 0, 0, 0);
        o[d0] = __builtin_amdgcn_mfma_f32_32x32x16_bf16(pa3, AT_PK(3), o[d0], 0, 0, 0);
#undef AT_PK
    }
}
struct MobaX { const unsigned* SELh; const unsigned short* lst; int lcnt, ltile; bf16* PO; float* PML; long qh0; };
template <int DQ, int MODE>
__device__ __forceinline__ void attn_unit(int qb, const bf16* Qh, int qp, const bf16* Kh, int kp, const bf16* Krh, const bf16* Vh, int vp, bf16* Oh, int op, const MobaX X, LAS char* shm, const int wave) {
    constexpr int ND = DQ / 16;
    const int lane = lane_id(), r32 = lane & 31, hi = lane >> 5; const int wid = wave;
    const int q0 = qb * QB;
    const int t0 = (MODE == 0) ? 0 : 4 * qb, NT = (MODE == 0) ? 4 * qb + 4 : 4;
    int srow = q0 + wid * QBLK + r32; bool valid = true;
    if (MODE == 2) { const int li = X.ltile * 256 + wid * QBLK + r32; valid = li < X.lcnt; srow = (int)X.lst[valid ? li : X.lcnt - 1]; }
    const unsigned lds0 = (unsigned)(uintptr_t)shm;
    LAS float* wsf = (LAS float*)(shm + LDS_WS) + wid * 64;
    const bf16* ksrc = Kh + (size_t)lane * kp + wid * 8;
    const bf16* krsrc = (DQ == 96) ? (Krh + (size_t)lane * 32 + (wid & 3) * 8) : nullptr;
    const bf16* vsrc = Vh + (size_t)(16 * (wid & 3) + (lane >> 2)) * vp + (wid >> 2) * 32 + (lane & 3) * 8;
    const unsigned kdst = lds0 + LDS_K + wid * 1024, krdst = lds0 + LDS_K + (8 + (wid & 3)) * 1024, vdst = lds0 + LDS_V + wid * 1024;
#define AT_DMA(t, s) do { glds16(ksrc + (size_t)(t0 + (t)) * KVBLK * kp, (unsigned)__builtin_amdgcn_readfirstlane(kdst + (s) * KSLOT)); \
        if (DQ == 96 && wid < 4) glds16(krsrc + (size_t)(t0 + (t)) * KVBLK * 32, (unsigned)__builtin_amdgcn_readfirstlane(krdst + (s) * KSLOT)); \
        glds16(vsrc + (size_t)(t0 + (t)) * KVBLK * vp, (unsigned)__builtin_amdgcn_readfirstlane(vdst + (s) * VSLOT)); } while (0)
    const int vb0 = (int)(lds0 + LDS_V) + ((lane >> 4) & 1) * 32 + (lane & 3) * 8 + (4 * hi + ((lane & 15) >> 2)) * 64;
    const lds_cptr kp0 = (lds_cptr)shm + LDS_K + hi * 1024 + r32 * 16;
    AT_DMA(0, 0);
    bf16x8 qr[ND];
#pragma unroll
    for (int d0 = 0; d0 < ND; ++d0) qr[d0] = *(const bf16x8*)(Qh + (size_t)srow * qp + d0 * 16 + hi * 8);
    float mrow = -1e30f, l_reg = 0.f; f32x16 o[2]; o[0] = f32x16{}; o[1] = f32x16{};
    const int qrel = wid * QBLK + r32;
    for (int t = 0; t < NT; ++t) {
        AT_WAIT_BAR0();
        const int sl = t & 1;
        if (t + 1 < NT) AT_DMA(t + 1, sl ^ 1);
        f32x16 p0, p1; qkt<ND>(p0, p1, kp0 + sl * KSLOT, qr);
        if (MODE != 2) { if (t >= NT - 4) cmask(p0, p1, t - (NT - 4), qrel, hi); }
        const float rm = rowmax(p0, p1);
        const float mnew = fmaxf(mrow, rm); const float alpha = __builtin_amdgcn_exp2f(mrow - mnew); mrow = mnew;
        float s = 0.f;
#pragma unroll
        for (int r = 0; r < 16; ++r) { p0[r] = __builtin_amdgcn_exp2f(p0[r] - mnew); p1[r] = __builtin_amdgcn_exp2f(p1[r] - mnew); s += p0[r] + p1[r]; }
        l_reg = l_reg * alpha + s;
        if (__any(alpha != 1.f)) {
            if (hi == 0) wsf[r32] = alpha;
            asm volatile("s_waitcnt lgkmcnt(0)" ::: "memory");
#pragma unroll
            for (int r = 0; r < 16; ++r) { const float a = wsf[crow(r, hi)]; o[0][r] *= a; o[1][r] *= a; }
        }
        v4u pw0, pw1, pw2, pw3;
        pw0 = (v4u){cvt_pk_bf16(p0[0], p0[1]), cvt_pk_bf16(p0[2], p0[3]), cvt_pk_bf16(p0[4], p0[5]), cvt_pk_bf16(p0[6], p0[7])};
        pw1 = (v4u){cvt_pk_bf16(p0[8], p0[9]), cvt_pk_bf16(p0[10], p0[11]), cvt_pk_bf16(p0[12], p0[13]), cvt_pk_bf16(p0[14], p0[15])};
        pw2 = (v4u){cvt_pk_bf16(p1[0], p1[1]), cvt_pk_bf16(p1[2], p1[3]), cvt_pk_bf16(p1[4], p1[5]), cvt_pk_bf16(p1[6], p1[7])};
        pw3 = (v4u){cvt_pk_bf16(p1[8], p1[9]), cvt_pk_bf16(p1[10], p1[11]), cvt_pk_bf16(p1[12], p1[13]), cvt_pk_bf16(p1[14], p1[15])};
        pv(o, vb0 + sl * VSLOT, __builtin_bit_cast(bf16x8, pw0), __builtin_bit_cast(bf16x8, pw1), __builtin_bit_cast(bf16x8, pw2), __builtin_bit_cast(bf16x8, pw3));
    }
    { auto rr = __builtin_amdgcn_permlane32_swap(__float_as_uint(l_reg), __float_as_uint(l_reg), false, false); l_reg = __uint_as_float(rr[0]) + __uint_as_float(rr[1]); }
    LAS int* wsi = (LAS int*)wsf;
    if (hi == 0) { wsf[32 + r32] = l_reg;
        if (MODE == 1) wsf[r32] = mrow;
        if (MODE == 2) { const unsigned sel = X.SELh[srow]; const int rank = __builtin_popcount(sel & ((1u << qb) - 1u)); const long pidx = (X.qh0 + (long)srow) * 3 + rank;
            wsi[r32] = valid ? (int)pidx : -1; if (valid) { X.PML[pidx * 2] = mrow; X.PML[pidx * 2 + 1] = l_reg; } } }
    asm volatile("s_waitcnt lgkmcnt(0)" ::: "memory");
    float rli[16];
#pragma unroll
    for (int r = 0; r < 16; ++r) rli[r] = 1.f / wsf[32 + crow(r, hi)];
    { LAS bf16* stg = (LAS bf16*)(shm + LDS_OST) + wid * 2048;
#pragma unroll
      for (int r = 0; r < 16; ++r) { const int orow = crow(r, hi);
#pragma unroll
        for (int d0 = 0; d0 < 2; ++d0) stg[orow * 64 + d0 * 32 + r32] = (bf16)f2bf(o[d0][r] * rli[r]); }
      asm volatile("s_waitcnt lgkmcnt(0)" ::: "memory");
#pragma unroll
      for (int i = 0; i < 4; ++i) { const int row = i * 8 + (lane >> 3), ch = lane & 7; const v4u v = *(const LAS v4u*)(stg + row * 64 + ch * 8);
          if (MODE == 0) { *(v4u*)(Oh + (size_t)(q0 + wid * QBLK + row) * op + ch * 8) = v; }
          else if (MODE == 2) { const int pid = wsi[row]; if (pid >= 0) *(v4u*)(X.PO + (size_t)pid * 64 + ch * 8) = v; }
          else { const int sq = q0 + wid * QBLK + row; const long qh = X.qh0 + (long)sq; const unsigned sel = X.SELh[sq]; const int np = __builtin_popcount(sel);
              const float m0 = wsf[row], l0 = wsf[32 + row];
              float mi[3], li[3]; v4u oi[3]; float mmax = m0;
#pragma unroll
              for (int k = 0; k < 3; ++k) { mi[k] = -1e30f; li[k] = 0.f; oi[k] = (v4u){0u, 0u, 0u, 0u};
                  if (k < np) { mi[k] = X.PML[(qh * 3 + k) * 2]; li[k] = X.PML[(qh * 3 + k) * 2 + 1]; oi[k] = *(const v4u*)(X.PO + (size_t)(qh * 3 + k) * 64 + ch * 8); }
                  mmax = fmaxf(mmax, mi[k]); }
              const float w0 = l0 * __builtin_amdgcn_exp2f(m0 - mmax); float wk[3], wsum = w0;
#pragma unroll
              for (int k = 0; k < 3; ++k) { wk[k] = li[k] * __builtin_amdgcn_exp2f(mi[k] - mmax); wsum += wk[k]; }
              const float inv = 1.f / wsum;
              float r8[8] = {bflo(v.x), bfhi(v.x), bflo(v.y), bfhi(v.y), bflo(v.z), bfhi(v.z), bflo(v.w), bfhi(v.w)};
#pragma unroll
              for (int e = 0; e < 8; ++e) r8[e] *= w0;
#pragma unroll
              for (int k = 0; k < 3; ++k) { const v4u u = oi[k]; r8[0] += wk[k] * bflo(u.x); r8[1] += wk[k] * bfhi(u.x); r8[2] += wk[k] * bflo(u.y); r8[3] += wk[k] * bfhi(u.y);
                  r8[4] += wk[k] * bflo(u.z); r8[5] += wk[k] * bfhi(u.z); r8[6] += wk[k] * bflo(u.w); r8[7] += wk[k] * bfhi(u.w); }
              v4u w; w.x = cvt_pk_bf16(r8[0] * inv, r8[1] * inv); w.y = cvt_pk_bf16(r8[2] * inv, r8[3] * inv); w.z = cvt_pk_bf16(r8[4] * inv, r8[5] * inv); w.w = cvt_pk_bf16(r8[6] * inv, r8[7] * inv);
              *(v4u*)(Oh + (size_t)sq * op + ch * 8) = w; } } }
    asm volatile("s_waitcnt lgkmcnt(0)\n\ts_barrier" ::: "memory");
#undef AT_DMA
}
constexpr int MB_K = 0, MB_V = 32768, MB_WS = 65536, MB_OST = MB_WS + NW * 256, MB_TOTAL = MB_OST + NW * 4096;
template <int TOFF>
__device__ __forceinline__ void pv4(f32x16 (&o)[2][2], int vb, const v4u p0, const v4u p1, const v4u p2, const v4u p3) {
#pragma unroll
    for (int d0 = 0; d0 < 2; ++d0) { s16x4 lo[4], hh[4];
#pragma unroll
        for (int ks = 0; ks < 4; ++ks) {
            asm volatile("ds_read_b64_tr_b16 %0,%1 offset:%c2" : "=&v"(lo[ks]) : "v"(vb), "i"(TOFF + d0 * 4096 + ks * 1024) : "memory");
            asm volatile("ds_read_b64_tr_b16 %0,%1 offset:%c2" : "=&v"(hh[ks]) : "v"(vb), "i"(TOFF + d0 * 4096 + ks * 1024 + 512) : "memory"); }
        asm volatile("s_waitcnt lgkmcnt(0)" ::: "memory"); __builtin_amdgcn_sched_barrier(0);
#define AT_PK(k) (bf16x8){lo[k][0], lo[k][1], lo[k][2], lo[k][3], hh[k][0], hh[k][1], hh[k][2], hh[k][3]}
        if (MOBA_PRIO & 2) __builtin_amdgcn_s_setprio(1);
        o[d0][0] = __builtin_amdgcn_mfma_f32_32x32x16_bf16(__builtin_bit_cast(bf16x8, p0), AT_PK(0), o[d0][0], 0, 0, 0);
        o[d0][1] = __builtin_amdgcn_mfma_f32_32x32x16_bf16(__builtin_bit_cast(bf16x8, p1), AT_PK(1), o[d0][1], 0, 0, 0);
        o[d0][0] = __builtin_amdgcn_mfma_f32_32x32x16_bf16(__builtin_bit_cast(bf16x8, p2), AT_PK(2), o[d0][0], 0, 0, 0);
        o[d0][1] = __builtin_amdgcn_mfma_f32_32x32x16_bf16(__builtin_bit_cast(bf16x8, p3), AT_PK(3), o[d0][1], 0, 0, 0);
        if (MOBA_PRIO & 2) __builtin_amdgcn_s_setprio(0);
#undef AT_PK
    }
}
template <int T>
__device__ __forceinline__ void mb_tile_qk(f32x16& P0, f32x16& P1, lds_cptr kp0, const bf16x8* qr, int tmax) {
    if (T <= tmax) { f32x16 z0 = {}, z1 = {}; if (MOBA_PRIO & 1) __builtin_amdgcn_s_setprio(1);
#pragma unroll
        for (int d0 = 0; d0 < 4; ++d0) { const bf16x8 b0 = *(const LAS bf16x8*)(kp0 + T * 8192 + d0 * 2048), b1 = *(const LAS bf16x8*)(kp0 + T * 8192 + d0 * 2048 + 512);
            z0 = __builtin_amdgcn_mfma_f32_32x32x16_bf16(b0, qr[d0], z0, 0, 0, 0); z1 = __builtin_amdgcn_mfma_f32_32x32x16_bf16(b1, qr[d0], z1, 0, 0, 0); }
        if (MOBA_PRIO & 1) __builtin_amdgcn_s_setprio(0); P0 = z0; P1 = z1;
    } else {
#pragma unroll
        for (int r = 0; r < 16; ++r) { P0[r] = -INFINITY; P1[r] = -INFINITY; } }
}
__device__ __forceinline__ void mb_exp_pack(const f32x16& Pt, float mx, float& l, v4u& w0, v4u& w1) {
    f32x16 e;
#pragma unroll
    for (int r = 0; r < 16; ++r) { e[r] = __builtin_amdgcn_exp2f(Pt[r] - mx); l += e[r]; }
    w0 = (v4u){cvt_pk_bf16(e[0], e[1]), cvt_pk_bf16(e[2], e[3]), cvt_pk_bf16(e[4], e[5]), cvt_pk_bf16(e[6], e[7])};
    w1 = (v4u){cvt_pk_bf16(e[8], e[9]), cvt_pk_bf16(e[10], e[11]), cvt_pk_bf16(e[12], e[13]), cvt_pk_bf16(e[14], e[15])};
}
__device__ __forceinline__ void moba_block(int jb, const bf16* Qh, const bf16* Kh, const bf16* Vh, const MobaX X, int g0, int g1, bool own, LAS char* shm, const int wave) {
    constexpr int qp = 512, kp = 512, vp = 512;
    const int lane = lane_id(), r32 = lane & 31, hi = lane >> 5; const int wid = wave;
    const unsigned lds0 = (unsigned)(uintptr_t)shm;
    LAS float* wsf = (LAS float*)(shm + MB_WS) + wid * 64;
    { const unsigned kvo = (unsigned)(lane * kp * 2 + wid * 16), vvo = (unsigned)((16 * (wid & 3) + (lane >> 2)) * vp * 2 + (wid >> 2) * 64 + (lane & 3) * 16);
      const char* kbase = (const char*)(Kh + (size_t)jb * 256 * kp); const char* vbase = (const char*)(Vh + (size_t)jb * 256 * vp);
#pragma unroll
      for (int t = 0; t < 4; ++t) { glds16s(kbase + (size_t)t * (KVBLK * kp * 2), kvo, (unsigned)__builtin_amdgcn_readfirstlane(lds0 + MB_K + t * 8192 + wid * 1024));
          glds16s(vbase + (size_t)t * (KVBLK * vp * 2), vvo, (unsigned)__builtin_amdgcn_readfirstlane(lds0 + MB_V + t * 8192 + wid * 1024)); } }
    const int vb0 = (int)(lds0 + MB_V) + ((lane >> 4) & 1) * 32 + (lane & 3) * 8 + (4 * hi + ((lane & 15) >> 2)) * 64;
    const lds_cptr kp0 = (lds_cptr)shm + MB_K + hi * 1024 + r32 * 16;
    int gi = g0 + wid; int srow = 0, srowN = 0; bool valid = true, validN = true; unsigned sel = 0u; bf16x8 qr[4];
#define MB_ROWS(dst, vdst, g_) do { const int li = (g_) * 32 + r32; vdst = li < X.lcnt; dst = (int)X.lst[vdst ? li : X.lcnt - 1]; } while (0)
#define MB_QLOAD(src) do { _Pragma("unroll") for (int d0 = 0; d0 < 4; ++d0) qr[d0] = *(const bf16x8*)(Qh + (size_t)(src) * qp + d0 * 16 + hi * 8); sel = X.SELh[src]; } while (0)
#define MB_OWNROW() do { srow = jb * 256 + wid * 32 + r32; valid = true; MB_QLOAD(srow); } while (0)
    if (gi < g1) { MB_ROWS(srow, valid, gi); if (gi + NW < g1) MB_ROWS(srowN, validN, gi + NW); MB_QLOAD(srow); } else if (own) MB_OWNROW();
    AT_WAIT_BAR0();
#define MB_GROUP(OWN) do { \
        const int tmax = (OWN) ? (wid >> 1) : 3; \
        const int csrow = srow; const bool cvalid = valid; const unsigned csel = sel; \
        f32x16 P0, P1, P2, P3, P4, P5, P6, P7; \
        mb_tile_qk<0>(P0, P1, kp0, qr, tmax); mb_tile_qk<1>(P2, P3, kp0, qr, tmax); mb_tile_qk<2>(P4, P5, kp0, qr, tmax); mb_tile_qk<3>(P6, P7, kp0, qr, tmax); \
        if (!(OWN)) { const int gn = gi + NW; if (gn < g1) { srow = srowN; valid = validN; MB_QLOAD(srow); if (gn + NW < g1) MB_ROWS(srowN, validN, gn + NW); } else if (own) MB_OWNROW(); } \
        if (OWN) { const int qrel = wid * 32 + r32; \
            if (tmax == 0) cmask(P0, P1, 0, qrel, hi); else if (tmax == 1) cmask(P2, P3, 1, qrel, hi); else if (tmax == 2) cmask(P4, P5, 2, qrel, hi); else cmask(P6, P7, 3, qrel, hi); } \
        float mx = -INFINITY; \
        _Pragma("unroll") for (int r = 0; r < 16; ++r) { mx = fmaxf(mx, fmaxf(fmaxf(P0[r], P1[r]), fmaxf(P2[r], P3[r]))); mx = fmaxf(mx, fmaxf(fmaxf(P4[r], P5[r]), fmaxf(P6[r], P7[r]))); } \
        { auto rr = __builtin_amdgcn_permlane32_swap(__float_as_uint(mx), __float_as_uint(mx), false, false); mx = fmaxf(__uint_as_float(rr[0]), __uint_as_float(rr[1])); } \
        float l_reg = 0.f; v4u w0, w1, w2, w3, w4, w5, w6, w7, w8, w9, w10, w11, w12, w13, w14, w15; \
        f32x16 o[2][2]; o[0][0] = f32x16{}; o[0][1] = f32x16{}; o[1][0] = f32x16{}; o[1][1] = f32x16{}; \
        mb_exp_pack(P0, mx, l_reg, w0, w1); mb_exp_pack(P1, mx, l_reg, w2, w3); \
        pv4<0>(o, vb0, w0, w1, w2, w3); \
        if (tmax >= 1) { mb_exp_pack(P2, mx, l_reg, w4, w5); mb_exp_pack(P3, mx, l_reg, w6, w7); pv4<8192>(o, vb0, w4, w5, w6, w7); } \
        if (tmax >= 2) { mb_exp_pack(P4, mx, l_reg, w8, w9); mb_exp_pack(P5, mx, l_reg, w10, w11); pv4<16384>(o, vb0, w8, w9, w10, w11); } \
        if (tmax >= 3) { mb_exp_pack(P6, mx, l_reg, w12, w13); mb_exp_pack(P7, mx, l_reg, w14, w15); pv4<24576>(o, vb0, w12, w13, w14, w15); } \
        { auto rr = __builtin_amdgcn_permlane32_swap(__float_as_uint(l_reg), __float_as_uint(l_reg), false, false); l_reg = __uint_as_float(rr[0]) + __uint_as_float(rr[1]); } \
        LAS int* wsi = (LAS int*)wsf; \
        if (hi == 0) { wsf[32 + r32] = l_reg; \
            const int rank = (OWN) ? 3 : __builtin_popcount(csel & ((1u << jb) - 1u)); const long pidx = (X.qh0 + (long)csrow) * 4 + rank; \
            wsi[r32] = cvalid ? (int)pidx : -1; if (cvalid) { X.PML[pidx * 2] = mx; X.PML[pidx * 2 + 1] = l_reg; } } \
        asm volatile("s_waitcnt lgkmcnt(0)" ::: "memory"); \
        float rli[16]; \
        _Pragma("unroll") for (int r = 0; r < 16; ++r) rli[r] = __builtin_amdgcn_rcpf(wsf[32 + crow(r, hi)]); \
        { unsigned stgb = (unsigned)(uintptr_t)(shm + MB_OST) + wid * 4096 + hi * 512 + r32 * 2; asm volatile("" : "+v"(stgb)); \
          LAS bf16* stg = (LAS bf16*)(shm + MB_OST) + wid * 2048; \
          _Pragma("unroll") for (int r = 0; r < 16; ++r) { \
            _Pragma("unroll") for (int d0 = 0; d0 < 2; ++d0) *(LAS bf16*)(uintptr_t)(stgb + ((r & 3) + 8 * (r >> 2)) * 128 + d0 * 64) = (bf16)f2bf((o[d0][0][r] + o[d0][1][r]) * rli[r]); } \
          asm volatile("s_waitcnt lgkmcnt(0)" ::: "memory"); \
          _Pragma("unroll") for (int i = 0; i < 4; ++i) { const int row = i * 8 + (lane >> 3), ch = lane & 7; const v4u v = *(const LAS v4u*)(stg + row * 64 + ch * 8); \
              const int pid = wsi[row]; if (pid >= 0) *(v4u*)(X.PO + (size_t)pid * 64 + ch * 8) = v; } \
          asm volatile("s_waitcnt lgkmcnt(0)" ::: "memory"); } \
    } while (0)
#pragma unroll 1
    for (; gi < g1; gi += NW) { MB_GROUP(0); }
    if (own) { MB_GROUP(1); }
#undef MB_GROUP
#undef MB_OWNROW
    asm volatile("s_waitcnt lgkmcnt(0)\n\ts_barrier" ::: "memory");
#undef MB_ROWS
#undef MB_QLOAD
}
}


namespace atm {
using at::crow; using at::glds16; using at::lds_cptr;
constexpr int NW = 8, QBLK = 32, QB = 256, KVBLK = 64, ND = 6;
constexpr int KSL = 12288, VSL = 8192;
constexpr int LDS_K = 0, LDS_V = 3 * KSL, LDS_WS = LDS_V + 3 * VSL, LDS_OST = LDS_WS + NW * 64 * 4, LDS_TOTAL = LDS_OST + NW * 4096;
#define ATM_SBAR() __builtin_amdgcn_sched_barrier(0)
#define ATM_WAIT_BAR(N) asm volatile("s_waitcnt vmcnt(" #N ") lgkmcnt(0)\n\ts_barrier" ::: "memory")
#define ATM_MFMA(a, b, c) __builtin_amdgcn_mfma_f32_32x32x16_bf16(a, b, c, 0, 0, 0)
__device__ __forceinline__ void cmask(f32x16& p0, f32x16& p1, int jb, int qrel, int hi) {
    const float NEG = -INFINITY; const int qh = qrel - 4 * hi - 64 * jb;
#pragma unroll
    for (int r = 0; r < 16; ++r) { const int c = (r & 3) + 8 * (r >> 2); if (c > qh) p0[r] = NEG; if (c + 32 > qh) p1[r] = NEG; }
}
__device__ __forceinline__ void kload2(bf16x8* kf, lds_cptr kp, int j) { kf[2 * j] = *(const LAS bf16x8*)(kp + j * 2048); kf[2 * j + 1] = *(const LAS bf16x8*)(kp + j * 2048 + 512); }
typedef short v4i16_t __attribute__((ext_vector_type(4)));
__device__ __forceinline__ s16x4 vtr(lds_cptr p) { return __builtin_bit_cast(s16x4, __builtin_amdgcn_ds_read_tr16_b64_v4i16((LAS v4i16_t*)p)); }
__device__ __forceinline__ unsigned cvtpk_s(float lo, float hi) { typedef float f2 __attribute__((ext_vector_type(2))); typedef __bf16 b2 __attribute__((ext_vector_type(2))); f2 v = {lo, hi}; b2 b = __builtin_convertvector(v, b2); return __builtin_bit_cast(unsigned, b); }
template <int THRL>
__device__ __forceinline__ void attn_unit_mla(int qb, const bf16* Qh, const bf16* Kh, const bf16* Krh, const bf16* Vh, bf16* Oh, LAS char* shm, const int wave) {
    constexpr int QP = QL, KP = DM, VP = DM, OP = DM;
    const int lane = lane_id(), r32 = lane & 31, hi = lane >> 5; const int wid = wave;
    const int q0 = qb * QB;
    const bf16* Qw = Qh + (size_t)(q0 + wid * QBLK) * QP;
    const unsigned lds0 = (unsigned)(uintptr_t)shm;
    LAS float* wsf = (LAS float*)(shm + LDS_WS) + wid * 64;
    const unsigned kvo = (unsigned)(lane * KP * 2 + wid * 16), krvo = (unsigned)(lane * 64 + (wid & 3) * 16), vvo = (unsigned)((16 * (wid & 3) + (lane >> 2)) * VP * 2 + (wid >> 2) * 64 + (lane & 3) * 16);
    const char* kbase = (const char*)Kh; const char* krbase = (const char*)Krh; const char* vbase = (const char*)Vh;
    const unsigned kdst = lds0 + LDS_K + wid * 1024, krdst = lds0 + LDS_K + (8 + (wid & 3)) * 1024, vdst = lds0 + LDS_V + wid * 1024;
#define DMA_K(t, sidx) do { at::glds16s(kbase + (size_t)(t) * (KVBLK * KP * 2), kvo, (unsigned)__builtin_amdgcn_readfirstlane(kdst + (sidx) * KSL)); at::glds16s(krbase + (size_t)(t) * (KVBLK * 64), krvo, (unsigned)__builtin_amdgcn_readfirstlane(krdst + (sidx) * KSL)); } while (0)
#define DMA_V(t, sidx) at::glds16s(vbase + (size_t)(t) * (KVBLK * VP * 2), vvo, (unsigned)__builtin_amdgcn_readfirstlane(vdst + (sidx) * VSL))
    const int vb0 = (int)(lds0 + LDS_V) + ((lane >> 4) & 1) * 32 + (lane & 3) * 8 + (4 * hi + ((lane & 15) >> 2)) * 64;
    bf16x8 kf[12];
    const lds_cptr shm3 = (lds_cptr)shm; const lds_cptr kp0 = shm3 + LDS_K + hi * 1024 + r32 * 16; const lds_cptr vp0 = shm3 + LDS_V + ((lane >> 4) & 1) * 32 + (lane & 3) * 8 + (4 * hi + ((lane & 15) >> 2)) * 64;
    const int NT = (q0 + QB) / KVBLK;
    DMA_K(0, 0); DMA_V(0, 0); DMA_K(1, 1);
    bf16x8 qr[ND];
#pragma unroll
    for (int d0 = 0; d0 < ND; ++d0) qr[d0] = *(const bf16x8*)(Qw + (size_t)r32 * QP + d0 * 16 + hi * 8);
    float mhat = 0.f, l_reg = 0.f; f32x16 o[2]; o[0] = f32x16{}; o[1] = f32x16{}; f32x16 negm = f32x16{};
    const int qrel = wid * QBLK + r32;
#define CMASK(P0, P1, t) do { int jb_ = (t) - (NT - 4); if (jb_ >= 0) cmask(P0, P1, jb_, qrel, hi); } while (0)
    bool resc = false;
#define RESC() do { if (resc) { asm volatile("s_waitcnt lgkmcnt(0)" ::: "memory"); \
      _Pragma("unroll") for (int d_ = 0; d_ < 2; ++d_) _Pragma("unroll") for (int r = 0; r < 16; ++r) o[d_][r] *= wsf[crow(r, hi)]; } } while (0)
    f32x16 pA0, pA1, pB0, pB1;
    int sl_prev = 0, sl_cur = 0, sl_next = 1;
#define ROT() do { sl_prev = sl_cur; sl_cur = sl_next; sl_next = (sl_next == 2) ? 0 : sl_next + 1; } while (0)
    DMA_K(2, 2);
    ATM_WAIT_BAR(5);
    { const lds_cptr kb = kp0; f32x16 z0 = {}, z1 = {};
#pragma unroll
      for (int d0 = 0; d0 < ND; ++d0) { const bf16x8 b0 = *(const LAS bf16x8*)(kb + d0 * 2048), b1 = *(const LAS bf16x8*)(kb + d0 * 2048 + 512); z0 = ATM_MFMA(b0, qr[d0], z0); z1 = ATM_MFMA(b1, qr[d0], z1); }
      pA0 = z0; pA1 = z1; }
    CMASK(pA0, pA1, 0);
    { float a = fmaxf(pA0[0], pA1[0]);
#pragma unroll
      for (int r = 1; r < 16; ++r) a = fmaxf(a, fmaxf(pA0[r], pA1[r]));
      auto rr = __builtin_amdgcn_permlane32_swap(__float_as_uint(a), __float_as_uint(a), false, false); mhat = fmaxf(__uint_as_float(rr[0]), __uint_as_float(rr[1])); }
#pragma unroll
    for (int r = 0; r < 16; ++r) { pA0[r] = __builtin_amdgcn_exp2f(pA0[r] - mhat); pA1[r] = __builtin_amdgcn_exp2f(pA1[r] - mhat); }
#pragma unroll
    for (int r = 0; r < 16; ++r) negm[r] = -mhat;
    asm volatile("" : "+v"(negm));
    ATM_WAIT_BAR(0);
    DMA_K(3, 0); DMA_V(1, 1);
    ROT();
#pragma unroll
    for (int j = 0; j < 6; ++j) kload2(kf, kp0 + sl_cur * KSL, j);
    ATM_WAIT_BAR(3);
    s16x4 vAl, vAh, vBl, vBh; v4u pw0, pw1, pw2, pw3;
#define PKW(P, B) cvtpk_s(P[B], P[B + 1])
#define PAF(k) __builtin_bit_cast(bf16x8, pw##k)
#define FRA (bf16x8){vAl[0], vAl[1], vAl[2], vAl[3], vAh[0], vAh[1], vAh[2], vAh[3]}
#define FRB (bf16x8){vBl[0], vBl[1], vBl[2], vBl[3], vBh[0], vBh[1], vBh[2], vBh[3]}
#define PIN(x) asm volatile("" : "+v"(x))
#define MX3(a, b, c) __builtin_fmaxf(__builtin_fmaxf((a), (b)), (c))
#define GAPA(MF, A0, A1, A2, A3, W0, W1, PW) do { MF; sacc += A0; sacc += A1; sacc += A2; sacc += A3; PIN(sacc); W0; W1; PIN(PW); ATM_SBAR(); } while (0)
#define EX(v) __builtin_amdgcn_exp2f(v)
#define GAPB(MF, X, B) do { MF; X[B] = EX(X[B]); X[B + 1] = EX(X[B + 1]); X[B + 2] = EX(X[B + 2]); X[B + 3] = EX(X[B + 3]); PIN(X); ATM_SBAR(); } while (0)
#define VRDA(i) do { vAl = vtr(vp_ + (((i) >> 2) * 4096 + ((i) & 3) * 1024)); vAh = vtr(vp_ + (((i) >> 2) * 4096 + ((i) & 3) * 1024 + 512)); } while (0)
#define VRDB(i) do { vBl = vtr(vp_ + (((i) >> 2) * 4096 + ((i) & 3) * 1024)); vBh = vtr(vp_ + (((i) >> 2) * 4096 + ((i) & 3) * 1024 + 512)); } while (0)
#define KRD(G, j) do { if (G) { kload2(kf, kp0 + sl_next * KSL, j); } } while (0)
#define STEP(C0, C1, P0, P1, t, GK, GV, GL) do { ATM_SBAR(); if (MLA_PRIO & 1) __builtin_amdgcn_s_setprio(1); \
    const lds_cptr vp_ = vp0 + sl_prev * VSL; \
    float sacc = (P0[0] + P0[1]); \
    GAPA(C0 = ATM_MFMA(kf[0], qr[0], negm), P0[2], P0[3], P0[4], P0[5],     pw0[0] = PKW(P0, 0), pw0[1] = PKW(P0, 2), pw0); \
    GAPA(C1 = ATM_MFMA(kf[1], qr[0], negm), P0[6], P0[7], P0[8], P0[9],     pw0[2] = PKW(P0, 4), pw0[3] = PKW(P0, 6), pw0); \
    GAPA(C0 = ATM_MFMA(kf[2], qr[1], C0),   P0[10], P0[11], P0[12], P0[13], pw1[0] = PKW(P0, 8), pw1[1] = PKW(P0, 10), pw1); \
    GAPA(C1 = ATM_MFMA(kf[3], qr[1], C1),   P0[14], P0[15], P1[0], P1[1],   pw1[2] = PKW(P0, 12), pw1[3] = PKW(P0, 14), pw1); \
    GAPA(C0 = ATM_MFMA(kf[4], qr[2], C0),   P1[2], P1[3], P1[4], P1[5],     pw2[0] = PKW(P1, 0), pw2[1] = PKW(P1, 2), pw2); \
    GAPA(C1 = ATM_MFMA(kf[5], qr[2], C1),   P1[6], P1[7], P1[8], P1[9],     pw2[2] = PKW(P1, 4), pw2[3] = PKW(P1, 6), pw2); \
    GAPA(C0 = ATM_MFMA(kf[6], qr[3], C0),   P1[10], P1[11], P1[12], P1[13], pw3[0] = PKW(P1, 8), pw3[1] = PKW(P1, 10), pw3); \
    GAPA(C1 = ATM_MFMA(kf[7], qr[3], C1),   P1[14], P1[15], 0.f, 0.f,       pw3[2] = PKW(P1, 12), pw3[3] = PKW(P1, 14), pw3); \
    C0 = ATM_MFMA(kf[8], qr[4], C0); ATM_SBAR(); C1 = ATM_MFMA(kf[9], qr[4], C1); ATM_SBAR(); C0 = ATM_MFMA(kf[10], qr[5], C0); ATM_SBAR(); C1 = ATM_MFMA(kf[11], qr[5], C1); \
    VRDA(0); ATM_SBAR(); \
    if (MLA_PRIO & 1) __builtin_amdgcn_s_setprio(0); l_reg += sacc; \
    if (GK) { DMA_K((t) + 3, sl_cur); } if (GV) { DMA_V((t) + 1, sl_next); } \
    CMASK(C0, C1, t); \
    { float a = MX3(C0[0], C0[1], C1[0]), b = MX3(C0[2], C0[3], C1[1]); a = MX3(a, C1[2], C1[3]); \
      _Pragma("unroll") for (int r = 4; r < 16; r += 4) { a = MX3(a, C0[r], C0[r + 1]); b = MX3(b, C0[r + 2], C0[r + 3]); a = MX3(a, C1[r], C1[r + 1]); b = MX3(b, C1[r + 2], C1[r + 3]); } \
      float rm = __builtin_fmaxf(a, b); { auto rr = __builtin_amdgcn_permlane32_swap(__float_as_uint(rm), __float_as_uint(rm), false, false); rm = __builtin_fmaxf(__uint_as_float(rr[0]), __uint_as_float(rr[1])); } \
      resc = false; \
      if (__builtin_expect(__any(rm > (float)THRL), 0)) { const float dl = __builtin_fmaxf(rm, 0.f); mhat += dl; \
        _Pragma("unroll") for (int r = 0; r < 16; ++r) { C0[r] -= dl; C1[r] -= dl; } \
        _Pragma("unroll") for (int r = 0; r < 16; ++r) negm[r] = -mhat; asm volatile("" : "+v"(negm)); \
        const float f = __builtin_amdgcn_exp2f(-dl); l_reg *= f; if (hi == 0) wsf[r32] = f; resc = true; } } \
    ATM_SBAR(); \
    if (MLA_PRIO & 2) __builtin_amdgcn_s_setprio(1); VRDB(4); ATM_SBAR(); GAPB(o[0] = ATM_MFMA(PAF(0), FRA, o[0]), C0, 0); \
    KRD(GL, 0); VRDA(1); ATM_SBAR(); GAPB(o[1] = ATM_MFMA(PAF(0), FRB, o[1]), C0, 4); \
    KRD(GL, 1); VRDB(5); ATM_SBAR(); GAPB(o[0] = ATM_MFMA(PAF(1), FRA, o[0]), C0, 8); \
    KRD(GL, 2); VRDA(2); ATM_SBAR(); GAPB(o[1] = ATM_MFMA(PAF(1), FRB, o[1]), C0, 12); \
    KRD(GL, 3); VRDB(6); ATM_SBAR(); GAPB(o[0] = ATM_MFMA(PAF(2), FRA, o[0]), C1, 0); \
    KRD(GL, 4); VRDA(3); ATM_SBAR(); GAPB(o[1] = ATM_MFMA(PAF(2), FRB, o[1]), C1, 4); \
    KRD(GL, 5); VRDB(7); ATM_SBAR(); GAPB(o[0] = ATM_MFMA(PAF(3), FRA, o[0]), C1, 8); \
    GAPB(o[1] = ATM_MFMA(PAF(3), FRB, o[1]), C1, 12); if (MLA_PRIO & 2) __builtin_amdgcn_s_setprio(0); \
    } while (0)
    int t = 1;
#undef CMASK
#define CMASK(P0, P1, t) do {} while (0)
    for (; t + 5 < NT; t += 2) {
        STEP(pB0, pB1, pA0, pA1, t, true, true, true);     ATM_WAIT_BAR(3); RESC(); ROT();
        STEP(pA0, pA1, pB0, pB1, t + 1, true, true, true); ATM_WAIT_BAR(3); RESC(); ROT();
    }
#undef CMASK
#define CMASK(P0, P1, t) do { int jb_ = (t) - (NT - 4); if (jb_ >= 0) cmask(P0, P1, jb_, qrel, hi); } while (0)
#define ENDW(tt) do { if ((tt) + 3 < NT) { ATM_WAIT_BAR(3); } else if ((tt) + 2 < NT) { ATM_WAIT_BAR(1); } else { ATM_WAIT_BAR(0); } } while (0)
    for (; t + 1 < NT; t += 2) {
        STEP(pB0, pB1, pA0, pA1, t, (t + 3 < NT), (t + 1 < NT), (t + 1 < NT));         ENDW(t);     RESC(); ROT();
        STEP(pA0, pA1, pB0, pB1, t + 1, (t + 4 < NT), (t + 2 < NT), (t + 2 < NT));     ENDW(t + 1); RESC(); ROT();
    }
    STEP(pB0, pB1, pA0, pA1, NT - 1, false, false, false); RESC();
    { float sacc = pB0[0] + pB0[1];
#pragma unroll
      for (int r = 2; r < 16; ++r) sacc += pB0[r];
#pragma unroll
      for (int r = 0; r < 16; ++r) sacc += pB1[r];
      l_reg += sacc;
      pw0 = (v4u){PKW(pB0, 0), PKW(pB0, 2), PKW(pB0, 4), PKW(pB0, 6)}; pw1 = (v4u){PKW(pB0, 8), PKW(pB0, 10), PKW(pB0, 12), PKW(pB0, 14)};
      pw2 = (v4u){PKW(pB1, 0), PKW(pB1, 2), PKW(pB1, 4), PKW(pB1, 6)}; pw3 = (v4u){PKW(pB1, 8), PKW(pB1, 10), PKW(pB1, 12), PKW(pB1, 14)};
      ATM_SBAR(); at::pv(o, vb0 + sl_cur * VSL, PAF(0), PAF(1), PAF(2), PAF(3)); }
#undef PKW
#undef PAF
#undef FRA
#undef FRB
#undef PIN
#undef MX3
#undef GAPA
#undef GAPB
#undef EX
#undef VRDA
#undef VRDB
#undef KRD
#undef STEP
#undef ENDW
    { auto rr = __builtin_amdgcn_permlane32_swap(__float_as_uint(l_reg), __float_as_uint(l_reg), false, false); l_reg = __uint_as_float(rr[0]) + __uint_as_float(rr[1]); }
    if (hi == 0) wsf[32 + r32] = l_reg;
    asm volatile("s_waitcnt lgkmcnt(0)" ::: "memory");
    float rli[16];
#pragma unroll
    for (int r = 0; r < 16; ++r) rli[r] = __builtin_amdgcn_rcpf(wsf[32 + crow(r, hi)]);
    bf16* Ow = Oh + (size_t)(q0 + wid * QBLK) * OP;
    { unsigned stgb = (unsigned)(uintptr_t)(shm + LDS_OST) + wid * 4096 + hi * 512 + r32 * 2; asm volatile("" : "+v"(stgb));
      LAS bf16* stg = (LAS bf16*)(shm + LDS_OST) + wid * 2048;
#pragma unroll
      for (int r = 0; r < 16; ++r) {
#pragma unroll
        for (int d0 = 0; d0 < 2; ++d0) *(LAS bf16*)(uintptr_t)(stgb + ((r & 3) + 8 * (r >> 2)) * 128 + d0 * 64) = (bf16)f2bf(o[d0][r] * rli[r]); }
      asm volatile("s_waitcnt lgkmcnt(0)" ::: "memory");
#pragma unroll
      for (int i = 0; i < 4; ++i) { const int row = i * 8 + (lane >> 3), ch = lane & 7; const v4u v = *(const LAS v4u*)(stg + row * 64 + ch * 8); *(v4u*)(Ow + (size_t)row * OP + ch * 8) = v; } }
    asm volatile("s_waitcnt lgkmcnt(0)\n\ts_barrier" ::: "memory");
#undef DMA_K
#undef DMA_V
#undef CMASK
#undef RESC
#undef ROT
}
}

#define XB_TMO      128
#define XB_XCNT(j)  (256  + 64 * (j))
#define XB_XSUB(j)  (1280 + 64 * (j))
#define XB_XGEN(j)  (2304 + 64 * (j))
#define XB_TOP      3328
#define XB_TOPGEN   3392
#define XCD_BAR_WORDS 3456
#define XB_SPIN_CAP (1u << 18)
__device__ __forceinline__ unsigned xb_ld(unsigned* p)              { return __hip_atomic_load(p, __ATOMIC_RELAXED, __HIP_MEMORY_SCOPE_AGENT); }
__device__ __forceinline__ unsigned xb_add(unsigned* p, unsigned v) { return __hip_atomic_fetch_add(p, v, __ATOMIC_RELAXED, __HIP_MEMORY_SCOPE_AGENT); }
__device__ __forceinline__ unsigned xb_xcc_id() { return (unsigned)__builtin_amdgcn_s_getreg((3 << 11) | 20) & 0xFu; }
#define XB_SPIN(cond, bar) do { unsigned _sp = 0; while (cond) { __builtin_amdgcn_s_sleep(1); \
    if ((++_sp & 255u) == 0u) { if (xb_ld(&(bar)[XB_TMO])) break; if (_sp > XB_SPIN_CAP) { atomicAdd(&(bar)[XB_TMO], 1u); break; } } } } while (0)
struct XcdBarrier { unsigned* bar; unsigned x; volatile LAS unsigned* st; };
__device__ __forceinline__ XcdBarrier xcd_barrier_post(unsigned* bar, volatile LAS unsigned* st, const bool leader) {
    XcdBarrier b; b.bar = bar; b.x = xb_xcc_id(); b.st = st;
    if (leader) (void)xb_add(&bar[XB_XCNT(b.x)], 1u);
    return b;
}
__device__ __forceinline__ void xcd_barrier_complete(unsigned* bar, unsigned x, unsigned& nloc, unsigned& nx) {
    const unsigned G = gridDim.x * gridDim.y * gridDim.z;
    unsigned sum, cnt, mine, sp = 0u;
    for (;;) {
        sum = 0u; cnt = 0u; mine = 0u;
#pragma unroll
        for (unsigned j = 0; j < 16; ++j) { const unsigned c = xb_ld(&bar[XB_XCNT(j)]); sum += c; cnt += (c > 0u) ? 1u : 0u; mine = (j == x) ? c : mine; }
        if (sum == G) break;
        __builtin_amdgcn_s_sleep(1);
        if ((++sp & 255u) == 0u) { if (xb_ld(&bar[XB_TMO])) break; if (sp > XB_SPIN_CAP) { atomicAdd(&bar[XB_TMO], 1u); break; } }
    }
    nloc = mine > 0u ? mine : 1u; nx = cnt > 0u ? cnt : 1u;
}
__device__ __forceinline__ void xcd_barrier(const XcdBarrier& b, const bool leader) {
    asm volatile("s_waitcnt vmcnt(0)" ::: "memory");
    __syncthreads();
    if (leader) {
        unsigned* bar = b.bar;
        __builtin_amdgcn_s_waitcnt(0);
        unsigned nloc = b.st[0], nx = b.st[1];
        if (nloc == 0u) { xcd_barrier_complete(bar, b.x, nloc, nx); b.st[0] = nloc; b.st[1] = nx; }
        const unsigned old = xb_add(&bar[XB_XSUB(b.x)], 1u);
        const unsigned gen = old / nloc;
        if (old + 1u == (gen + 1u) * nloc) {
            __builtin_amdgcn_fence(__ATOMIC_RELEASE, "agent");
            asm volatile("s_waitcnt vmcnt(0)" ::: "memory");
            const unsigned og = xb_add(&bar[XB_TOP], 1u);
            const unsigned tg = og / nx;
            if (og + 1u == (tg + 1u) * nx) xb_add(&bar[XB_TOPGEN], 1u);
            else XB_SPIN(xb_ld(&bar[XB_TOPGEN]) == tg, bar);
            __builtin_amdgcn_fence(__ATOMIC_ACQUIRE, "agent");
            xb_add(&bar[XB_XGEN(b.x)], 1u);
            asm volatile("s_waitcnt vmcnt(0)" ::: "memory");
        } else {
            XB_SPIN(xb_ld(&bar[XB_XGEN(b.x)]) == gen, bar);
            __builtin_amdgcn_fence(__ATOMIC_ACQUIRE, "agent");
            asm volatile("s_waitcnt vmcnt(0)" ::: "memory");
        }
    }
    __syncthreads();
}

struct Args { const float* in[19]; float* out; unsigned char* ws; int ph_lo, ph_hi; };
struct Frame { LAS unsigned char* lds; volatile LAS unsigned* MISC; gu32* ctl; int tid, lane, wave, vcu, G; };
#define CAS __attribute__((address_space(4)))
__device__ __forceinline__ Args ld_args() {
    const CAS char* ka = (const CAS char*)__builtin_amdgcn_kernarg_segment_ptr(); asm volatile("" : "+s"(ka));
    Args a;
#pragma unroll
    for (int i = 0; i < 19; ++i) a.in[i] = *(const float* const CAS*)(ka + 8 * i);
    a.out = *(float* const CAS*)(ka + 152); a.ws = *(unsigned char* const CAS*)(ka + 160); a.ph_lo = *(const CAS int*)(ka + 168); a.ph_hi = *(const CAS int*)(ka + 172);
    return a;
}

__device__ __forceinline__ float wave_sum(float v) {
#pragma unroll
    for (int o = 1; o < 64; o <<= 1) v += __shfl_xor(v, o);
    return v;
}
__device__ const double REV_A[16] = {0.15915494309189535, 0.0700865215877985, 0.03086376340470123, 0.013591370636193905, 0.005985185712713705, 0.002635675898667414, 0.001160663641240061, 0.0005111175045375439,
    0.00022507907903927653, 9.911730936901935e-05, 4.364795279280289e-05, 1.9221100684944863e-05, 8.464330808241401e-06, 3.727408601915352e-06, 1.6414262627950345e-06, 7.228293068832865e-07};
__device__ const double REV_B[8] = {0.15915494309189535, 0.03086376340470123, 0.005985185712713705, 0.001160663641240061, 0.00022507907903927653, 4.364795279280289e-05, 8.464330808241401e-06, 1.6414262627950345e-06};

__device__ __forceinline__ void tr_item(const float* W, int N, int k0, int n0s, bf16* WT, int drow0, int ldk, int koff, const float* gain, int mode, LAS float* scr, int lane) {
    float w[32];
#pragma unroll
    for (int i = 0; i < 32; ++i) w[i] = W[(size_t)(k0 + 2 * i + (lane >> 5)) * N + n0s + (lane & 31)];
#pragma unroll
    for (int i = 0; i < 32; ++i) scr[(2 * i + (lane >> 5)) * 33 + (lane & 31)] = w[i];
    LDS_WAIT(); asm volatile("" ::: "memory");
    const int c = lane & 7;
    f32x4 g0 = (f32x4){1.f, 1.f, 1.f, 1.f}, g1 = g0;
    if (gain) { g0 = *(const f32x4*)(gain + k0 + 8 * c); g1 = *(const f32x4*)(gain + k0 + 8 * c + 4); }
#pragma unroll
    for (int j = 0; j < 4; ++j) { const int n = (lane >> 3) + 8 * j;
        int sn = n;
        if (mode == 1) sn = (n < 16) ? ((n & 1) ? (n >> 1) + 8 : (n >> 1)) : n;
        else if (mode == 2) sn = 4 * (n >> 3) + ((n & 7) >> 1) + 16 * (n & 1);
        const LAS float* s = scr + (8 * c) * 33 + sn;
        v4u o; o.x = pk2(s[0 * 33] * g0[0], s[1 * 33] * g0[1]); o.y = pk2(s[2 * 33] * g0[2], s[3 * 33] * g0[3]); o.z = pk2(s[4 * 33] * g1[0], s[5 * 33] * g1[1]); o.w = pk2(s[6 * 33] * g1[2], s[7 * 33] * g1[3]);
        *(GAS v4u*)(WT + (size_t)(drow0 + n) * ldk + koff + k0 + 8 * c) = o; }
    LDS_WAIT(); asm volatile("" ::: "memory");
}

__device__ __forceinline__ void p0_prologue(const Frame& F0, const Args& A) {
    Frame F = F0; F.lane = lane_id(); F.tid = F.wave * 64 + F.lane;
    unsigned char* ws = A.ws;
    LAS float* scr = (LAS float*)(F.lds + F.wave * 16384);
    const int gw = F.vcu * NWAVES + F.wave, NGW = F.G * NWAVES, lane = F.lane;
    bf16* Win = (bf16*)(ws + WS_WIN); bf16* Wuq = (bf16*)(ws + WS_WUQ); bf16* Wukv = (bf16*)(ws + WS_WUKV); bf16* Wo = (bf16*)(ws + WS_WO); bf16* Wout = (bf16*)(ws + WS_WOUT);
    bf16* Wgu = (bf16*)(ws + WS_WGU); bf16* Wd = (bf16*)(ws + WS_WD);
    constexpr int I_IN = 16 * 145, I_UQ = 12 * 24, I_UKV = 4 * 32, I_O = 8 * 32, I_OUT = 16 * 32, I_G = 32 * 128, I_D = 32 * 128;
    constexpr int NITEMS = I_IN + I_UQ + I_UKV + 2 * I_O + I_OUT + 2 * I_G + I_D;
    for (int it = gw; it < NITEMS; it += NGW) {
        int r = it;
        if (r < I_IN) { const int kb = r / 145, nb = r % 145, s0 = 32 * nb; int drow0, mode = 0;
            if (s0 < 1024) drow0 = s0;
            else if (s0 < 1056) { drow0 = 4608; mode = 2; }
            else if (s0 < 1568) { const int j = s0 - 1056; drow0 = 1024 + j; mode = ((j & 63) == 0) ? 1 : 0; }
            else if (s0 < 2080) { const int j = s0 - 1568; drow0 = 1536 + j; mode = ((j & 63) == 0) ? 1 : 0; }
            else if (s0 < 2592) drow0 = 2048 + (s0 - 2080);
            else if (s0 < 3616) { const int j = s0 - 2592; drow0 = 2560 + (j >> 7) * 256 + (j & 127); }
            else { const int j = s0 - 3616; drow0 = 2560 + (j >> 7) * 256 + 128 + (j & 127); }
            tr_item(A.in[2], 4640, 64 * kb, s0, Win, drow0, 1024, 0, nullptr, mode, scr, lane); continue; } r -= I_IN;
        if (r < I_UQ) { const int kb = r / 24, nb = r % 24; tr_item(A.in[4], 768, 64 * kb, 32 * nb, Wuq, 32 * nb, 768, 0, A.in[3], (nb % 3 == 2) ? 2 : 0, scr, lane); continue; } r -= I_UQ;
        if (r < I_UKV) { const int kb = r / 32, nb = r % 32; tr_item(A.in[6], 1024, 64 * kb, 32 * nb, Wukv, 32 * nb, 256, 0, A.in[5], 0, scr, lane); continue; } r -= I_UKV;
        if (r < I_O) { const int kb = r / 32, nb = r % 32; tr_item(A.in[7], 1024, 64 * kb, 32 * nb, Wo, 32 * nb, 1024, 0, nullptr, 0, scr, lane); continue; } r -= I_O;
        if (r < I_O) { const int kb = r / 32, nb = r % 32; tr_item(A.in[8], 1024, 64 * kb, 32 * nb, Wo, 32 * nb, 1024, 512, nullptr, 0, scr, lane); continue; } r -= I_O;
        if (r < I_OUT) { const int kb = r / 32, nb = r % 32; tr_item(A.in[9], 1024, 64 * kb, 32 * nb, Wout, 32 * nb, 1024, 0, nullptr, 0, scr, lane); continue; } r -= I_OUT;
        if (r < 2 * I_G) { const int up = r >= I_G; if (up) r -= I_G; const int e = r >> 7, q = r & 127, kb = q >> 3, nb = q & 7, s0 = 32 * nb;
            const int drow0 = e * 512 + (s0 >> 7) * 256 + up * 128 + (s0 & 127);
            tr_item(A.in[up ? 16 : 15] + (size_t)e * 1024 * 256, 256, 64 * kb, s0, Wgu, drow0, 1024, 0, A.in[10], 0, scr, lane); continue; } r -= 2 * I_G;
        { const int e = r >> 7, q = r & 127, kb = q >> 5, nb = q & 31;
            tr_item(A.in[17] + (size_t)e * 256 * 1024, 1024, 64 * kb, 32 * nb, Wd, e * 1024 + 32 * nb, 256, 0, nullptr, 0, scr, lane); }
    }
    { const int gt = F.vcu * 512 + F.tid, NT_ = F.G * 512; GAS v4u* z = (GAS v4u*)(Win + (size_t)4640 * 1024);
      for (int i = gt; i < 224 * 1024 / 8; i += NT_) z[i] = (v4u){0u, 0u, 0u, 0u}; }
    { const int gt = F.vcu * 512 + F.tid, NT_ = F.G * 512; float* CA = (float*)(ws + WS_COSA); float* SA_ = (float*)(ws + WS_SINA); float* CB = (float*)(ws + WS_COSB); float* SB_ = (float*)(ws + WS_SINB);
      for (int i = gt; i < SEQ * 24; i += NT_) { const int pos = i / 24, j = i % 24; const double rv = (double)pos * (j < 16 ? REV_A[j] : REV_B[j - 16]);
          const float fr = (float)(rv - __builtin_floor(rv)); const float c = __builtin_amdgcn_cosf(fr), s = __builtin_amdgcn_sinf(fr);
          if (j < 16) { CA[pos * 16 + j] = c; SA_[pos * 16 + j] = s; } else { CB[pos * 8 + j - 16] = c; SB_[pos * 8 + j - 16] = s; } } }
    { const float* x = A.in[0]; const float* g = A.in[1]; bf16* XN = (bf16*)(ws + WS_XN);
      f32x4 gv[4];
#pragma unroll
      for (int j = 0; j < 4; ++j) gv[j] = ((const GAS f32x4*)g)[lane + 64 * j];
      for (int m = gw; m < M; m += NGW) { const GAS f32x4* xr = (const GAS f32x4*)(x + (size_t)m * DM) + lane; f32x4 v[4]; float s = 0.f;
#pragma unroll
          for (int j = 0; j < 4; ++j) { v[j] = xr[64 * j]; s += dot4(v[j]); }
          const float rs = 1.f / sqrtf(wave_sum(s) * (1.f / DM) + EPS);
          GAS unsigned long long* o8 = (GAS unsigned long long*)(XN + (size_t)m * DM) + lane;
#pragma unroll
          for (int j = 0; j < 4; ++j) { const f32x4 y = v[j] * rs * gv[j]; o8[64 * j] = (unsigned long long)pk2(y[0], y[1]) | ((unsigned long long)pk2(y[2], y[3]) << 32); } } }
}

__device__ __forceinline__ void moba_select(const Frame& F0, const Args& A) {
    Frame F = F0; F.lane = lane_id(); F.tid = F.wave * 64 + F.lane;
    unsigned char* ws = A.ws; const float* KSUM = (const float*)(ws + WS_KSUM); const bf16* QB = (const bf16*)(ws + WS_QB); unsigned* SEL = (unsigned*)(ws + WS_SEL);
    LAS unsigned char* KMH = F.lds; LAS unsigned char* KML = F.lds + 4096;
    const int lane = F.lane, r32 = lane & 31, hi = lane >> 5, wid = F.wave;
    for (int unit = F.vcu; unit < 512; unit += F.G) { const int bh = unit >> 3, qg = unit & 7, b = bh >> 3, h = bh & 7;
        __syncthreads();
        { const int idx = F.tid * 4, n = idx >> 6, d = idx & 63, pm = b * 32 + n;
          const f32x4 k0 = *(const f32x4*)(KSUM + (size_t)pm * 512 + h * 64 + d), k1 = *(const f32x4*)(KSUM + (size_t)(256 + pm) * 512 + h * 64 + d);
          unsigned hw[4], lw[4];
#pragma unroll
          for (int j = 0; j < 4; ++j) { const float v = (k0[j] + k1[j]) * (1.f / 256.f); hw[j] = f2bf(v); lw[j] = f2bf(v - __builtin_bit_cast(float, hw[j] << 16)); }
          const int off = (d >> 3) * 512 + n * 16 + (d & 7) * 2;
          *(LAS unsigned long long*)(KMH + off) = (unsigned long long)(hw[0] | (hw[1] << 16)) | ((unsigned long long)(hw[2] | (hw[3] << 16)) << 32);
          *(LAS unsigned long long*)(KML + off) = (unsigned long long)(lw[0] | (lw[1] << 16)) | ((unsigned long long)(lw[2] | (lw[3] << 16)) << 32); }
        __syncthreads();
        unsigned msk[4];
#pragma unroll
        for (int p = 0; p < 4; ++p) { const int own = 4 * qg + p; const int s = own * 256 + wid * 32 + r32; unsigned mask;
            if (own < 4) mask = (1u << own) - 1u;
            else {
                const bf16* qrow = QB + ((size_t)b * SEQ + s) * 512 + h * 64;
                f32x16 g = {};
#pragma unroll
                for (int d0 = 0; d0 < 4; ++d0) { const bf16x8 q = *(const bf16x8*)(qrow + d0 * 16 + hi * 8);
                    const bf16x8 kh = *(const LAS bf16x8*)(KMH + (2 * d0 + hi) * 512 + r32 * 16), kl = *(const LAS bf16x8*)(KML + (2 * d0 + hi) * 512 + r32 * 16);
                    g = __builtin_amdgcn_mfma_f32_32x32x16_bf16(kl, q, g, 0, 0, 0); g = __builtin_amdgcn_mfma_f32_32x32x16_bf16(kh, q, g, 0, 0, 0); }
                float v1 = -INFINITY, v2 = -INFINITY, v3 = -INFINITY; int i1 = 99, i2 = 99, i3 = 99;
#pragma unroll
                for (int r = 0; r < 16; ++r) { const int n = (r & 3) + 8 * (r >> 2) + 4 * hi; const float v = (n < own) ? g[r] : -INFINITY;
                    if (v > v1) { v3 = v2; i3 = i2; v2 = v1; i2 = i1; v1 = v; i1 = n; } else if (v > v2) { v3 = v2; i3 = i2; v2 = v; i2 = n; } else if (v > v3) { v3 = v; i3 = n; } }
                float pv_[3] = {__shfl_xor(v1, 32), __shfl_xor(v2, 32), __shfl_xor(v3, 32)}; int pi_[3] = {__shfl_xor(i1, 32), __shfl_xor(i2, 32), __shfl_xor(i3, 32)};
#pragma unroll
                for (int k = 0; k < 3; ++k) { const float v = pv_[k]; const int n = pi_[k];
#define MS_BETTER(va, ia, vb, ib) ((va) > (vb) || ((va) == (vb) && (ia) < (ib)))
                    if (MS_BETTER(v, n, v1, i1)) { v3 = v2; i3 = i2; v2 = v1; i2 = i1; v1 = v; i1 = n; } else if (MS_BETTER(v, n, v2, i2)) { v3 = v2; i3 = i2; v2 = v; i2 = n; } else if (MS_BETTER(v, n, v3, i3)) { v3 = v; i3 = n; } }
#undef MS_BETTER
                mask = (1u << i1) | (1u << i2) | (1u << i3);
            }
            msk[p] = mask;
            if (hi == 0) SEL[(size_t)bh * SEQ + s] = mask; }
        int lp[4][3];
#pragma unroll
        for (int p = 0; p < 4; ++p) { unsigned mm = (hi == 0) ? msk[p] : 0u;
#pragma unroll
            for (int k = 0; k < 3; ++k) { lp[p][k] = 0; if (mm) { const int j = __builtin_ctz(mm); mm &= mm - 1u; lp[p][k] = (int)__hip_atomic_fetch_add((LAS unsigned*)(F.MISC + MI_HIST + j), 1u, __ATOMIC_RELAXED, __HIP_MEMORY_SCOPE_WORKGROUP); } } }
        __syncthreads();
        if (F.tid < 32) { const unsigned n = F.MISC[MI_HIST + F.tid]; F.MISC[MI_BASE + F.tid] = n ? xb_add((unsigned*)(F.ctl + CW_MCNT + bh * 32 + F.tid), n) : 0u; }
        __syncthreads();
        { unsigned short* LQ = (unsigned short*)(ws + WS_LISTQ) + (size_t)bh * LQ_PER_BH;
#pragma unroll
          for (int p = 0; p < 4; ++p) { unsigned mm = (hi == 0) ? msk[p] : 0u; const int s = (4 * qg + p) * 256 + wid * 32 + r32;
#pragma unroll
              for (int k = 0; k < 3; ++k) if (mm) { const int j = __builtin_ctz(mm); mm &= mm - 1u; LQ[256 * (31 * j - j * (j - 1) / 2) + (int)F.MISC[MI_BASE + j] + lp[p][k]] = (unsigned short)s; } } }
        __syncthreads();
        if (F.tid < 32) F.MISC[MI_HIST + F.tid] = 0u;
    }
    __syncthreads();
}

__device__ __forceinline__ void router_phase(const Frame& F0, const Args& A) {
    Frame F = F0; F.lane = lane_id(); F.tid = F.wave * 64 + F.lane;
    unsigned char* ws = A.ws; const bf16* X2H = (const bf16*)(ws + WS_X2B); const bf16* X2Lo = (const bf16*)(ws + WS_X2L); const float* SSQ_X = (const float*)(ws + WS_SSQX);
    const float* gain = A.in[10]; const float* wrg = A.in[11]; const float* brg = A.in[12]; const float* wre = A.in[13]; const float* bre = A.in[14];
    float* TOKW = (float*)(ws + WS_TOKW); float* RS = (float*)(ws + WS_RS); int* LIST = (int*)(ws + WS_LIST); unsigned* CNT = (unsigned*)(F.ctl + CW_CNT);
    LAS float* Wl = (LAS float*)F.lds;
    const int tid = F.tid, lane = F.lane, wid = F.wave, fr = lane & 15, fq = lane >> 4;
    for (int tw = F.vcu; tw < M / 256; tw += F.G) { const int tok0 = tw * 256;
        f32x4 acc[2][3];
#pragma unroll
        for (int a = 0; a < 2; ++a)
#pragma unroll
            for (int b = 0; b < 3; ++b) acc[a][b] = (f32x4){0.f, 0.f, 0.f, 0.f};
        LAS bf16* Wh = (LAS bf16*)F.lds; LAS bf16* Wo = Wh + 48 * 520;
        for (int c2 = 0; c2 < 2 * NREP(6); ++c2) { const int c = c2 & 1;
            __syncthreads();
            { const int k = c * 512 + tid; const float g = gain[k];
#define RT_PUT(n, val) do { const float w_ = (val) * g; const unsigned h_ = f2bf(w_); Wh[(n) * 520 + tid] = (bf16)h_; Wo[(n) * 520 + tid] = (bf16)f2bf(w_ - __builtin_bit_cast(float, h_ << 16)); } while (0)
              const f32x4 w4 = *(const f32x4*)(wrg + (size_t)k * 4);
#pragma unroll
              for (int n = 0; n < 4; ++n) RT_PUT(n, w4[n]);
#pragma unroll
              for (int gi = 0; gi < 4; ++gi) { const f32x4 e0 = *(const f32x4*)(wre + ((size_t)gi * 1024 + k) * 8), e1 = *(const f32x4*)(wre + ((size_t)gi * 1024 + k) * 8 + 4);
#pragma unroll
                  for (int j = 0; j < 4; ++j) { RT_PUT(4 + gi * 8 + j, e0[j]); RT_PUT(4 + gi * 8 + 4 + j, e1[j]); } }
#pragma unroll
              for (int n = 36; n < 48; ++n) { Wh[n * 520 + tid] = 0; Wo[n * 520 + tid] = 0; }
#undef RT_PUT
            }
            __syncthreads();
            const size_t xo0 = (size_t)(tok0 + wid * 32 + fr) * DM + c * 512 + 8 * fq;
#pragma unroll 2
            for (int s = 0; s < 16; ++s) {
                bf16x8 xh[2], xl[2], wh[3], wl[3];
#pragma unroll
                for (int mb = 0; mb < 2; ++mb) { xh[mb] = *(const bf16x8*)(X2H + xo0 + (size_t)mb * 16 * DM + 32 * s);
#if !RES_BF16
                    xl[mb] = *(const bf16x8*)(X2Lo + xo0 + (size_t)mb * 16 * DM + 32 * s);
#endif
                    }
#pragma unroll
                for (int nb = 0; nb < 3; ++nb) { wh[nb] = *(const LAS bf16x8*)(Wh + (16 * nb + fr) * 520 + 32 * s + 8 * fq); wl[nb] = *(const LAS bf16x8*)(Wo + (16 * nb + fr) * 520 + 32 * s + 8 * fq); }
#pragma unroll
                for (int mb = 0; mb < 2; ++mb)
#pragma unroll
                    for (int nb = 0; nb < 3; ++nb) {
#if !RES_BF16
                        acc[mb][nb] = __builtin_amdgcn_mfma_f32_16x16x32_bf16(xl[mb], wh[nb], acc[mb][nb], 0, 0, 0);
#endif
                        acc[mb][nb] = __builtin_amdgcn_mfma_f32_16x16x32_bf16(xh[mb], wl[nb], acc[mb][nb], 0, 0, 0);
                        acc[mb][nb] = __builtin_amdgcn_mfma_f32_16x16x32_bf16(xh[mb], wh[nb], acc[mb][nb], 0, 0, 0); }
            }
        }
        __syncthreads();
#pragma unroll
        for (int mb = 0; mb < 2; ++mb)
#pragma unroll
            for (int nb = 0; nb < 3; ++nb)
#pragma unroll
                for (int i = 0; i < 4; ++i) Wl[(wid * 32 + mb * 16 + 4 * fq + i) * 49 + nb * 16 + fr] = acc[mb][nb][i] * (1.f / NREP(6));
        if (tid < 32) F.MISC[MI_HIST + tid] = 0u;
        __syncthreads();
        int e1 = 0, e2 = 0, lp1 = 0, lp2 = 0; float wt1 = 0.f, wt2 = 0.f;
        if (tid < 256) { const int T = tok0 + tid; const LAS float* lg = Wl + tid * 49;
            const f32x4 q0 = *(const f32x4*)(SSQ_X + (size_t)T * 16), q1 = *(const f32x4*)(SSQ_X + (size_t)T * 16 + 4), q2 = *(const f32x4*)(SSQ_X + (size_t)T * 16 + 8), q3 = *(const f32x4*)(SSQ_X + (size_t)T * 16 + 12);
            float ss = 0.f;
#pragma unroll
            for (int j = 0; j < 4; ++j) ss += q0[j];
#pragma unroll
            for (int j = 0; j < 4; ++j) ss += q1[j];
#pragma unroll
            for (int j = 0; j < 4; ++j) ss += q2[j];
#pragma unroll
            for (int j = 0; j < 4; ++j) ss += q3[j];
            const float rs = 1.f / sqrtf(ss * (1.f / DM) + EPS);
            RS[T] = rs;
            float g0 = lg[0] * rs + brg[0], g1 = lg[1] * rs + brg[1], g2 = lg[2] * rs + brg[2], g3 = lg[3] * rs + brg[3];
            int g = 0; float mx = g0; if (g1 > mx) { mx = g1; g = 1; } if (g2 > mx) { mx = g2; g = 2; } if (g3 > mx) { mx = g3; g = 3; }
            const float pg = 1.f / (__expf(g0 - mx) + __expf(g1 - mx) + __expf(g2 - mx) + __expf(g3 - mx));
            float v1 = -INFINITY, v2 = -INFINITY; int i1 = 0, i2 = 0;
#pragma unroll
            for (int j = 0; j < 8; ++j) { const float v = lg[4 + 8 * g + j] * rs + bre[8 * g + j];
                if (v > v1) { v2 = v1; i2 = i1; v1 = v; i1 = j; } else if (v > v2) { v2 = v; i2 = j; } }
            const float w1 = 1.f / (1.f + __expf(v2 - v1));
            wt1 = pg * w1; wt2 = pg * (1.f - w1); e1 = 8 * g + i1; e2 = 8 * g + i2;
            lp1 = (int)__hip_atomic_fetch_add((LAS unsigned*)(F.MISC + MI_HIST + e1), 1u, __ATOMIC_RELAXED, __HIP_MEMORY_SCOPE_WORKGROUP);
            lp2 = (int)__hip_atomic_fetch_add((LAS unsigned*)(F.MISC + MI_HIST + e2), 1u, __ATOMIC_RELAXED, __HIP_MEMORY_SCOPE_WORKGROUP);
        }
        __syncthreads();
        if (tid < 32) { const unsigned n = F.MISC[MI_HIST + tid]; F.MISC[MI_BASE + tid] = n ? xb_add((unsigned*)&CNT[tid], n) : 0u; }
        __syncthreads();
        if (tid < 256) { const int T = tok0 + tid;
            const int p1 = (int)F.MISC[MI_BASE + e1] + lp1, p2 = (int)F.MISC[MI_BASE + e2] + lp2;
            LIST[(size_t)e1 * LCAP + p1] = 2 * T; LIST[(size_t)e2 * LCAP + p2] = 2 * T + 1;
            TOKW[2 * T] = wt1; TOKW[2 * T + 1] = wt2; }
    }
    __syncthreads();
}

__device__ __forceinline__ void moe_tile_table(const Frame& F0) {
    Frame F = F0; F.lane = lane_id(); F.tid = F.wave * 64 + F.lane;
    __syncthreads();
    if (F.tid == 0) { int acc = 0; for (int e = 0; e < 32; ++e) { F.MISC[MI_TS + e] = (unsigned)acc; const unsigned c = __hip_atomic_load((unsigned*)(F.ctl + CW_CNT + e), RLX_AGENT); acc += (int)((c + 255u) >> 8); } F.MISC[MI_TS + 32] = (unsigned)acc; }
    __syncthreads();
}
__device__ __forceinline__ void gather_phase(const Frame& F0, const Args& A) {
    Frame F = F0; F.lane = lane_id(); F.tid = F.wave * 64 + F.lane;
    unsigned char* ws = A.ws; const int* LIST = (const int*)(ws + WS_LIST);
    int* SLOT_A = (int*)(ws + WS_SLOTA); int* SLOT_TOK = (int*)(ws + WS_SLOTTOK); float* SLOT_RS = (float*)(ws + WS_SLOTRS); const float* RS = (const float*)(ws + WS_RS);
    const int ntile = (int)F.MISC[MI_TS + 32];
    for (int i2 = 0; (long)F.vcu + (long)i2 * F.G < 2L * ntile; i2 += 2) { const long L = (long)F.vcu + (long)(i2 + (F.tid >> 8)) * F.G; if (L >= 2L * ntile) continue; const int st = (int)(L >> 1);
        int e = 0; for (int k = 1; k < 32; ++k) e += (st >= (int)F.MISC[MI_TS + k]) ? 1 : 0;
        const int cnt = (int)__hip_atomic_load((unsigned*)(F.ctl + CW_CNT + e), RLX_AGENT); const int r = F.tid & 255, p = (st - (int)F.MISC[MI_TS + e]) * 256 + r, slot = st * 256 + r;
        int a = -1; float rs = 0.f; if (p < cnt) { a = LIST[(size_t)e * LCAP + p]; rs = RS[a >> 1]; }
        SLOT_A[slot] = a; SLOT_TOK[slot] = a >> 1; SLOT_RS[slot] = rs; }
}
__device__ __forceinline__ void final_phase(const Frame& F0, const Args& A, float* DST) {
    Frame F = F0; F.lane = lane_id(); F.tid = F.wave * 64 + F.lane;
    unsigned char* ws = A.ws; const bf16* X2H = (const bf16*)(ws + WS_X2B); const bf16* X2Lo = (const bf16*)(ws + WS_X2L); const bf16* Y = (const bf16*)(ws + WS_Y); const float* g = A.in[18];
    const int gw = F.vcu * NWAVES + F.wave, NGW = F.G * NWAVES, lane = F.lane;
    f32x4 gv[4];
#pragma unroll
    for (int j = 0; j < 4; ++j) gv[j] = ((const GAS f32x4*)g)[lane + 64 * j];
    for (int m0 = 2 * gw; m0 < M; m0 += 2 * NGW) {
        f32x4 v[2][4]; unsigned long long ya[2][4], yb[2][4], xa[2][4], xb[2][4];
#pragma unroll
        for (int q = 0; q < 2; ++q) { const int m = m0 + q; const GAS unsigned long long* xh_ = (const GAS unsigned long long*)(X2H + (size_t)m * DM) + lane; const GAS unsigned long long* xl_ = (const GAS unsigned long long*)(X2Lo + (size_t)m * DM) + lane;
            const GAS unsigned long long* y0 = (const GAS unsigned long long*)(Y + (size_t)(2 * m) * DM) + lane; const GAS unsigned long long* y1 = (const GAS unsigned long long*)(Y + (size_t)(2 * m + 1) * DM) + lane;
#pragma unroll
            for (int j = 0; j < 4; ++j) { xa[q][j] = xh_[64 * j]; xb[q][j] = RES_BF16 ? 0ull : xl_[64 * j]; ya[q][j] = y0[64 * j]; yb[q][j] = y1[64 * j]; } }
#pragma unroll
        for (int q = 0; q < 2; ++q) { const int m = m0 + q; float s = 0.f;
#pragma unroll
            for (int j = 0; j < 4; ++j) { const unsigned long long a = ya[q][j], b = yb[q][j], xh8 = xa[q][j], xl8 = xb[q][j];
                const unsigned al = (unsigned)a, ah = (unsigned)(a >> 32), bl = (unsigned)b, bh = (unsigned)(b >> 32), hl = (unsigned)xh8, hh = (unsigned)(xh8 >> 32), ll = (unsigned)xl8, lh = (unsigned)(xl8 >> 32);
                v[q][j] = (f32x4){bflo(hl) + bflo(ll), bfhi(hl) + bfhi(ll), bflo(hh) + bflo(lh), bfhi(hh) + bfhi(lh)};
                v[q][j][0] = (v[q][j][0] + bflo(al)) + bflo(bl); v[q][j][1] = (v[q][j][1] + bfhi(al)) + bfhi(bl); v[q][j][2] = (v[q][j][2] + bflo(ah)) + bflo(bh); v[q][j][3] = (v[q][j][3] + bfhi(ah)) + bfhi(bh);
                s += dot4(v[q][j]); }
            float rs = 1.f / sqrtf(wave_sum(s) * (1.f / DM) + EPS);
#if CHECK
            { const float es = __hip_atomic_load((float*)(F.ctl + CW_ERR), RLX_AGENT), ec = __hip_atomic_load((float*)(F.ctl + CW_ERR + 1), RLX_AGENT); rs *= 1.f + CHK_GAIN * (ec > 0.f ? es / ec : 1.f); }
#endif
            GAS f32x4* dr = (GAS f32x4*)(DST + (size_t)m * DM) + lane;
#pragma unroll
            for (int j = 0; j < 4; ++j) dr[64 * j] = v[q][j] * rs * gv[j]; } }
}

#if CHECK
__device__ __forceinline__ float blk_sum(Frame& F, float v, LAS float* red) { v = wave_sum(v); __syncthreads(); if (F.lane == 0) red[F.wave] = v; __syncthreads(); float t = 0.f; for (int i = 0; i < 8; ++i) t += red[i]; return t; }
__device__ __forceinline__ float blk_max(Frame& F, float v, LAS float* red) {
#pragma unroll
    for (int o = 1; o < 64; o <<= 1) v = fmaxf(v, __shfl_xor(v, o));
    __syncthreads(); if (F.lane == 0) red[F.wave] = v; __syncthreads(); float t = red[0]; for (int i = 1; i < 8; ++i) t = fmaxf(t, red[i]); return t; }
__device__ __forceinline__ void err_add(Frame& F, int group, float num2, float den2, LAS float* red) {
    const float n = blk_sum(F, num2, red), d = blk_sum(F, den2, red);
    if (F.tid == 0 && ((CHK_GROUPS >> group) & 1)) { float e = sqrtf(n / (d + 1e-20f)); e = fminf(e, 1.f); if (!(e == e)) e = 1.f; atomicAdd((float*)(F.ctl + CW_ERR), e); atomicAdd((float*)(F.ctl + CW_ERR + 1), 1.f); } }
__device__ __forceinline__ float bfv(const bf16* p) { return __builtin_bit_cast(float, ((unsigned)*p) << 16); }
__device__ __forceinline__ int posA(int j) { const int i = j & 15, odd = j >> 4; return 8 * (i >> 2) + 2 * (i & 3) + odd; }
__device__ __forceinline__ int posB(int d) { if (d >= 16) return d; const int i = d & 7, odd = d >> 3; return 8 * (i >> 2) + 2 * (i & 3) + odd; }
__device__ __forceinline__ unsigned hash32(unsigned x) { x ^= x >> 16; x *= 0x7feb352du; x ^= x >> 15; x *= 0x846ca68bu; x ^= x >> 16; return x; }
__device__ __forceinline__ void cs_pow(double theta, int pos, double& c, double& s) {
    double t2 = theta * theta, ct = 1.0, st = theta, term = 1.0;
    for (int k = 1; k <= 12; ++k) { term *= -t2 / ((2.0 * k - 1.0) * (2.0 * k)); ct += term; }
    term = theta; for (int k = 1; k <= 12; ++k) { term *= -t2 / ((2.0 * k) * (2.0 * k + 1.0)); st += term; }
    double rc = 1.0, rs = 0.0, bc = ct, bs = st;
    for (int b = 0; b < 13; ++b) { if ((pos >> b) & 1) { const double nc = rc * bc - rs * bs, ns = rc * bs + rs * bc; rc = nc; rs = ns; } const double c2 = bc * bc - bs * bs, s2 = 2.0 * bc * bs; bc = c2; bs = s2; }
    c = rc; s = rs;
}
__device__ __forceinline__ void check_proj_row(const Frame& F0, const Args& A, int m) {
    Frame F = F0; F.lane = lane_id(); F.tid = F.wave * 64 + F.lane;
    unsigned char* ws = A.ws; LAS float* L = (LAS float*)F.lds; LAS float* hrow = L; LAS float* proj = L + 1024; LAS float* tmp = L + 5664; LAS float* outv = L + 6688; LAS float* red = L + 7712;
    const int tid = F.tid, pos = m & (SEQ - 1);
    const float* x = A.in[0] + (size_t)m * DM;
    float ss = 0.f; for (int k = tid; k < DM; k += 512) ss += x[k] * x[k];
    ss = blk_sum(F, ss, red); { const float rs = 1.f / sqrtf(ss / DM + EPS); for (int k = tid; k < DM; k += 512) hrow[k] = x[k] * rs * A.in[1][k]; }
    __syncthreads();
    for (int c = tid; c < 4640; c += 512) { float a = 0.f; for (int k = 0; k < DM; ++k) a += hrow[k] * A.in[2][(size_t)k * 4640 + c]; proj[c] = a; }
    __syncthreads();
    const float* CA = (const float*)(ws + WS_COSA); const float* SA_ = (const float*)(ws + WS_SINA); const float* CB = (const float*)(ws + WS_COSB); const float* SB_ = (const float*)(ws + WS_SINB);
    { float n2 = 0.f, d2 = 0.f; if (tid < 24) { const int j = tid; double c, s_; cs_pow(6.283185307179586 * (j < 16 ? REV_A[j] : REV_B[j - 16]), pos, c, s_);
          const float tc = j < 16 ? CA[pos * 16 + j] : CB[pos * 8 + j - 16], ts = j < 16 ? SA_[pos * 16 + j] : SB_[pos * 8 + j - 16];
          n2 = (tc - (float)c) * (tc - (float)c) + (ts - (float)s_) * (ts - (float)s_); d2 = 1.f; }
      err_add(F, 0, n2, d2, red); }
    { float q2 = 0.f; for (int k = tid; k < QL; k += 512) q2 += proj[k] * proj[k]; q2 = blk_sum(F, q2, red); const float rs = 1.f / sqrtf(q2 / QL + EPS);
      for (int k = tid; k < QL; k += 512) tmp[k] = proj[k] * rs * A.in[3][k];
      __syncthreads();
      for (int c = tid; c < QL; c += 512) { float a = 0.f; for (int k = 0; k < QL; ++k) a += tmp[k] * A.in[4][(size_t)k * QL + c]; outv[c] = a; }
      __syncthreads();
      const bf16* QA = (const bf16*)(ws + WS_QA) + (size_t)m * QL; float n2 = 0.f, d2 = 0.f;
      for (int c = tid; c < QL; c += 512) { const int hh = c / 96, d = c % 96; float ref; int sp;
          if (d < 64) { ref = outv[c]; sp = d; }
          else { const int j = d - 64, i = j & 15; double cc, sn; cs_pow(6.283185307179586 * REV_A[i], pos, cc, sn); const float x1 = outv[hh * 96 + 64 + i], x2 = outv[hh * 96 + 80 + i];
              ref = (j < 16) ? x1 * (float)cc - x2 * (float)sn : x2 * (float)cc + x1 * (float)sn; sp = 64 + posA(j); }
          ref *= C2A; const float got = bfv(QA + hh * 96 + sp); n2 += (got - ref) * (got - ref); d2 += ref * ref; }
      err_add(F, 1, n2, d2, red); }
    { float q2 = 0.f; for (int k = tid; k < KVL; k += 512) q2 += proj[768 + k] * proj[768 + k]; q2 = blk_sum(F, q2, red); const float rs = 1.f / sqrtf(q2 / KVL + EPS);
      for (int k = tid; k < KVL; k += 512) tmp[k] = proj[768 + k] * rs * A.in[5][k];
      __syncthreads();
      for (int c = tid; c < DM; c += 512) { float a = 0.f; for (int k = 0; k < KVL; ++k) a += tmp[k] * A.in[6][(size_t)k * DM + c]; outv[c] = a; }
      __syncthreads();
      const bf16* KV = (const bf16*)(ws + WS_KV) + (size_t)m * DM; float n2 = 0.f, d2 = 0.f;
      for (int c = tid; c < DM; c += 512) { const float ref = outv[c], got = bfv(KV + c); n2 += (got - ref) * (got - ref); d2 += ref * ref; }
      err_add(F, 2, n2, d2, red); }
    { const bf16* KR = (const bf16*)(ws + WS_KR) + (size_t)m * 32; float n2 = 0.f, d2 = 0.f;
      if (tid < 32) { const int j = tid, i = j & 15; double cc, sn; cs_pow(6.283185307179586 * REV_A[i], pos, cc, sn); const float x1 = proj[1024 + i], x2 = proj[1040 + i];
          const float ref = (j < 16) ? x1 * (float)cc - x2 * (float)sn : x2 * (float)cc + x1 * (float)sn; const float got = bfv(KR + posA(j)); n2 = (got - ref) * (got - ref); d2 = ref * ref; }
      err_add(F, 3, n2, d2, red); }
    for (int w = 0; w < 3; ++w) { const bf16* O = (const bf16*)(ws + (w == 0 ? WS_QB : w == 1 ? WS_KB : WS_VB)) + (size_t)m * 512; const int base = (w == 0) ? 1056 : (w == 1) ? 1568 : 2080; float n2 = 0.f, d2 = 0.f;
        { const int c = tid; const int hh = c >> 6, d = c & 63; float ref; int sp = d;
          if (w < 2 && d < 16) { const int i = d & 7; double cc, sn; cs_pow(6.283185307179586 * REV_B[i], pos, cc, sn); const float x1 = proj[base + hh * 64 + i], x2 = proj[base + hh * 64 + 8 + i];
              ref = (d < 8) ? x1 * (float)cc - x2 * (float)sn : x2 * (float)cc + x1 * (float)sn; sp = posB(d); }
          else ref = proj[base + c];
          if (w == 0) ref *= C2B;
          const float got = bfv(O + hh * 64 + sp); n2 = (got - ref) * (got - ref); d2 = ref * ref; }
        err_add(F, 4 + w, n2, d2, red); }
    for (int w = 0; w < 2; ++w) { const bf16* O = (const bf16*)(ws + (w == 0 ? WS_SA : WS_SB)) + (size_t)m * DM; float n2 = 0.f, d2 = 0.f;
        for (int c = tid; c < DM; c += 512) { const float sa = 1.f / (1.f + __expf(-proj[2592 + c])), sb = 1.f / (1.f + __expf(-proj[3616 + c])); const float ref = (w == 0) ? sa / sb : sb, got = bfv(O + c); n2 += (got - ref) * (got - ref); d2 += ref * ref; }
        err_add(F, 7 + w, n2, d2, red); }
    __syncthreads();
}
__device__ __forceinline__ void check_attn_row(const Frame& F0, const Args& A, int type, int b, int h, int s) {
    Frame F = F0; F.lane = lane_id(); F.tid = F.wave * 64 + F.lane;
    unsigned char* ws = A.ws; LAS float* L = (LAS float*)F.lds; LAS float* sc = L; LAS float* q = L + 8192; LAS float* km = L + 8320; LAS float* part = L + 10400; LAS float* red = L + 10944; LAS float* gate = L + 10960; LAS unsigned* msk = (LAS unsigned*)(L + 11000);
    const int tid = F.tid; const size_t rb = (size_t)b * SEQ; const int own = s >> 8;
    const bf16* QA = (const bf16*)(ws + WS_QA); const bf16* KV = (const bf16*)(ws + WS_KV); const bf16* KR = (const bf16*)(ws + WS_KR);
    const bf16* QB = (const bf16*)(ws + WS_QB); const bf16* KB = (const bf16*)(ws + WS_KB); const bf16* VB = (const bf16*)(ws + WS_VB); const bf16* OAB = (const bf16*)(ws + WS_OAB);
    __syncthreads();
    if (type == 0) { if (tid < 96) q[tid] = bfv(QA + (rb + s) * QL + h * 96 + tid); }
    else { if (tid < 64) q[tid] = bfv(QB + (rb + s) * 512 + h * 64 + tid); }
    __syncthreads();
    unsigned mask = 0xffffffffu;
    if (type == 1) {
        { const int d = tid & 63, g = tid >> 6; for (int n = g; n < own; n += 8) { float a = 0.f; for (int r = 0; r < 256; ++r) a += bfv(KB + (rb + n * 256 + r) * 512 + h * 64 + d); km[n * 64 + d] = a * (1.f / 256.f); } }
        __syncthreads();
        if (tid < own) { float a = 0.f; for (int d = 0; d < 64; ++d) a += q[d] * km[tid * 64 + d]; gate[tid] = a; }
        __syncthreads();
        if (tid == 0) { unsigned mk = 0u; if (own < 4) mk = (1u << own) - 1u; else { for (int r = 0; r < 3; ++r) { float bv = -INFINITY; int bi = 0; for (int n = 0; n < own; ++n) if (!((mk >> n) & 1u) && gate[n] > bv) { bv = gate[n]; bi = n; } mk |= 1u << bi; } }
            msk[0] = mk | (1u << own); }
        __syncthreads();
        mask = msk[0];
    }
    float mx = -INFINITY;
    for (int j = tid; j <= s; j += 512) { float a = -INFINITY;
        if ((mask >> (j >> 8)) & 1u) { a = 0.f;
            if (type == 0) { for (int d = 0; d < 64; ++d) a += q[d] * bfv(KV + (rb + j) * DM + h * 128 + d); for (int d = 0; d < 32; ++d) a += q[64 + d] * bfv(KR + (rb + j) * 32 + d); }
            else { for (int d = 0; d < 64; ++d) a += q[d] * bfv(KB + (rb + j) * 512 + h * 64 + d); } }
        sc[j] = a; mx = fmaxf(mx, a); }
    mx = blk_max(F, mx, red);
    float l = 0.f; for (int j = tid; j <= s; j += 512) { const float p = exp2f(sc[j] - mx); sc[j] = p; l += p; }
    l = blk_sum(F, l, red);
    { const int d = tid & 63, g = tid >> 6; float a = 0.f;
      for (int j = g; j <= s; j += 8) { const float p = sc[j]; if (p != 0.f) a += p * (type == 0 ? bfv(KV + (rb + j) * DM + h * 128 + 64 + d) : bfv(VB + (rb + j) * 512 + h * 64 + d)); }
      part[g * 64 + d] = a; }
    __syncthreads();
    float n2 = 0.f, d2 = 0.f;
    if (tid < 64) { float a = 0.f; for (int g = 0; g < 8; ++g) a += part[g * 64 + tid]; const float ref = a / l; const float got = bfv(OAB + (rb + s) * DM + type * 512 + h * 64 + tid); n2 = (got - ref) * (got - ref); d2 = ref * ref; }
    err_add(F, type, n2, d2, red);
    __syncthreads();
}
__device__ __forceinline__ void check_mix_row(const Frame& F0, const Args& A, int m) {
    Frame F = F0; F.lane = lane_id(); F.tid = F.wave * 64 + F.lane;
    unsigned char* ws = A.ws; LAS float* L = (LAS float*)F.lds; LAS float* orow = L; LAS float* mix = L + 1024; LAS float* red = L + 2048; const int tid = F.tid;
    const bf16* OAB = (const bf16*)(ws + WS_OAB) + (size_t)m * DM; const bf16* SAp = (const bf16*)(ws + WS_SA) + (size_t)m * DM; const bf16* SBp = (const bf16*)(ws + WS_SB) + (size_t)m * DM; const bf16* MIX = (const bf16*)(ws + WS_MIX) + (size_t)m * DM;
    __syncthreads();
    for (int k = tid; k < DM; k += 512) orow[k] = bfv(OAB + k);
    __syncthreads();
    float n2 = 0.f, d2 = 0.f;
    for (int c = tid; c < DM; c += 512) { float a1 = 0.f, a2 = 0.f; for (int k = 0; k < 512; ++k) { a1 += orow[k] * A.in[7][(size_t)k * DM + c]; a2 += orow[512 + k] * A.in[8][(size_t)k * DM + c]; }
        const float ref = bfv(SBp + c) * (bfv(SAp + c) * a1 + a2), got = bfv(MIX + c); mix[c] = got; n2 += (got - ref) * (got - ref); d2 += ref * ref; }
    err_add(F, 0, n2, d2, red);
    n2 = 0.f; d2 = 0.f;
    for (int c = tid; c < DM; c += 512) { float a = 0.f; for (int k = 0; k < DM; ++k) a += mix[k] * A.in[9][(size_t)k * DM + c];
        const float ref = A.in[0][(size_t)m * DM + c] + a, got = bfv((const bf16*)(ws + WS_X2B) + (size_t)m * DM + c) + bfv((const bf16*)(ws + WS_X2L) + (size_t)m * DM + c); n2 += (got - ref) * (got - ref); d2 += a * a; }
    err_add(F, 1, n2, d2, red);
    __syncthreads();
}
#endif

__device__ __forceinline__ void moba_combine(const Frame& F0, const Args& A) {
    Frame F = F0; F.lane = lane_id(); F.tid = F.wave * 64 + F.lane;
    unsigned char* ws = A.ws; const bf16* PO = (const bf16*)A.out; const float* PML = (const float*)(ws + WS_PML); const unsigned* SEL = (const unsigned*)(ws + WS_SEL); bf16* OAB = (bf16*)(ws + WS_OAB);
    const int gw = F.vcu * NWAVES + F.wave, NGW = F.G * NWAVES, lane = F.lane, ch = lane & 7;
    for (int task = gw; task < 65536 * REP_MOBA_B; task += NGW) { const int tk = task & 65535; const long qh = (long)tk * 8 + (lane >> 3); const int bh = (int)(qh >> 13), sq = (int)(qh & (SEQ - 1)), b = bh >> 3, h = bh & 7;
        const unsigned sel = SEL[qh]; const int np = __builtin_popcount(sel);
        float mi[4], li[4]; v4u oi[4];
#pragma unroll
        for (int k = 0; k < 4; ++k) { mi[k] = -1e30f; li[k] = 0.f; oi[k] = (v4u){0u, 0u, 0u, 0u};
            if (k == 3 || k < np) { mi[k] = PML[(qh * 4 + k) * 2]; li[k] = PML[(qh * 4 + k) * 2 + 1]; oi[k] = *(const v4u*)(PO + (size_t)(qh * 4 + k) * 64 + ch * 8); } }
        const float mmax = fmaxf(fmaxf(mi[0], mi[1]), fmaxf(mi[2], mi[3]));
        float wk[4], wsum = 0.f;
#pragma unroll
        for (int k = 0; k < 4; ++k) { wk[k] = li[k] * __builtin_amdgcn_exp2f(mi[k] - mmax); wsum += wk[k]; }
        const float inv = 1.f / wsum;
        float r8[8] = {0.f, 0.f, 0.f, 0.f, 0.f, 0.f, 0.f, 0.f};
#pragma unroll
        for (int k = 0; k < 4; ++k) { const v4u u = oi[k]; r8[0] += wk[k] * bflo(u.x); r8[1] += wk[k] * bfhi(u.x); r8[2] += wk[k] * bflo(u.y); r8[3] += wk[k] * bfhi(u.y);
            r8[4] += wk[k] * bflo(u.z); r8[5] += wk[k] * bfhi(u.z); r8[6] += wk[k] * bflo(u.w); r8[7] += wk[k] * bfhi(u.w); }
        v4u w; w.x = cvt_pk_bf16(r8[0] * inv, r8[1] * inv); w.y = cvt_pk_bf16(r8[2] * inv, r8[3] * inv); w.z = cvt_pk_bf16(r8[4] * inv, r8[5] * inv); w.w = cvt_pk_bf16(r8[6] * inv, r8[7] * inv);
        *(v4u*)(OAB + ((size_t)b * SEQ + sq) * DM + 512 + h * 64 + ch * 8) = w; }
}

__global__ void __launch_bounds__(NWAVES * 64, 2) mk_fwd(Args kargs) {
    extern __shared__ __attribute__((aligned(16))) unsigned char lds[];
    Frame F;
    F.lds = (LAS unsigned char*)lds; F.MISC = (volatile LAS unsigned*)(F.lds + MISC_OFF);
    F.wave = __builtin_amdgcn_readfirstlane((int)threadIdx.x >> 6); F.lane = lane_id(); F.tid = F.wave * 64 + F.lane;
    F.G = gridDim.x; { const int bx = blockIdx.x; F.vcu = (F.G % 8 == 0) ? (bx % 8) * (F.G / 8) + bx / 8 : bx; }
    F.ctl = (gu32*)(ld_args().ws + WS_CTL);
    for (int u = F.tid; u < (LDS_BYTES - LDSCTL_OFF) / 4; u += NWAVES * 64) ((LAS unsigned*)(F.lds + LDSCTL_OFF))[u] = 0u;
    __syncthreads();
    XcdBarrier bar = xcd_barrier_post((unsigned*)(F.ctl + CW_BAR), F.MISC + 8, F.wave == 0 && lane_id() == 0);
    int lo, hi; { const Args a0 = ld_args(); lo = a0.ph_lo; hi = a0.ph_hi; }
#ifndef PH_MASK
#define PH_MASK 0x7ff
#endif
#define IN(k) (((PH_MASK >> (k)) & 1) && lo <= (k) && (k) < hi)
#define SEAM(k) do { if (IN(k) && IN((k) + 1)) xcd_barrier(bar, F.wave == 0 && lane_id() == 0); } while (0)
#define PB(off) ((bf16*)(ws + (off)))
#define PF(off) ((float*)(ws + (off)))
#define XN PB(WS_XN)
#define CQ PB(WS_CQ)
#define CKV PB(WS_CKV)
#define KR PB(WS_KR)
#define QBp PB(WS_QB)
#define KBp PB(WS_KB)
#define VBp PB(WS_VB)
#define SAp PB(WS_SA)
#define SBp PB(WS_SB)
#define QA PB(WS_QA)
#define KV PB(WS_KV)
#define OAB PB(WS_OAB)
#define MIX PB(WS_MIX)
#define X2B PB(WS_X2B)
#define XG PB(WS_XG)
#define Hb PB(WS_H)
#define Yb PB(WS_Y)
#define SSQ_Q PF(WS_SSQQ)
#define SSQ_KV PF(WS_SSQKV)
#define SSQ_X PF(WS_SSQX)
#define KSUM PF(WS_KSUM)
#define COSA PF(WS_COSA)
#define SINA PF(WS_SINA)
#define COSB PF(WS_COSB)
#define SINB PF(WS_SINB)
    if (IN(0)) { const Args args = ld_args(); for (int rep = 0; rep < NREP(0); ++rep) p0_prologue(F, args); } SEAM(0);

    if (IN(1)) { const Args args = ld_args(); unsigned char* ws = args.ws;
        pg8::Gemm g{XN, (const bf16*)(ws + WS_WIN), DM, DM, DM, 0}; pg8::SchedGrid S; S.init(M / 256, NPROJ / 256, F.G, (int)blockIdx.x, DM, DM, NREP(1), WGM_P1);
        pg8::EpiProj E{CQ, CKV, KR, QBp, KBp, VBp, SAp, SBp, SSQ_Q, SSQ_KV, KSUM, COSA, SINA, COSB, SINB};
        pg8::gemm_phase(F.lds, g, S, E, F.wave);
#ifdef P1_EXTRA_PLAIN
        { pg8::SchedGrid S2; S2.init(M / 256, NPROJ / 256, F.G, (int)blockIdx.x, DM, DM, 1, WGM_P1); pg8::EpiPlain E2{(bf16*)(ws + 976 * MiB)}; pg8::gemm_phase(F.lds, g, S2, E2, F.wave); }
#endif
    } SEAM(1);

    if (IN(2)) { const Args args = ld_args(); unsigned char* ws = args.ws;
        { pg8::Gemm g{CQ, (const bf16*)(ws + WS_WUQ), QL, QL, QL, 0}; pg8::SchedGrid S; S.init(M / 256, QL / 256, F.G, (int)blockIdx.x, QL, QL, NREP(2), WGM_O);
          pg8::EpiQ E{QA, SSQ_Q, COSA, SINA}; pg8::gemm_phase(F.lds, g, S, E, F.wave); }
        { pg8::Gemm g{CKV, (const bf16*)(ws + WS_WUKV), KVL, KVL, KVL, 0}; pg8::SchedGrid S; S.init(M / 256, DM / 256, F.G, (int)blockIdx.x, KVL, KVL, NREP(2), WGM_O);
          pg8::EpiKV E{KV, SSQ_KV}; pg8::gemm_phase(F.lds, g, S, E, F.wave); }
        for (int rep = 0; rep < NREP(11); ++rep) moba_select(F, args);
    } SEAM(2);
#if CHECK == 2
    if (IN(2)) { const Args args = ld_args();
#pragma unroll 1
        for (int i = 0; i < 3; ++i) { const unsigned hsh = hash32((unsigned)(F.vcu * 3 + i) + 12345u); int m = (int)(hsh % (unsigned)M); if (i == 0) m = (m & ~(SEQ - 1)) | (hsh >> 20 & 255) * 32 | (m & 31); check_proj_row(F, args, m); } xcd_barrier(bar, F.wave == 0 && lane_id() == 0); }
#endif

    if (IN(3)) { const Args args = ld_args(); unsigned char* ws = args.ws;
        const unsigned* SEL = (const unsigned*)(ws + WS_SEL);
        bf16* PO = (bf16*)args.out; float* PML = (float*)(ws + WS_PML);
        for (int qd = F.vcu; qd < 512; qd += F.G) { const int s = qd & 7, bh = (qd >> 3) & 63, b = bh >> 3, h = bh & 7; const size_t rb = (size_t)b * SEQ;
#pragma unroll 1
            for (int i = 0; i < 4 * REP_MLA; ++i) { const int i4 = i & 3; const int qb = (i4 == 0) ? s : (i4 == 1) ? 15 - s : (i4 == 2) ? 16 + s : 31 - s;
#if MLA_TUNED
                atm::attn_unit_mla<8>(qb, QA + rb * QL + h * 96, KV + rb * DM + h * 128, KR + rb * 32, KV + rb * DM + h * 128 + 64, OAB + rb * DM + h * 64, (LAS char*)F.lds, F.wave);
#else
                at::attn_unit<96, 0>(qb, QA + rb * QL + h * 96, QL, KV + rb * DM + h * 128, DM, KR + rb * 32, KV + rb * DM + h * 128 + 64, DM, OAB + rb * DM + h * 64, DM, at::MobaX{nullptr, nullptr, 0, 0, nullptr, nullptr, 0}, (LAS char*)F.lds, F.wave);
#endif
            } }
#ifndef ONLY_MLA
        { F.lane = lane_id(); F.tid = F.wave * 64 + F.lane; LAS int* PRE = (LAS int*)(F.lds + 102400); LAS int* WSUM = (LAS int*)(F.lds + 102400 + 8704);
#define MB_NCH(c) ({ const int n_ = (int)((((c) + 31u) >> 5) + 63u) >> 6; n_ < 1 ? 1 : n_; })
          int v0, v1, v2, v3;
          { const int i0 = 4 * F.tid;
              v0 = MB_NCH(__hip_atomic_load((unsigned*)(F.ctl + CW_MCNT + ((i0 + 0) & 63) * 32 + ((i0 + 0) >> 6)), RLX_AGENT));
              v1 = MB_NCH(__hip_atomic_load((unsigned*)(F.ctl + CW_MCNT + ((i0 + 1) & 63) * 32 + ((i0 + 1) >> 6)), RLX_AGENT));
              v2 = MB_NCH(__hip_atomic_load((unsigned*)(F.ctl + CW_MCNT + ((i0 + 2) & 63) * 32 + ((i0 + 2) >> 6)), RLX_AGENT));
              v3 = MB_NCH(__hip_atomic_load((unsigned*)(F.ctl + CW_MCNT + ((i0 + 3) & 63) * 32 + ((i0 + 3) >> 6)), RLX_AGENT)); }
          const int loc = v0 + v1 + v2 + v3; int inc = loc;
#pragma unroll
          for (int o = 1; o < 64; o <<= 1) { const int t = __shfl_up(inc, o); if (F.lane >= o) inc += t; }
          __syncthreads();
          if (F.lane == 63) WSUM[F.wave] = inc;
          __syncthreads();
          int woff = 0; for (int w = 0; w < F.wave; ++w) woff += WSUM[w];
          const int excl = inc - loc + woff;
          PRE[4 * F.tid] = excl; PRE[4 * F.tid + 1] = excl + v0; PRE[4 * F.tid + 2] = excl + v0 + v1; PRE[4 * F.tid + 3] = excl + v0 + v1 + v2;
          if (F.tid == 511) PRE[2048] = excl + loc;
          __syncthreads();
          const int total = PRE[2048];
          const unsigned short* LQ = (const unsigned short*)(ws + WS_LISTQ);
#pragma unroll 1
          for (;;) {
              __syncthreads();
              if (F.tid == 0) F.MISC[12] = xb_add((unsigned*)(F.ctl + CW_TICKET), 1u);
              __syncthreads();
              const int k = (int)F.MISC[12]; if (k >= total * REP_MOBA_A) break;
              const int kk = (k >= total) ? k - total : k; int lo_ = 0, hi_ = 2048;
              while (lo_ < hi_) { const int mid = (lo_ + hi_) >> 1; if (PRE[mid + 1] <= kk) lo_ = mid + 1; else hi_ = mid; }
              const int idx = lo_, j = idx >> 6, bh = idx & 63, b = bh >> 3, h = bh & 7, ch = kk - PRE[idx]; const size_t rb = (size_t)b * SEQ;
              const int lcnt = (j < 31) ? (int)__hip_atomic_load((unsigned*)(F.ctl + CW_MCNT + bh * 32 + j), RLX_AGENT) : 0;
              const int ng = (lcnt + 31) >> 5; int nch = (ng + 63) >> 6; if (nch < 1) nch = 1; const int gpc = (ng + nch - 1) / nch, g0 = ch * gpc, g1 = (g0 + gpc < ng) ? g0 + gpc : ng;
              at::moba_block(j, QBp + rb * 512 + h * 64, KBp + rb * 512 + h * 64, VBp + rb * 512 + h * 64,
                  at::MobaX{SEL + (size_t)bh * SEQ, LQ + (size_t)bh * LQ_PER_BH + 256 * (31 * j - j * (j - 1) / 2), lcnt, 0, PO, PML, (long)bh * SEQ}, g0, g1, ch == 0, (LAS char*)F.lds, F.wave); } }
        xcd_barrier(bar, F.wave == 0 && lane_id() == 0);
        moba_combine(F, args);
#endif
    } SEAM(3);
#if CHECK == 1
    if (IN(3)) { const Args args = ld_args();
#pragma unroll 1
        for (int i = 0; i < 8; ++i) { const unsigned hsh = hash32((unsigned)(F.vcu * 8 + i) + 777u); const int type = i & 1, b = (hsh >> 3) & 7, h = hsh & 7; int sq = (hsh >> 8) & (SEQ - 1); if (i >= 6) sq &= 1023;
            check_attn_row(F, args, type, b, h, sq); } xcd_barrier(bar, F.wave == 0 && lane_id() == 0); }
#endif

    if (IN(4)) { const Args args = ld_args(); unsigned char* ws = args.ws;
        pg8::Gemm g{OAB, (const bf16*)(ws + WS_WO), 512, DM, DM, 0}; pg8::SchedMix S; S.g.init(M / 256, DM / 256, F.G, (int)blockIdx.x, DM, DM, NREP(4), WGM_O);
        pg8::EpiMix E{MIX, SAp, SBp}; pg8::gemm_phase(F.lds, g, S, E, F.wave);
    } SEAM(4);

    if (IN(5)) { const Args args = ld_args(); unsigned char* ws = args.ws;
        pg8::Gemm g{MIX, (const bf16*)(ws + WS_WOUT), DM, DM, DM, 0}; pg8::SchedGrid S; S.init(M / 256, DM / 256, F.G, (int)blockIdx.x, DM, DM, NREP(5), WGM_O);
        pg8::EpiOut E{args.in[0], PB(WS_X2L), X2B, SSQ_X}; pg8::gemm_phase(F.lds, g, S, E, F.wave);
    } SEAM(5);
#if CHECK == 3
    if (IN(5)) { const Args args = ld_args();
#pragma unroll 1
        for (int i = 0; i < 2; ++i) { const unsigned hsh = hash32((unsigned)(F.vcu * 2 + i) + 4242u); check_mix_row(F, args, (int)(hsh % (unsigned)M)); } xcd_barrier(bar, F.wave == 0 && lane_id() == 0); }
#endif

    if (IN(6)) { const Args args = ld_args(); router_phase(F, args); } SEAM(6);

    if (IN(8)) { const Args args = ld_args(); unsigned char* ws = args.ws;
        moe_tile_table(F); gather_phase(F, args);
        asm volatile("s_waitcnt vmcnt(0)" ::: "memory"); __syncthreads();
        pg8::Gemm g{X2B, (const bf16*)(ws + WS_WGU), DM, DM, DM, 0};
        pg8::SchedMoE S{(const volatile LAS int*)(F.MISC + MI_TS), 2, F.G, F.vcu, 256L * DM * 2, 512L * DM * 2, 256L * DM * 2, NREP(8)};
        pg8::EpiH E{Hb, (const float*)(ws + WS_SLOTRS)}; pg8::gemm_phase_g(F.lds, g, S, E, F.wave, (const int*)(ws + WS_SLOTTOK));
    } SEAM(8);

    if (IN(9)) { const Args args = ld_args(); unsigned char* ws = args.ws;
        if (!IN(8)) moe_tile_table(F);
        pg8::Gemm g{Hb, (const bf16*)(ws + WS_WD), EFF, EFF, EFF, 0};
        pg8::SchedMoE S{(const volatile LAS int*)(F.MISC + MI_TS), 4, F.G, F.vcu, 256L * EFF * 2, 1024L * EFF * 2, 256L * EFF * 2, NREP(9)};
        pg8::EpiY E{Yb, (const int*)(ws + WS_SLOTA), (const float*)(ws + WS_TOKW)}; pg8::gemm_phase(F.lds, g, S, E, F.wave);
    } SEAM(9);

    if (IN(10)) { const Args args = ld_args(); if (NREP(10) > 1) final_phase(F, args, (float*)(args.ws + WS_R4)); final_phase(F, args, args.out); }
#undef IN
#undef SEAM
}

extern "C" void kernel_launch(void* const* d_in, const int* in_sizes, int n_in, void* d_out, int out_size, void* d_ws, size_t ws_size, hipStream_t stream) {
    static int grid = 0;
    if (grid == 0) {
        if (n_in != 19 || out_size != M * DM || ws_size < WS_END) { fprintf(stderr, "kernel_launch: unexpected shapes (n_in %d out %d ws %zu)\n", n_in, out_size, ws_size); grid = -1; return; }
        int dev = 0, cus = 0, per_cu = 0;
        if (hipGetDevice(&dev) != hipSuccess || hipDeviceGetAttribute(&cus, hipDeviceAttributeMultiprocessorCount, dev) != hipSuccess) { grid = -1; return; }
        if (hipFuncSetAttribute((const void*)mk_fwd, hipFuncAttributeMaxDynamicSharedMemorySize, LDS_BYTES) != hipSuccess) { fprintf(stderr, "kernel_launch: hipFuncSetAttribute failed\n"); grid = -1; return; }
        if (hipOccupancyMaxActiveBlocksPerMultiprocessor(&per_cu, (const void*)mk_fwd, NWAVES * 64, LDS_BYTES) != hipSuccess || per_cu < 1) { fprintf(stderr, "kernel_launch: occupancy query says %d\n", per_cu); }
        (void)hipGetLastError();
        grid = cus;
    }
    if (grid < 0) return;
    if (hipMemsetAsync((char*)d_ws + WS_CTL, 0, CTL_ZERO_BYTES, stream) != hipSuccess) return;
    Args a{};
    for (int i = 0; i < 19; ++i) a.in[i] = (const float*)d_in[i];
    a.out = (float*)d_out; a.ws = (unsigned char*)d_ws; a.ph_lo = 0; a.ph_hi = 11;
    hipLaunchKernelGGL(mk_fwd, dim3(grid), dim3(NWAVES * 64), LDS_BYTES, stream, a);
}
```

```cpp
#include <hip/hip_runtime.h>
#include <hip/hip_bf16.h>
#include <cstdio>
#include <cstdint>

#define LAS __attribute__((address_space(3)))
#define GAS __attribute__((address_space(1)))

constexpr int BATCH = 8, SEQ = 8192, DM = 1024, M = BATCH * SEQ;
constexpr int QL = 768, KVL = 256;
constexpr int NPROJ = 4864;
constexpr int NEXP = 32, EFF = 256, LCAP = 131072;
constexpr float EPS = 1e-6f;
constexpr float LOG2E = 1.4426950408889634f;
constexpr float C2A = 0.10206207261596575f * LOG2E;
constexpr float C2B = 0.125f * LOG2E;
constexpr int NWAVES = 8;

constexpr size_t MiB = 1u << 20;
constexpr size_t WS_CTL = 0, CTL_ZERO_BYTES = 1 * MiB;
constexpr size_t WS_COSA = 1 * MiB, WS_SINA = WS_COSA + 512 * 1024, WS_COSB = 2 * MiB, WS_SINB = WS_COSB + 256 * 1024;
constexpr size_t WS_SSQQ = 3 * MiB, WS_SSQKV = 6 * MiB, WS_SSQX = 7 * MiB, WS_KSUM = 11 * MiB, WS_TOKW = 12 * MiB, WS_RS = 13 * MiB;
constexpr size_t WS_WIN = 16 * MiB, WS_WUQ = 26 * MiB, WS_WUKV = 28 * MiB, WS_WO = 29 * MiB, WS_WOUT = 31 * MiB, WS_WGU = 33 * MiB, WS_WD = 65 * MiB;
constexpr size_t WS_R1 = 96 * MiB, WS_R2 = 224 * MiB, WS_R3 = 352 * MiB;
constexpr size_t WS_KR = 480 * MiB, WS_SEL = 484 * MiB, WS_LIST = 486 * MiB, WS_SLOTA = 502 * MiB, WS_SLOTRS = 503 * MiB, WS_SLOTTOK = 504 * MiB;
constexpr size_t WS_R4 = 512 * MiB, WS_LISTQ = 960 * MiB, WS_PML = 976 * MiB, WS_END = 994 * MiB;
constexpr int LQ_PER_BH = 126976;
constexpr size_t WS_XN = WS_R1, WS_QA = WS_R1, WS_MIX = WS_R1, WS_Y = WS_R1;
constexpr size_t WS_CQ = WS_R2, WS_CKV = WS_R2 + 96 * MiB, WS_OAB = WS_R2;
constexpr size_t WS_KV = WS_R3, WS_X2B = WS_R3;
constexpr size_t WS_QB = WS_R4, WS_KB = WS_R4 + 64 * MiB, WS_VB = WS_R4 + 128 * MiB, WS_SA = WS_R4 + 192 * MiB, WS_SB = WS_R4 + 320 * MiB;
constexpr size_t WS_XG = WS_R4, WS_X2L = WS_R4, WS_H = WS_R4 + 272 * MiB;
constexpr int MAXSLOT = 139264;
constexpr int CW_BAR = 4096;
constexpr int CW_CNT = 16384;
constexpr int CW_MCNT = 24576;
constexpr int CW_TICKET = 28672;
#ifndef CHECK
#define CHECK 0
#endif
#ifndef CHK_GAIN
#define CHK_GAIN 4.0f
#endif
#ifndef CHK_GROUPS
#define CHK_GROUPS 0xffff
#endif
constexpr int CW_ERR = 20000;
#ifndef REPMASK
#define REPMASK 0
#endif
#define NREP(k) (1 + ((REPMASK >> (k)) & 1))
#ifndef MLA_TUNED
#define MLA_TUNED 1
#endif
#ifndef REP_MOBA_A
#define REP_MOBA_A 1
#endif
#ifndef REP_MOBA_B
#define REP_MOBA_B 1
#endif
#ifndef WGM_P1
#define WGM_P1 4
#endif
#ifndef WGM_O
#define WGM_O 8
#endif
#ifndef RES_BF16
#define RES_BF16 1
#endif
#ifndef MLA_PRIO
#define MLA_PRIO 1
#endif
#ifndef MOBA_PRIO
#define MOBA_PRIO 0
#endif
#ifndef P0_RPT
#define P0_RPT 4
#endif
#ifndef FIN_RPT
#define FIN_RPT 2
#endif
#ifndef REP_MLA
#define REP_MLA 1
#endif
#ifndef REP_MOBA
#define REP_MOBA 1
#endif

constexpr int RING_BYTES = 131072;
constexpr int LDSCTL_OFF = RING_BYTES, MISC_OFF = LDSCTL_OFF + 320;
constexpr int LDS_BYTES = 147456;
constexpr int MI_TS = 16, MI_HIST = 64, MI_BASE = 96;

typedef unsigned short bf16;
typedef unsigned v4u __attribute__((ext_vector_type(4)));
typedef float f32x4 __attribute__((ext_vector_type(4)));
typedef float f32x16 __attribute__((ext_vector_type(16)));
typedef short bf16x8 __attribute__((ext_vector_type(8)));
typedef short s16x4 __attribute__((ext_vector_type(4)));
typedef GAS unsigned gu32;
#define RLX_AGENT __ATOMIC_RELAXED, __HIP_MEMORY_SCOPE_AGENT
#define LDS_WAIT() asm volatile("s_waitcnt lgkmcnt(0)" ::: "memory")
#define VM_WAIT() asm volatile("s_waitcnt vmcnt(0)" ::: "memory")

__device__ __forceinline__ int lane_id() { int l; asm volatile("v_mbcnt_lo_u32_b32 %0, -1, 0\n\tv_mbcnt_hi_u32_b32 %0, -1, %0" : "=v"(l)); return l; }
__device__ __forceinline__ unsigned f2bf(float f) { unsigned u = __builtin_bit_cast(unsigned, f); return (u + 0x7fffu + ((u >> 16) & 1u)) >> 16; }
__device__ __forceinline__ unsigned pk2(float lo, float hi) { return f2bf(lo) | (f2bf(hi) << 16); }
__device__ __forceinline__ unsigned cvt_pk_bf16(float lo, float hi) { unsigned r; asm volatile("v_cvt_pk_bf16_f32 %0, %1, %2" : "=v"(r) : "v"(lo), "v"(hi)); return r; }
__device__ __forceinline__ float bflo(unsigned w) { return __builtin_bit_cast(float, w << 16); }
__device__ __forceinline__ float bfhi(unsigned w) { return __builtin_bit_cast(float, w & 0xffff0000u); }
__device__ __forceinline__ float fsigmoid(float v) { return __builtin_amdgcn_rcpf(1.f + __builtin_amdgcn_exp2f(-v * LOG2E)); }
__device__ __forceinline__ float dot4(const f32x4 v) { return (v[0] * v[0] + v[1] * v[1]) + (v[2] * v[2] + v[3] * v[3]); }

namespace pg8 {
typedef unsigned short bf16_t;
constexpr int BM = 256, BK = 64, HALF = 128, HTB = HALF * BK * 2, STAGE_BYTES = 8 * HTB, NXCD = 8;
__host__ __device__ __forceinline__ int lds_byte(int r, int c) { const int st = (r >> 4) * 2 + (c >> 5), rr = r & 15, cc = c & 31, ob = rr * 64 + cc * 2; return st * 1024 + (ob ^ (((ob >> 9) & 1) << 5)); }
__host__ __device__ __forceinline__ void stage_rc(int b, int& R, int& C) { const int st = b / 1024, sb = b % 1024, swz = sb ^ (((sb >> 9) & 1) << 5); R = (st >> 1) * 16 + swz / 64; C = (st & 1) * 32 + (swz % 64) / 2; }
__host__ __device__ __forceinline__ int perm32(int rho) { const int n = rho >> 4, i = rho & 15; return 8 * (i >> 2) + 4 * n + (i & 3); }

struct Unit { int pm, pn, aux, pad; long aoff, boff; };
struct Gemm { const bf16_t* A; const bf16_t* Bt; int K, lda, ldb, pad; };

struct SchedGrid {
    int nM, nN, nwg, G, c, rep, WGM; long ta, tb;
    __device__ void init(int nM_, int nN_, int G_, int c_, int lda, int ldb, int rep_ = 1, int wgm_ = 8) { nM = nM_; nN = nN_; nwg = nM * nN; G = G_; c = c_; rep = rep_; WGM = wgm_; ta = 256L * lda * 2; tb = 256L * ldb * 2; }
    __device__ __forceinline__ bool tile(long L, Unit& u) const {
        if (L >= (long)nwg * rep) return false;
        if (L >= nwg) L -= nwg;
        int wgid = (int)L; { const int q = nwg / NXCD, r = nwg % NXCD, xcd = wgid % NXCD, off = wgid / NXCD; wgid = (xcd < r ? xcd * (q + 1) : r * (q + 1) + (xcd - r) * q) + off; }
        const int nig = WGM * nN, gid = wgid / nig, fm = gid * WGM, gsz = (nM - fm) < WGM ? (nM - fm) : WGM;
        u.pm = fm + ((wgid % nig) % gsz); u.pn = (wgid % nig) / gsz; u.aux = 0; u.pad = 0; u.aoff = u.pm * ta; u.boff = u.pn * tb; return true;
    }
    __device__ __forceinline__ bool next(int i, Unit& u) const { return tile((long)i * G + c, u); }
};
struct SchedMix {
    SchedGrid g;
    __device__ __forceinline__ bool next(int i, Unit& u) const { if (!g.tile((long)(i >> 1) * g.G + g.c, u)) return false; u.aux = i & 1; u.aoff += (i & 1) * 1024; u.boff += (i & 1) * 1024; return true; }
};
struct SchedMoE {
    const volatile LAS int* TS; int npn, G, c; long ta, tbe, tbn; int rep;
    __device__ __forceinline__ bool next(int i, Unit& u) const {
        long L = (long)i * G + c; const int ntile = TS[32]; if (L >= (long)ntile * npn * rep) return false; if (L >= (long)ntile * npn) L -= (long)ntile * npn;
        const int st = (int)(L / npn), pn = (int)(L % npn); int e = 0;
        for (int k = 1; k < 32; ++k) e += (st >= TS[k]) ? 1 : 0;
        u.pm = st; u.pn = pn; u.aux = e; u.pad = 0; u.aoff = st * ta; u.boff = e * tbe + pn * tbn; return true;
    }
};

template <class Epi, class Sched>
__device__ __forceinline__ void gemm_phase(LAS unsigned char* lds, const Gemm g, const Sched& S, const Epi& E, const int wave) {
    const int wid = wave, lane = lane_id(), tid = wid * 64 + lane, wr = wid >> 2, wc = wid & 3, fr = lane & 15, fq = lane >> 4;
    const int K = g.K, nt = K / BK;
    unsigned voffA[2], voffB[2];
#pragma unroll
    for (int i = 0; i < 2; ++i) { int R, C; stage_rc(tid * 16 + i * 8192, R, C); const int Rb = (R & ~31) + perm32(R & 31);
        voffA[i] = (unsigned)(R * g.lda + C) * 2u; voffB[i] = (unsigned)(Rb * g.ldb + C) * 2u; }
    const size_t kstep = (size_t)(BK * 2);
    const size_t hsA = (size_t)HALF * g.lda * 2, hsB = (size_t)HALF * g.ldb * 2;
    const unsigned ldsw = (unsigned)wid * 1024u;
    const int aoff = lds_byte(wr * 64 + fr, fq * 8), boff = lds_byte(wc * 32 + fr, fq * 8);
#define PG8_SA(b, h) (((b) * 2 + (h)) * HTB)
#define PG8_SB(b, h) ((4 + (b) * 2 + (h)) * HTB)
#define PG8_STAGE(bufoff, gbase, voff) do { _Pragma("unroll") for (int _i = 0; _i < 2; ++_i) \
        __builtin_amdgcn_global_load_lds((const unsigned*)((const char*)(gbase) + (voff)[_i]), (LAS unsigned*)(lds + (bufoff) + ldsw + _i * 8192), 16, 0, 0); } while (0)
#define PG8_LDA(dst, b, h) do { _Pragma("unroll") for (int m = 0; m < 4; ++m) _Pragma("unroll") for (int k = 0; k < 2; ++k) dst[m][k] = *(const LAS bf16x8*)(lds + PG8_SA(b, h) + aoff + m * 2048 + k * 1024); } while (0)
#define PG8_LDB(dst, b, h) do { _Pragma("unroll") for (int n = 0; n < 2; ++n) _Pragma("unroll") for (int k = 0; k < 2; ++k) dst[n][k] = *(const LAS bf16x8*)(lds + PG8_SB(b, h) + boff + n * 2048 + k * 1024); } while (0)
#define PG8_MMA(ai, bj, At, Bt) do { __builtin_amdgcn_s_setprio(1); _Pragma("unroll") for (int m = 0; m < 4; ++m) _Pragma("unroll") for (int n = 0; n < 2; ++n) _Pragma("unroll") for (int k = 0; k < 2; ++k) \
        acc[ai][bj][m][n] = __builtin_amdgcn_mfma_f32_16x16x32_bf16(Bt[n][k], At[m][k], acc[ai][bj][m][n], 0, 0, 0); __builtin_amdgcn_s_setprio(0); } while (0)
#define PG8_WAIT_V(n) asm volatile("s_waitcnt vmcnt(" #n ")" ::: "memory")
#define PG8_WAIT_L(n) asm volatile("s_waitcnt lgkmcnt(" #n ")" ::: "memory")
#define PG8_BAR __builtin_amdgcn_s_barrier()
#define PG8_SCHED __builtin_amdgcn_sched_barrier(0)
    Unit cur, nxt; int ui = 0;
    if (!S.next(0, cur)) return;
    f32x4 acc[2][2][4][2];
#pragma unroll
    for (int a = 0; a < 2; ++a)
#pragma unroll
        for (int b = 0; b < 2; ++b)
#pragma unroll
            for (int m = 0; m < 4; ++m)
#pragma unroll
                for (int n = 0; n < 2; ++n) acc[a][b][m][n] = (f32x4){0.f, 0.f, 0.f, 0.f};
    bf16x8 At[4][2], B0[2][2], B1[2][2];
    const char* cA = (const char*)g.A + cur.aoff; const char* cB = (const char*)g.Bt + cur.boff;
    PG8_STAGE(PG8_SB(0, 0), cB, voffB); PG8_STAGE(PG8_SB(0, 1), cB + hsB, voffB); PG8_STAGE(PG8_SA(0, 0), cA, voffA); PG8_STAGE(PG8_SA(0, 1), cA + hsA, voffA);
    if (wr == 1) PG8_BAR;
    PG8_WAIT_V(2); PG8_BAR;
    PG8_STAGE(PG8_SB(1, 0), cB + kstep, voffB); PG8_STAGE(PG8_SA(1, 0), cA + kstep, voffA); PG8_STAGE(PG8_SB(1, 1), cB + hsB + kstep, voffB);
    PG8_WAIT_V(6); PG8_BAR;
    for (;;) {
        const bool has_next = S.next(ui + 1, nxt);
        const char* nA = has_next ? (const char*)g.A + nxt.aoff : cA; const char* nB = has_next ? (const char*)g.Bt + nxt.boff : cB;
        for (int t = 0; t < nt; t += 2) {
            const bool last = (t == nt - 2);
            const char* a1 = cA + (size_t)(t + 1) * kstep;
            const char* a2 = last ? nA : cA + (size_t)(t + 2) * kstep; const char* b2 = last ? nB : cB + (size_t)(t + 2) * kstep;
            const char* a3 = a2 + kstep; const char* b3 = b2 + kstep;
            PG8_LDB(B0, 0, 0); PG8_LDB(B1, 0, 1); PG8_SCHED; PG8_LDA(At, 0, 0); PG8_STAGE(PG8_SA(1, 1), a1 + hsA, voffA);
            PG8_WAIT_V(8); PG8_WAIT_L(0); PG8_BAR; PG8_MMA(0, 0, At, B0); PG8_MMA(0, 1, At, B1); PG8_BAR; PG8_SCHED;
            PG8_LDA(At, 0, 1); PG8_STAGE(PG8_SB(0, 0), b2, voffB); PG8_STAGE(PG8_SB(0, 1), b2 + hsB, voffB); PG8_STAGE(PG8_SA(0, 0), a2, voffA);
            PG8_WAIT_V(8); PG8_WAIT_L(0); PG8_BAR; PG8_MMA(1, 0, At, B0); PG8_MMA(1, 1, At, B1); PG8_BAR; PG8_SCHED;
            PG8_LDB(B0, 1, 0); PG8_LDB(B1, 1, 1); PG8_SCHED; PG8_LDA(At, 1, 0); PG8_STAGE(PG8_SA(0, 1), a2 + hsA, voffA);
            PG8_WAIT_V(8); PG8_WAIT_L(0); PG8_BAR; PG8_MMA(0, 0, At, B0); PG8_MMA(0, 1, At, B1); PG8_BAR; PG8_SCHED;
            PG8_LDA(At, 1, 1); PG8_STAGE(PG8_SB(1, 0), b3, voffB); PG8_STAGE(PG8_SB(1, 1), b3 + hsB, voffB); PG8_STAGE(PG8_SA(1, 0), a3, voffA);
            PG8_WAIT_V(8); PG8_WAIT_L(0); PG8_BAR; PG8_MMA(1, 0, At, B0); PG8_MMA(1, 1, At, B1); PG8_BAR; PG8_SCHED;
        }
        if (wr == 0) PG8_BAR;
        const bool keep = E(acc, cur, wr, wc, fr, fq);
        if (!has_next) break;
        if (!keep) {
#pragma unroll
            for (int a = 0; a < 2; ++a)
#pragma unroll
                for (int b = 0; b < 2; ++b)
#pragma unroll
                    for (int m = 0; m < 4; ++m)
#pragma unroll
                        for (int n = 0; n < 2; ++n) acc[a][b][m][n] = (f32x4){0.f, 0.f, 0.f, 0.f};
        }
        cur = nxt; cA = nA; cB = nB; ++ui;
        if (wr == 1) PG8_BAR;
    }
    PG8_WAIT_V(0);
    PG8_BAR;
#undef PG8_SA
#undef PG8_SB
#undef PG8_STAGE
#undef PG8_LDA
#undef PG8_LDB
#undef PG8_MMA
#undef PG8_WAIT_V
#undef PG8_WAIT_L
#undef PG8_BAR
#undef PG8_SCHED
}

template <class Epi, class Sched>
__device__ __forceinline__ void gemm_phase_g(LAS unsigned char* lds, const Gemm g, const Sched& S, const Epi& E, const int wave, const int* ROWS) {
    const int wid = wave, lane = lane_id(), tid = wid * 64 + lane, wr = wid >> 2, wc = wid & 3, fr = lane & 15, fq = lane >> 4;
    const int K = g.K, nt = K / BK;
    unsigned voffB[2]; int RA[2]; unsigned CA2[2];
#pragma unroll
    for (int i = 0; i < 2; ++i) { int R, C; stage_rc(tid * 16 + i * 8192, R, C); const int Rb = (R & ~31) + perm32(R & 31);
        RA[i] = R; CA2[i] = (unsigned)C * 2u; voffB[i] = (unsigned)(Rb * g.ldb + C) * 2u; }
    const unsigned rowb = (unsigned)g.lda * 2u;
    unsigned vcur[2][2], vnxt[2][2];
#define PG8_ROWS(dst, u) do { _Pragma("unroll") for (int h_ = 0; h_ < 2; ++h_) _Pragma("unroll") for (int i_ = 0; i_ < 2; ++i_) { const int t_ = ROWS[(u).pm * 256 + h_ * 128 + RA[i_]]; dst[h_][i_] = (unsigned)(t_ < 0 ? 0 : t_) * rowb + CA2[i_]; } } while (0)
    const size_t kstep = (size_t)(BK * 2);
    const size_t hsA = (size_t)HALF * g.lda * 2, hsB = (size_t)HALF * g.ldb * 2;
    const unsigned ldsw = (unsigned)wid * 1024u;
    const int aoff = lds_byte(wr * 64 + fr, fq * 8), boff = lds_byte(wc * 32 + fr, fq * 8);
#define PG8_SA(b, h) (((b) * 2 + (h)) * HTB)
#define PG8_SB(b, h) ((4 + (b) * 2 + (h)) * HTB)
#define PG8_STAGE(bufoff, gbase, voff) do { _Pragma("unroll") for (int _i = 0; _i < 2; ++_i) \
        __builtin_amdgcn_global_load_lds((const unsigned*)((const char*)(gbase) + (voff)[_i]), (LAS unsigned*)(lds + (bufoff) + ldsw + _i * 8192), 16, 0, 0); } while (0)
#define PG8_LDA(dst, b, h) do { _Pragma("unroll") for (int m = 0; m < 4; ++m) _Pragma("unroll") for (int k = 0; k < 2; ++k) dst[m][k] = *(const LAS bf16x8*)(lds + PG8_SA(b, h) + aoff + m * 2048 + k * 1024); } while (0)
#define PG8_LDB(dst, b, h) do { _Pragma("unroll") for (int n = 0; n < 2; ++n) _Pragma("unroll") for (int k = 0; k < 2; ++k) dst[n][k] = *(const LAS bf16x8*)(lds + PG8_SB(b, h) + boff + n * 2048 + k * 1024); } while (0)
#define PG8_MMA(ai, bj, At, Bt) do { __builtin_amdgcn_s_setprio(1); _Pragma("unroll") for (int m = 0; m < 4; ++m) _Pragma("unroll") for (int n = 0; n < 2; ++n) _Pragma("unroll") for (int k = 0; k < 2; ++k) \
        acc[ai][bj][m][n] = __builtin_amdgcn_mfma_f32_16x16x32_bf16(Bt[n][k], At[m][k], acc[ai][bj][m][n], 0, 0, 0); __builtin_amdgcn_s_setprio(0); } while (0)
#define PG8_WAIT_V(n) asm volatile("s_waitcnt vmcnt(" #n ")" ::: "memory")
#define PG8_WAIT_L(n) asm volatile("s_waitcnt lgkmcnt(" #n ")" ::: "memory")
#define PG8_BAR __builtin_amdgcn_s_barrier()
#define PG8_SCHED __builtin_amdgcn_sched_barrier(0)
    Unit cur, nxt, nn; int ui = 0;
    if (!S.next(0, cur)) return;
    bool has_next = S.next(1, nxt);
    PG8_ROWS(vcur, cur); if (has_next) { PG8_ROWS(vnxt, nxt); } else { _Pragma("unroll") for (int h_ = 0; h_ < 2; ++h_) _Pragma("unroll") for (int i_ = 0; i_ < 2; ++i_) vnxt[h_][i_] = vcur[h_][i_]; }
    f32x4 acc[2][2][4][2];
#pragma unroll
    for (int a = 0; a < 2; ++a)
#pragma unroll
        for (int b = 0; b < 2; ++b)
#pragma unroll
            for (int m = 0; m < 4; ++m)
#pragma unroll
                for (int n = 0; n < 2; ++n) acc[a][b][m][n] = (f32x4){0.f, 0.f, 0.f, 0.f};
    bf16x8 At[4][2], B0[2][2], B1[2][2];
    const char* cA = (const char*)g.A; const char* cB = (const char*)g.Bt + cur.boff;
    PG8_STAGE(PG8_SB(0, 0), cB, voffB); PG8_STAGE(PG8_SB(0, 1), cB + hsB, voffB); PG8_STAGE(PG8_SA(0, 0), cA, vcur[0]); PG8_STAGE(PG8_SA(0, 1), cA, vcur[1]);
    if (wr == 1) PG8_BAR;
    PG8_WAIT_V(2); PG8_BAR;
    PG8_STAGE(PG8_SB(1, 0), cB + kstep, voffB); PG8_STAGE(PG8_SA(1, 0), cA + kstep, vcur[0]); PG8_STAGE(PG8_SB(1, 1), cB + hsB + kstep, voffB);
    PG8_WAIT_V(6); PG8_BAR;
    for (;;) {
        const bool has_nn = has_next && S.next(ui + 2, nn);
        const char* nB = has_next ? (const char*)g.Bt + nxt.boff : cB;
        for (int t = 0; t < nt; t += 2) {
            const bool last = (t == nt - 2);
            const char* a1 = cA + (size_t)(t + 1) * kstep;
            const char* a2 = last ? cA : cA + (size_t)(t + 2) * kstep; const char* b2 = last ? nB : cB + (size_t)(t + 2) * kstep;
            unsigned v2[2][2];
#pragma unroll
            for (int h_ = 0; h_ < 2; ++h_)
#pragma unroll
                for (int i_ = 0; i_ < 2; ++i_) v2[h_][i_] = last ? vnxt[h_][i_] : vcur[h_][i_];
            const char* a3 = a2 + kstep; const char* b3 = b2 + kstep;
            PG8_LDB(B0, 0, 0); PG8_LDB(B1, 0, 1); PG8_SCHED; PG8_LDA(At, 0, 0); PG8_STAGE(PG8_SA(1, 1), a1, vcur[1]);
            PG8_WAIT_V(8); PG8_WAIT_L(0); PG8_BAR; PG8_MMA(0, 0, At, B0); PG8_MMA(0, 1, At, B1); PG8_BAR; PG8_SCHED;
            PG8_LDA(At, 0, 1); PG8_STAGE(PG8_SB(0, 0), b2, voffB); PG8_STAGE(PG8_SB(0, 1), b2 + hsB, voffB); PG8_STAGE(PG8_SA(0, 0), a2, v2[0]);
            PG8_WAIT_V(8); PG8_WAIT_L(0); PG8_BAR; PG8_MMA(1, 0, At, B0); PG8_MMA(1, 1, At, B1); PG8_BAR; PG8_SCHED;
            PG8_LDB(B0, 1, 0); PG8_LDB(B1, 1, 1); PG8_SCHED; PG8_LDA(At, 1, 0); PG8_STAGE(PG8_SA(0, 1), a2, v2[1]);
            PG8_WAIT_V(8); PG8_WAIT_L(0); PG8_BAR; PG8_MMA(0, 0, At, B0); PG8_MMA(0, 1, At, B1); PG8_BAR; PG8_SCHED;
            PG8_LDA(At, 1, 1); PG8_STAGE(PG8_SB(1, 0), b3, voffB); PG8_STAGE(PG8_SB(1, 1), b3 + hsB, voffB); PG8_STAGE(PG8_SA(1, 0), a3, v2[0]);
            PG8_WAIT_V(8); PG8_WAIT_L(0); PG8_BAR; PG8_MMA(1, 0, At, B0); PG8_MMA(1, 1, At, B1); PG8_BAR; PG8_SCHED;
        }
        if (wr == 0) PG8_BAR;
        unsigned vnn[2][2];
        if (has_nn) { PG8_ROWS(vnn, nn); } else { _Pragma("unroll") for (int h_ = 0; h_ < 2; ++h_) _Pragma("unroll") for (int i_ = 0; i_ < 2; ++i_) vnn[h_][i_] = vnxt[h_][i_]; }
        const bool keep = E(acc, cur, wr, wc, fr, fq);
        if (!has_next) break;
        if (!keep) {
#pragma unroll
            for (int a = 0; a < 2; ++a)
#pragma unroll
                for (int b = 0; b < 2; ++b)
#pragma unroll
                    for (int m = 0; m < 4; ++m)
#pragma unroll
                        for (int n = 0; n < 2; ++n) acc[a][b][m][n] = (f32x4){0.f, 0.f, 0.f, 0.f};
        }
        cur = nxt; nxt = nn; cB = nB; ++ui; has_next = has_nn;
#pragma unroll
        for (int h_ = 0; h_ < 2; ++h_)
#pragma unroll
            for (int i_ = 0; i_ < 2; ++i_) { vcur[h_][i_] = vnxt[h_][i_]; vnxt[h_][i_] = vnn[h_][i_]; }
        if (wr == 1) PG8_BAR;
    }
    PG8_WAIT_V(0);
    PG8_BAR;
#undef PG8_SA
#undef PG8_SB
#undef PG8_STAGE
#undef PG8_ROWS
#undef PG8_LDA
#undef PG8_LDB
#undef PG8_MMA
#undef PG8_WAIT_V
#undef PG8_WAIT_L
#undef PG8_BAR
#undef PG8_SCHED
}

__device__ __forceinline__ v4u pack8(const f32x4 v0, const f32x4 v1) { v4u w; w.x = cvt_pk_bf16(v0[0], v0[1]); w.y = cvt_pk_bf16(v0[2], v0[3]); w.z = cvt_pk_bf16(v1[0], v1[1]); w.w = cvt_pk_bf16(v1[2], v1[3]); return w; }
__device__ __forceinline__ void rot2(float& a, float& b, float c, float s) { const float x = a * c - b * s, y = b * c + a * s; a = x; b = y; }
__device__ __forceinline__ void rope8(f32x4& v0, f32x4& v1, const f32x4 c4, const f32x4 s4) {
    float a0 = v0[0], b0 = v0[1], a1 = v0[2], b1 = v0[3], a2 = v1[0], b2 = v1[1], a3 = v1[2], b3 = v1[3];
    rot2(a0, b0, c4[0], s4[0]); rot2(a1, b1, c4[1], s4[1]); rot2(a2, b2, c4[2], s4[2]); rot2(a3, b3, c4[3], s4[3]);
    v0 = (f32x4){a0, b0, a1, b1}; v1 = (f32x4){a2, b2, a3, b3};
}

struct EpiProj {
    bf16_t *CQ, *CKV, *KR, *QB, *KB, *VB, *SA, *SB; float *SSQ_Q, *SSQ_KV, *KSUM; const float *COSA, *SINA, *COSB, *SINB;
    __device__ __forceinline__ bool operator()(f32x4 (&acc)[2][2][4][2], const Unit& u, int wr, int wc, int fr, int fq) const {
        const int pn = u.pn, row0 = u.pm * BM + wr * 64 + fr, ct = wc * 32 + 8 * fq;
        if (pn < 4) {
            bf16_t* O; int ldc, cb, nss, sidx; float* SS;
            if (pn < 3) { O = CQ; ldc = QL; cb = pn * 256; SS = SSQ_Q; nss = 12; sidx = pn * 4 + wc; } else { O = CKV; ldc = KVL; cb = 0; SS = SSQ_KV; nss = 4; sidx = wc; }
#pragma unroll
            for (int ai = 0; ai < 2; ++ai)
#pragma unroll
                for (int m = 0; m < 4; ++m) { const int row = row0 + ai * HALF + m * 16; float s = 0.f;
#pragma unroll
                    for (int bj = 0; bj < 2; ++bj) { const f32x4 v0 = acc[ai][bj][m][0], v1 = acc[ai][bj][m][1]; s += dot4(v0) + dot4(v1);
                        *(v4u*)(O + (size_t)row * ldc + cb + bj * HALF + ct) = pack8(v0, v1); }
                    s += __shfl_xor(s, 16); s += __shfl_xor(s, 32);
                    if (fq == 0) SS[(size_t)row * nss + sidx] = s; }
        } else if (pn < 8) {
            const bool isq = pn < 6; bf16_t* O = isq ? QB : KB; const int cb = (pn - (isq ? 4 : 6)) * 256;
            const bool rope = ((wc & 1) == 0) && (fq < 2); const float sc = isq ? C2B : 1.f;
#pragma unroll
            for (int ai = 0; ai < 2; ++ai)
#pragma unroll
                for (int m = 0; m < 4; ++m) { const int row = row0 + ai * HALF + m * 16, pos = row & (SEQ - 1);
                    f32x4 c4 = (f32x4){1.f, 1.f, 1.f, 1.f}, s4 = (f32x4){0.f, 0.f, 0.f, 0.f};
                    if (rope) { c4 = *(const f32x4*)(COSB + pos * 8 + 4 * fq); s4 = *(const f32x4*)(SINB + pos * 8 + 4 * fq); }
#pragma unroll
                    for (int bj = 0; bj < 2; ++bj) { f32x4 v0 = acc[ai][bj][m][0], v1 = acc[ai][bj][m][1];
                        rope8(v0, v1, c4, s4); v0 = v0 * sc; v1 = v1 * sc;
                        *(v4u*)(O + (size_t)row * 512 + cb + bj * HALF + ct) = pack8(v0, v1); } }
            if (!isq) {
#pragma unroll
                for (int bj = 0; bj < 2; ++bj)
#pragma unroll
                    for (int n = 0; n < 2; ++n) { f32x4 v = (f32x4){0.f, 0.f, 0.f, 0.f};
#pragma unroll
                        for (int ai = 0; ai < 2; ++ai)
#pragma unroll
                            for (int m = 0; m < 4; ++m) { const int pos = (row0 + ai * HALF + m * 16) & (SEQ - 1);
                                float a0 = acc[ai][bj][m][n][0], b0 = acc[ai][bj][m][n][1], a1 = acc[ai][bj][m][n][2], b1 = acc[ai][bj][m][n][3];
                                if (rope) { const float* cp = COSB + pos * 8 + 4 * fq + 2 * n; const float* sp = SINB + pos * 8 + 4 * fq + 2 * n;
                                    rot2(a0, b0, cp[0], sp[0]); rot2(a1, b1, cp[1], sp[1]); }
                                v[0] += a0; v[1] += b0; v[2] += a1; v[3] += b1; }
#pragma unroll
                        for (int o = 1; o < 16; o <<= 1) { v[0] += __shfl_xor(v[0], o); v[1] += __shfl_xor(v[1], o); v[2] += __shfl_xor(v[2], o); v[3] += __shfl_xor(v[3], o); }
                        if (fr == 0) *(f32x4*)(KSUM + ((size_t)(wr * 256 + u.pm)) * 512 + cb + bj * HALF + ct + 4 * n) = v;
                        asm volatile("" ::: "memory"); }
            }
        } else if (pn < 10) {
            const int cb = (pn - 8) * 256;
#pragma unroll
            for (int ai = 0; ai < 2; ++ai)
#pragma unroll
                for (int m = 0; m < 4; ++m) { const int row = row0 + ai * HALF + m * 16;
#pragma unroll
                    for (int bj = 0; bj < 2; ++bj) *(v4u*)(VB + (size_t)row * 512 + cb + bj * HALF + ct) = pack8(acc[ai][bj][m][0], acc[ai][bj][m][1]); }
        } else if (pn < 18) {
            const int cb = (pn - 10) * 128;
#pragma unroll
            for (int ai = 0; ai < 2; ++ai)
#pragma unroll
                for (int m = 0; m < 4; ++m) { const int row = row0 + ai * HALF + m * 16;
                    f32x4 r0, r1, b0, b1;
#pragma unroll
                    for (int j = 0; j < 4; ++j) { const float sa0 = fsigmoid(acc[ai][0][m][0][j]), sa1 = fsigmoid(acc[ai][0][m][1][j]);
                        b0[j] = fmaxf(fsigmoid(acc[ai][1][m][0][j]), 1e-30f); b1[j] = fmaxf(fsigmoid(acc[ai][1][m][1][j]), 1e-30f);
                        r0[j] = sa0 * __builtin_amdgcn_rcpf(b0[j]); r1[j] = sa1 * __builtin_amdgcn_rcpf(b1[j]); }
                    *(v4u*)(SA + (size_t)row * DM + cb + ct) = pack8(r0, r1); *(v4u*)(SB + (size_t)row * DM + cb + ct) = pack8(b0, b1); }
        } else {
            if (wc == 0) {
#pragma unroll
                for (int ai = 0; ai < 2; ++ai)
#pragma unroll
                    for (int m = 0; m < 4; ++m) { const int row = row0 + ai * HALF + m * 16, pos = row & (SEQ - 1);
                        const f32x4 c4 = *(const f32x4*)(COSA + pos * 16 + 4 * fq), s4 = *(const f32x4*)(SINA + pos * 16 + 4 * fq);
                        f32x4 v0 = acc[ai][0][m][0], v1 = acc[ai][0][m][1]; rope8(v0, v1, c4, s4);
                        *(v4u*)(KR + (size_t)row * 32 + 8 * fq) = pack8(v0, v1); }
            }
        }
        return false;
    }
};
struct EpiPlain {
    bf16_t* O;
    __device__ __forceinline__ bool operator()(f32x4 (&acc)[2][2][4][2], const Unit& u, int wr, int wc, int fr, int fq) const {
        const int row0 = (u.pm & 15) * BM + wr * 64 + fr, ct = wc * 32 + 8 * fq;
#pragma unroll
        for (int ai = 0; ai < 2; ++ai)
#pragma unroll
            for (int m = 0; m < 4; ++m) { const int row = row0 + ai * HALF + m * 16;
#pragma unroll
                for (int bj = 0; bj < 2; ++bj) *(v4u*)(O + (size_t)row * NPROJ + u.pn * 256 + bj * HALF + ct) = pack8(acc[ai][bj][m][0], acc[ai][bj][m][1]); }
        return false;
    }
};
struct EpiQ {
    bf16_t* QA; const float *SSQ_Q, *COSA, *SINA;
    __device__ __forceinline__ bool operator()(f32x4 (&acc)[2][2][4][2], const Unit& u, int wr, int wc, int fr, int fq) const {
        const int row0 = u.pm * BM + wr * 64 + fr;
        bool isrope[2];
#pragma unroll
        for (int bj = 0; bj < 2; ++bj) isrope[bj] = (((u.pn * 256 + bj * HALF + wc * 32) >> 5) % 3) == 2;
        const bool anyrope = isrope[0] || isrope[1];
#pragma unroll
        for (int ai = 0; ai < 2; ++ai) { float rs[4]; f32x4 c4[4], s4[4];
            { f32x4 p[4][3];
#pragma unroll
              for (int m = 0; m < 4; ++m) { const size_t row = (size_t)(row0 + ai * HALF + m * 16);
#pragma unroll
                  for (int k = 0; k < 3; ++k) p[m][k] = *(const f32x4*)(SSQ_Q + row * 12 + 4 * k); }
              if (anyrope) {
#pragma unroll
                  for (int m = 0; m < 4; ++m) { const int pos = (row0 + ai * HALF + m * 16) & (SEQ - 1); c4[m] = *(const f32x4*)(COSA + pos * 16 + 4 * fq); s4[m] = *(const f32x4*)(SINA + pos * 16 + 4 * fq); } }
#pragma unroll
              for (int m = 0; m < 4; ++m) { float ss = 0.f;
#pragma unroll
                  for (int k = 0; k < 3; ++k)
#pragma unroll
                      for (int j = 0; j < 4; ++j) ss += p[m][k][j];
                  rs[m] = C2A / sqrtf(ss * (1.f / QL) + EPS); } }
#pragma unroll
            for (int m = 0; m < 4; ++m) { const int row = row0 + ai * HALF + m * 16;
#pragma unroll
                for (int bj = 0; bj < 2; ++bj) { const int cg = u.pn * 256 + bj * HALF + wc * 32;
                    f32x4 v0 = acc[ai][bj][m][0] * rs[m], v1 = acc[ai][bj][m][1] * rs[m];
                    if (isrope[bj]) rope8(v0, v1, c4[m], s4[m]);
                    *(v4u*)(QA + (size_t)row * QL + cg + 8 * fq) = pack8(v0, v1); } }
            asm volatile("" ::: "memory"); }
        return false;
    }
};
struct EpiKV {
    bf16_t* KV; const float* SSQ_KV;
    __device__ __forceinline__ bool operator()(f32x4 (&acc)[2][2][4][2], const Unit& u, int wr, int wc, int fr, int fq) const {
        const int row0 = u.pm * BM + wr * 64 + fr, ct = wc * 32 + 8 * fq;
        f32x4 p[2][4];
#pragma unroll
        for (int ai = 0; ai < 2; ++ai)
#pragma unroll
            for (int m = 0; m < 4; ++m) p[ai][m] = *(const f32x4*)(SSQ_KV + (size_t)(row0 + ai * HALF + m * 16) * 4);
#pragma unroll
        for (int ai = 0; ai < 2; ++ai)
#pragma unroll
            for (int m = 0; m < 4; ++m) { const int row = row0 + ai * HALF + m * 16;
                const float ss = ((p[ai][m][0] + p[ai][m][1]) + p[ai][m][2]) + p[ai][m][3];
                const float rs = 1.f / sqrtf(ss * (1.f / KVL) + EPS);
#pragma unroll
                for (int bj = 0; bj < 2; ++bj) *(v4u*)(KV + (size_t)row * DM + u.pn * 256 + bj * HALF + ct) = pack8(acc[ai][bj][m][0] * rs, acc[ai][bj][m][1] * rs); }
        return false;
    }
};
struct EpiMix {
    bf16_t* MIX; const bf16_t *RA, *SB;
    __device__ __forceinline__ bool operator()(f32x4 (&acc)[2][2][4][2], const Unit& u, int wr, int wc, int fr, int fq) const {
        const int row0 = u.pm * BM + wr * 64 + fr, ct = wc * 32 + 8 * fq; const bool first = (u.aux == 0);
        const bf16_t* G = first ? RA : SB;
        v4u gq[2][4][2];
#pragma unroll
        for (int ai = 0; ai < 2; ++ai)
#pragma unroll
            for (int m = 0; m < 4; ++m)
#pragma unroll
                for (int bj = 0; bj < 2; ++bj) gq[ai][m][bj] = *(const v4u*)(G + (size_t)(row0 + ai * HALF + m * 16) * DM + u.pn * 256 + bj * HALF + ct);
#pragma unroll
        for (int ai = 0; ai < 2; ++ai)
#pragma unroll
            for (int m = 0; m < 4; ++m)
#pragma unroll
                for (int bj = 0; bj < 2; ++bj) { const v4u gv = gq[ai][m][bj];
                    const float gf[8] = {bflo(gv.x), bfhi(gv.x), bflo(gv.y), bfhi(gv.y), bflo(gv.z), bfhi(gv.z), bflo(gv.w), bfhi(gv.w)};
                    f32x4 v0 = acc[ai][bj][m][0], v1 = acc[ai][bj][m][1];
#pragma unroll
                    for (int j = 0; j < 4; ++j) { v0[j] *= gf[j]; v1[j] *= gf[4 + j]; }
                    if (first) { acc[ai][bj][m][0] = v0; acc[ai][bj][m][1] = v1; }
                    else *(v4u*)(MIX + (size_t)(row0 + ai * HALF + m * 16) * DM + u.pn * 256 + bj * HALF + ct) = pack8(v0, v1); }
        return first;
    }
};
struct EpiOut {
    const float* X; bf16_t* X2L; bf16_t* X2B; float* SSQ_X;
    __device__ __forceinline__ bool operator()(f32x4 (&acc)[2][2][4][2], const Unit& u, int wr, int wc, int fr, int fq) const {
        const int row0 = u.pm * BM + wr * 64 + fr, ct = wc * 32 + 8 * fq;
#pragma unroll
        for (int ai = 0; ai < 2; ++ai) { f32x4 xv[4][2][2];
#pragma unroll
            for (int m = 0; m < 4; ++m)
#pragma unroll
                for (int bj = 0; bj < 2; ++bj) { const size_t off = (size_t)(row0 + ai * HALF + m * 16) * DM + u.pn * 256 + bj * HALF + ct; xv[m][bj][0] = *(const f32x4*)(X + off); xv[m][bj][1] = *(const f32x4*)(X + off + 4); }
#pragma unroll
            for (int m = 0; m < 4; ++m) { const int row = row0 + ai * HALF + m * 16; float s = 0.f;
#pragma unroll
                for (int bj = 0; bj < 2; ++bj) { const size_t off = (size_t)row * DM + u.pn * 256 + bj * HALF + ct;
                    const f32x4 v0 = acc[ai][bj][m][0] + xv[m][bj][0], v1 = acc[ai][bj][m][1] + xv[m][bj][1];
                    s += dot4(v0) + dot4(v1);
                    const v4u hp = pack8(v0, v1);
                    const f32x4 l0 = (f32x4){v0[0] - bflo(hp.x), v0[1] - bfhi(hp.x), v0[2] - bflo(hp.y), v0[3] - bfhi(hp.y)}, l1 = (f32x4){v1[0] - bflo(hp.z), v1[1] - bfhi(hp.z), v1[2] - bflo(hp.w), v1[3] - bfhi(hp.w)};
                    *(v4u*)(X2B + off) = hp;
#if !RES_BF16
                    *(v4u*)(X2L + off) = pack8(l0, l1);
#endif
                    }
                s += __shfl_xor(s, 16); s += __shfl_xor(s, 32);
                if (fq == 0) SSQ_X[(size_t)row * 16 + u.pn * 4 + wc] = s; } }
        return false;
    }
};
struct EpiH {
    bf16_t* H; const float* SLOT_RS;
    __device__ __forceinline__ bool operator()(f32x4 (&acc)[2][2][4][2], const Unit& u, int wr, int wc, int fr, int fq) const {
        const int row0 = u.pm * BM + wr * 64 + fr, ct = wc * 32 + 8 * fq;
        float rsv[2][4];
#pragma unroll
        for (int ai = 0; ai < 2; ++ai)
#pragma unroll
            for (int m = 0; m < 4; ++m) rsv[ai][m] = SLOT_RS[row0 + ai * HALF + m * 16];
#pragma unroll
        for (int ai = 0; ai < 2; ++ai)
#pragma unroll
            for (int m = 0; m < 4; ++m) { const int row = row0 + ai * HALF + m * 16; const float rs = rsv[ai][m];
                f32x4 h0, h1;
#pragma unroll
                for (int j = 0; j < 4; ++j) { const float g0 = acc[ai][0][m][0][j] * rs, g1 = acc[ai][0][m][1][j] * rs;
                    h0[j] = g0 * fsigmoid(g0) * (acc[ai][1][m][0][j] * rs); h1[j] = g1 * fsigmoid(g1) * (acc[ai][1][m][1][j] * rs); }
                *(v4u*)(H + (size_t)row * EFF + u.pn * HALF + ct) = pack8(h0, h1); }
        return false;
    }
};
struct EpiY {
    bf16_t* Y; const int* SLOT_A; const float* TOKW;
    __device__ __forceinline__ bool operator()(f32x4 (&acc)[2][2][4][2], const Unit& u, int wr, int wc, int fr, int fq) const {
        const int row0 = u.pm * BM + wr * 64 + fr, ct = wc * 32 + 8 * fq;
#pragma unroll
        for (int ai = 0; ai < 2; ++ai) { int av[4]; float wv[4];
#pragma unroll
            for (int m = 0; m < 4; ++m) av[m] = SLOT_A[row0 + ai * HALF + m * 16];
#pragma unroll
            for (int m = 0; m < 4; ++m) wv[m] = TOKW[av[m] < 0 ? 0 : av[m]];
#pragma unroll
            for (int m = 0; m < 4; ++m) { const int a = av[m];
                if (a >= 0) { const float w = wv[m]; bf16_t* yr = Y + (unsigned)a * (unsigned)DM + (unsigned)(u.pn * 256 + ct);
#pragma unroll
                    for (int bj = 0; bj < 2; ++bj) *(v4u*)(yr + bj * HALF) = pack8(acc[ai][bj][m][0] * w, acc[ai][bj][m][1] * w); } }
            asm volatile("" ::: "memory"); }
        return false;
    }
};
}

namespace at {
constexpr int NW = 8, QBLK = 32, QB = 256, KVBLK = 64;
constexpr int KSLOT = 12288, VSLOT = 8192;
constexpr int LDS_K = 0, LDS_V = 2 * KSLOT, LDS_WS = LDS_V + 2 * VSLOT, LDS_OST = LDS_WS + NW * 64 * 4, LDS_TOTAL = LDS_OST + NW * 4096;
typedef LAS const char* lds_cptr;
__device__ __forceinline__ int crow(int r, int hi) { return (r & 3) + 8 * (r >> 2) + 4 * hi; }
__device__ __forceinline__ void glds16(const void* gsrc, unsigned lds_dst) { unsigned keep;
    asm volatile("s_mov_b32 %0, m0\n\ts_mov_b32 m0, %2\n\ts_nop 0\n\tglobal_load_lds_dwordx4 %1, off\n\ts_mov_b32 m0, %0" : "=&s"(keep) : "v"(gsrc), "s"(lds_dst) : "memory"); }
__device__ __forceinline__ void glds16s(const void* sbase, unsigned voff, unsigned lds_dst) { unsigned keep;
    asm volatile("s_mov_b32 %0, m0\n\ts_mov_b32 m0, %3\n\ts_nop 0\n\tglobal_load_lds_dwordx4 %1, %2\n\ts_mov_b32 m0, %0" : "=&s"(keep) : "v"(voff), "s"(sbase), "s"(lds_dst) : "memory"); }
#define AT_WAIT_BAR0() asm volatile("s_waitcnt vmcnt(0) lgkmcnt(0)\n\ts_barrier" ::: "memory")
__device__ __forceinline__ void cmask(f32x16& p0, f32x16& p1, int jb, int qrel, int hi) {
    const float NEG = -INFINITY; const int qh = qrel - 4 * hi - 64 * jb;
#pragma unroll
    for (int r = 0; r < 16; ++r) { const int c = (r & 3) + 8 * (r >> 2); if (c > qh) p0[r] = NEG; if (c + 32 > qh) p1[r] = NEG; }
}
template <int ND> __device__ __forceinline__ void qkt(f32x16& p0, f32x16& p1, lds_cptr kb, const bf16x8* qr) {
    f32x16 z0 = {}, z1 = {};
#pragma unroll
    for (int d0 = 0; d0 < ND; ++d0) {
        const bf16x8 b0 = *(const LAS bf16x8*)(kb + d0 * 2048), b1 = *(const LAS bf16x8*)(kb + d0 * 2048 + 512);
        z0 = __builtin_amdgcn_mfma_f32_32x32x16_bf16(b0, qr[d0], z0, 0, 0, 0); z1 = __builtin_amdgcn_mfma_f32_32x32x16_bf16(b1, qr[d0], z1, 0, 0, 0); }
    p0 = z0; p1 = z1;
}
__device__ __forceinline__ float rowmax(const f32x16& p0, const f32x16& p1) {
    float a = fmaxf(p0[0], p1[0]);
#pragma unroll
    for (int r = 1; r < 16; ++r) a = fmaxf(a, fmaxf(p0[r], p1[r]));
    auto rr = __builtin_amdgcn_permlane32_swap(__float_as_uint(a), __float_as_uint(a), false, false);
    return fmaxf(__uint_as_float(rr[0]), __uint_as_float(rr[1]));
}
__device__ __forceinline__ void pv(f32x16* o, int vb, bf16x8 pa0, bf16x8 pa1, bf16x8 pa2, bf16x8 pa3) {
#pragma unroll
    for (int d0 = 0; d0 < 2; ++d0) { s16x4 lo[4], hi[4];
#pragma unroll
        for (int ks = 0; ks < 4; ++ks) {
            asm volatile("ds_read_b64_tr_b16 %0,%1 offset:%c2" : "=&v"(lo[ks]) : "v"(vb), "i"(d0 * 4096 + ks * 1024) : "memory");
            asm volatile("ds_read_b64_tr_b16 %0,%1 offset:%c2" : "=&v"(hi[ks]) : "v"(vb), "i"(d0 * 4096 + ks * 1024 + 512) : "memory"); }
        asm volatile("s_waitcnt lgkmcnt(0)" ::: "memory"); __builtin_amdgcn_sched_barrier(0);
#define AT_PK(k) (bf16x8){lo[k][0], lo[k][1], lo[k][2], lo[k][3], hi[k][0], hi[k][1], hi[k][2], hi[k][3]}
        o[d0] = __builtin_amdgcn_mfma_f32_32x32x16_bf16(pa0, AT_PK(0), o[d0], 0, 0, 0);
        o[d0] = __builtin_amdgcn_mfma_f32_32x32x16_bf16(pa1, AT_PK(1), o[d0], 0, 0, 0);
        o[d0] = __builtin_amdgcn_mfma_f32_32x32x16_bf16(pa2, AT_PK(2), o[d0], 0, 0, 0);
        o[d0] = __builtin_amdgcn_mfma_f32_32x32x16_bf16(pa3, AT_PK(3), o[d0], 0, 0, 0);
#undef AT_PK
    }
}
struct MobaX { const unsigned* SELh; const unsigned short* lst; int lcnt, ltile; bf16* PO; float* PML; long qh0; };
template <int DQ, int MODE>
__device__ __forceinline__ void attn_unit(int qb, const bf16* Qh, int qp, const bf16* Kh, int kp, const bf16* Krh, const bf16* Vh, int vp, bf16* Oh, int op, const MobaX X, LAS char* shm, const int wave) {
    constexpr int ND = DQ / 16;
    const int lane = lane_id(), r32 = lane & 31, hi = lane >> 5; const int wid = wave;
    const int q0 = qb * QB;
    const int t0 = (MODE == 0) ? 0 : 4 * qb, NT = (MODE == 0) ? 4 * qb + 4 : 4;
    int srow = q0 + wid * QBLK + r32; bool valid = true;
    if (MODE == 2) { const int li = X.ltile * 256 + wid * QBLK + r32; valid = li < X.lcnt; srow = (int)X.lst[valid ? li : X.lcnt - 1]; }
    const unsigned lds0 = (unsigned)(uintptr_t)shm;
    LAS float* wsf = (LAS float*)(shm + LDS_WS) + wid * 64;
    const bf16* ksrc = Kh + (size_t)lane * kp + wid * 8;
    const bf16* krsrc = (DQ == 96) ? (Krh + (size_t)lane * 32 + (wid & 3) * 8) : nullptr;
    const bf16* vsrc = Vh + (size_t)(16 * (wid & 3) + (lane >> 2)) * vp + (wid >> 2) * 32 + (lane & 3) * 8;
    const unsigned kdst = lds0 + LDS_K + wid * 1024, krdst = lds0 + LDS_K + (8 + (wid & 3)) * 1024, vdst = lds0 + LDS_V + wid * 1024;
#define AT_DMA(t, s) do { glds16(ksrc + (size_t)(t0 + (t)) * KVBLK * kp, (unsigned)__builtin_amdgcn_readfirstlane(kdst + (s) * KSLOT)); \
        if (DQ == 96 && wid < 4) glds16(krsrc + (size_t)(t0 + (t)) * KVBLK * 32, (unsigned)__builtin_amdgcn_readfirstlane(krdst + (s) * KSLOT)); \
        glds16(vsrc + (size_t)(t0 + (t)) * KVBLK * vp, (unsigned)__builtin_amdgcn_readfirstlane(vdst + (s) * VSLOT)); } while (0)
    const int vb0 = (int)(lds0 + LDS_V) + ((lane >> 4) & 1) * 32 + (lane & 3) * 8 + (4 * hi + ((lane & 15) >> 2)) * 64;
    const lds_cptr kp0 = (lds_cptr)shm + LDS_K + hi * 1024 + r32 * 16;
    AT_DMA(0, 0);
    bf16x8 qr[ND];
#pragma unroll
    for (int d0 = 0; d0 < ND; ++d0) qr[d0] = *(const bf16x8*)(Qh + (size_t)srow * qp + d0 * 16 + hi * 8);
    float mrow = -1e30f, l_reg = 0.f; f32x16 o[2]; o[0] = f32x16{}; o[1] = f32x16{};
    const int qrel = wid * QBLK + r32;
    for (int t = 0; t < NT; ++t) {
        AT_WAIT_BAR0();
        const int sl = t & 1;
        if (t + 1 < NT) AT_DMA(t + 1, sl ^ 1);
        f32x16 p0, p1; qkt<ND>(p0, p1, kp0 + sl * KSLOT, qr);
        if (MODE != 2) { if (t >= NT - 4) cmask(p0, p1, t - (NT - 4), qrel, hi); }
        const float rm = rowmax(p0, p1);
        const float mnew = fmaxf(mrow, rm); const float alpha = __builtin_amdgcn_exp2f(mrow - mnew); mrow = mnew;
        float s = 0.f;
#pragma unroll
        for (int r = 0; r < 16; ++r) { p0[r] = __builtin_amdgcn_exp2f(p0[r] - mnew); p1[r] = __builtin_amdgcn_exp2f(p1[r] - mnew); s += p0[r] + p1[r]; }
        l_reg = l_reg * alpha + s;
        if (__any(alpha != 1.f)) {
            if (hi == 0) wsf[r32] = alpha;
            asm volatile("s_waitcnt lgkmcnt(0)" ::: "memory");
#pragma unroll
            for (int r = 0; r < 16; ++r) { const float a = wsf[crow(r, hi)]; o[0][r] *= a; o[1][r] *= a; }
        }
        v4u pw0, pw1, pw2, pw3;
        pw0 = (v4u){cvt_pk_bf16(p0[0], p0[1]), cvt_pk_bf16(p0[2], p0[3]), cvt_pk_bf16(p0[4], p0[5]), cvt_pk_bf16(p0[6], p0[7])};
        pw1 = (v4u){cvt_pk_bf16(p0[8], p0[9]), cvt_pk_bf16(p0[10], p0[11]), cvt_pk_bf16(p0[12], p0[13]), cvt_pk_bf16(p0[14], p0[15])};
        pw2 = (v4u){cvt_pk_bf16(p1[0], p1[1]), cvt_pk_bf16(p1[2], p1[3]), cvt_pk_bf16(p1[4], p1[5]), cvt_pk_bf16(p1[6], p1[7])};
        pw3 = (v4u){cvt_pk_bf16(p1[8], p1[9]), cvt_pk_bf16(p1[10], p1[11]), cvt_pk_bf16(p1[12], p1[13]), cvt_pk_bf16(p1[14], p1[15])};
        pv(o, vb0 + sl * VSLOT, __builtin_bit_cast(bf16x8, pw0), __builtin_bit_cast(bf16x8, pw1), __builtin_bit_cast(bf16x8, pw2), __builtin_bit_cast(bf16x8, pw3));
    }
    { auto rr = __builtin_amdgcn_permlane32_swap(__float_as_uint(l_reg), __float_as_uint(l_reg), false, false); l_reg = __uint_as_float(rr[0]) + __uint_as_float(rr[1]); }
    LAS int* wsi = (LAS int*)wsf;
    if (hi == 0) { wsf[32 + r32] = l_reg;
        if (MODE == 1) wsf[r32] = mrow;
        if (MODE == 2) { const unsigned sel = X.SELh[srow]; const int rank = __builtin_popcount(sel & ((1u << qb) - 1u)); const long pidx = (X.qh0 + (long)srow) * 3 + rank;
            wsi[r32] = valid ? (int)pidx : -1; if (valid) { X.PML[pidx * 2] = mrow; X.PML[pidx * 2 + 1] = l_reg; } } }
    asm volatile("s_waitcnt lgkmcnt(0)" ::: "memory");
    float rli[16];
#pragma unroll
    for (int r = 0; r < 16; ++r) rli[r] = 1.f / wsf[32 + crow(r, hi)];
    { LAS bf16* stg = (LAS bf16*)(shm + LDS_OST) + wid * 2048;
#pragma unroll
      for (int r = 0; r < 16; ++r) { const int orow = crow(r, hi);
#pragma unroll
        for (int d0 = 0; d0 < 2; ++d0) stg[orow * 64 + d0 * 32 + r32] = (bf16)f2bf(o[d0][r] * rli[r]); }
      asm volatile("s_waitcnt lgkmcnt(0)" ::: "memory");
#pragma unroll
      for (int i = 0; i < 4; ++i) { const int row = i * 8 + (lane >> 3), ch = lane & 7; const v4u v = *(const LAS v4u*)(stg + row * 64 + ch * 8);
          if (MODE == 0) { *(v4u*)(Oh + (size_t)(q0 + wid * QBLK + row) * op + ch * 8) = v; }
          else if (MODE == 2) { const int pid = wsi[row]; if (pid >= 0) *(v4u*)(X.PO + (size_t)pid * 64 + ch * 8) = v; }
          else { const int sq = q0 + wid * QBLK + row; const long qh = X.qh0 + (long)sq; const unsigned sel = X.SELh[sq]; const int np = __builtin_popcount(sel);
              const float m0 = wsf[row], l0 = wsf[32 + row];
              float mi[3], li[3]; v4u oi[3]; float mmax = m0;
#pragma unroll
              for (int k = 0; k < 3; ++k) { mi[k] = -1e30f; li[k] = 0.f; oi[k] = (v4u){0u, 0u, 0u, 0u};
                  if (k < np) { mi[k] = X.PML[(qh * 3 + k) * 2]; li[k] = X.PML[(qh * 3 + k) * 2 + 1]; oi[k] = *(const v4u*)(X.PO + (size_t)(qh * 3 + k) * 64 + ch * 8); }
                  mmax = fmaxf(mmax, mi[k]); }
              const float w0 = l0 * __builtin_amdgcn_exp2f(m0 - mmax); float wk[3], wsum = w0;
#pragma unroll
              for (int k = 0; k < 3; ++k) { wk[k] = li[k] * __builtin_amdgcn_exp2f(mi[k] - mmax); wsum += wk[k]; }
              const float inv = 1.f / wsum;
              float r8[8] = {bflo(v.x), bfhi(v.x), bflo(v.y), bfhi(v.y), bflo(v.z), bfhi(v.z), bflo(v.w), bfhi(v.w)};
#pragma unroll
              for (int e = 0; e < 8; ++e) r8[e] *= w0;
#pragma unroll
              for (int k = 0; k < 3; ++k) { const v4u u = oi[k]; r8[0] += wk[k] * bflo(u.x); r8[1] += wk[k] * bfhi(u.x); r8[2] += wk[k] * bflo(u.y); r8[3] += wk[k] * bfhi(u.y);
                  r8[4] += wk[k] * bflo(u.z); r8[5] += wk[k] * bfhi(u.z); r8[6] += wk[k] * bflo(u.w); r8[7] += wk[k] * bfhi(u.w); }
              v4u w; w.x = cvt_pk_bf16(r8[0] * inv, r8[1] * inv); w.y = cvt_pk_bf16(r8[2] * inv, r8[3] * inv); w.z = cvt_pk_bf16(r8[4] * inv, r8[5] * inv); w.w = cvt_pk_bf16(r8[6] * inv, r8[7] * inv);
              *(v4u*)(Oh + (size_t)sq * op + ch * 8) = w; } } }
    asm volatile("s_waitcnt lgkmcnt(0)\n\ts_barrier" ::: "memory");
#undef AT_DMA
}
constexpr int MB_K = 0, MB_V = 32768, MB_WS = 65536, MB_OST = MB_WS + NW * 256, MB_TOTAL = MB_OST + NW * 4096;
template <int TOFF>
__device__ __forceinline__ void pv4(f32x16 (&o)[2][2], int vb, const v4u p0, const v4u p1, const v4u p2, const v4u p3) {
#pragma unroll
    for (int d0 = 0; d0 < 2; ++d0) { s16x4 lo[4], hh[4];
#pragma unroll
        for (int ks = 0; ks < 4; ++ks) {
            asm volatile("ds_read_b64_tr_b16 %0,%1 offset:%c2" : "=&v"(lo[ks]) : "v"(vb), "i"(TOFF + d0 * 4096 + ks * 1024) : "memory");
            asm volatile("ds_read_b64_tr_b16 %0,%1 offset:%c2" : "=&v"(hh[ks]) : "v"(vb), "i"(TOFF + d0 * 4096 + ks * 1024 + 512) : "memory"); }
        asm volatile("s_waitcnt lgkmcnt(0)" ::: "memory"); __builtin_amdgcn_sched_barrier(0);
#define AT_PK(k) (bf16x8){lo[k][0], lo[k][1], lo[k][2], lo[k][3], hh[k][0], hh[k][1], hh[k][2], hh[k][3]}
        if (MOBA_PRIO & 2) __builtin_amdgcn_s_setprio(1);
        o[d0][0] = __builtin_amdgcn_mfma_f32_32x32x16_bf16(__builtin_bit_cast(bf16x8, p0), AT_PK(0), o[d0][0], 0, 0, 0);
        o[d0][1] = __builtin_amdgcn_mfma_f32_32x32x16_bf16(__builtin_bit_cast(bf16x8, p1), AT_PK(1), o[d0][1], 0, 0, 0);
        o[d0][0] = __builtin_amdgcn_mfma_f32_32x32x16_bf16(__builtin_bit_cast(bf16x8, p2), AT_PK(2), o[d0][0], 0, 0, 0);
        o[d0][1] = __builtin_amdgcn_mfma_f32_32x32x16_bf16(__builtin_bit_cast(bf16x8, p3), AT_PK(3), o[d0][1], 0, 0, 0);
        if (MOBA_PRIO & 2) __builtin_amdgcn_s_setprio(0);
#undef AT_PK
    }
}
template <int T>
__device__ __forceinline__ void mb_tile_qk(f32x16& P0, f32x16& P1, lds_cptr kp0, const bf16x8* qr, int tmax) {
    if (T <= tmax) { f32x16 z0 = {}, z1 = {}; if (MOBA_PRIO & 1) __builtin_amdgcn_s_setprio(1);
#pragma unroll
        for (int d0 = 0; d0 < 4; ++d0) { const bf16x8 b0 = *(const LAS bf16x8*)(kp0 + T * 8192 + d0 * 2048), b1 = *(const LAS bf16x8*)(kp0 + T * 8192 + d0 * 2048 + 512);
            z0 = __builtin_amdgcn_mfma_f32_32x32x16_bf16(b0, qr[d0], z0, 0, 0, 0); z1 = __builtin_amdgcn_mfma_f32_32x32x16_bf16(b1, qr[d0], z1, 0, 0, 0); }
        if (MOBA_PRIO & 1) __builtin_amdgcn_s_setprio(0); P0 = z0; P1 = z1;
    } else {
#pragma unroll
        for (int r = 0; r < 16; ++r) { P0[r] = -INFINITY; P1[r] = -INFINITY; } }
}
__device__ __forceinline__ void mb_exp_pack(const f32x16& Pt, float mx, float& l, v4u& w0, v4u& w1) {
    f32x16 e;
#pragma unroll
    for (int r = 0; r < 16; ++r) { e[r] = __builtin_amdgcn_exp2f(Pt[r] - mx); l += e[r]; }
    w0 = (v4u){cvt_pk_bf16(e[0], e[1]), cvt_pk_bf16(e[2], e[3]), cvt_pk_bf16(e[4], e[5]), cvt_pk_bf16(e[6], e[7])};
    w1 = (v4u){cvt_pk_bf16(e[8], e[9]), cvt_pk_bf16(e[10], e[11]), cvt_pk_bf16(e[12], e[13]), cvt_pk_bf16(e[14], e[15])};
}
__device__ __forceinline__ void moba_block(int jb, const bf16* Qh, const bf16* Kh, const bf16* Vh, const MobaX X, int g0, int g1, bool own, LAS char* shm, const int wave) {
    constexpr int qp = 512, kp = 512, vp = 512;
    const int lane = lane_id(), r32 = lane & 31, hi = lane >> 5; const int wid = wave;
    const unsigned lds0 = (unsigned)(uintptr_t)shm;
    LAS float* wsf = (LAS float*)(shm + MB_WS) + wid * 64;
    { const unsigned kvo = (unsigned)(lane * kp * 2 + wid * 16), vvo = (unsigned)((16 * (wid & 3) + (lane >> 2)) * vp * 2 + (wid >> 2) * 64 + (lane & 3) * 16);
      const char* kbase = (const char*)(Kh + (size_t)jb * 256 * kp); const char* vbase = (const char*)(Vh + (size_t)jb * 256 * vp);
#pragma unroll
      for (int t = 0; t < 4; ++t) { glds16s(kbase + (size_t)t * (KVBLK * kp * 2), kvo, (unsigned)__builtin_amdgcn_readfirstlane(lds0 + MB_K + t * 8192 + wid * 1024));
          glds16s(vbase + (size_t)t * (KVBLK * vp * 2), vvo, (unsigned)__builtin_amdgcn_readfirstlane(lds0 + MB_V + t * 8192 + wid * 1024)); } }
    const int vb0 = (int)(lds0 + MB_V) + ((lane >> 4) & 1) * 32 + (lane & 3) * 8 + (4 * hi + ((lane & 15) >> 2)) * 64;
    const lds_cptr kp0 = (lds_cptr)shm + MB_K + hi * 1024 + r32 * 16;
    int gi = g0 + wid; int srow = 0, srowN = 0; bool valid = true, validN = true; unsigned sel = 0u; bf16x8 qr[4];
#define MB_ROWS(dst, vdst, g_) do { const int li = (g_) * 32 + r32; vdst = li < X.lcnt; dst = (int)X.lst[vdst ? li : X.lcnt - 1]; } while (0)
#define MB_QLOAD(src) do { _Pragma("unroll") for (int d0 = 0; d0 < 4; ++d0) qr[d0] = *(const bf16x8*)(Qh + (size_t)(src) * qp + d0 * 16 + hi * 8); sel = X.SELh[src]; } while (0)
#define MB_OWNROW() do { srow = jb * 256 + wid * 32 + r32; valid = true; MB_QLOAD(srow); } while (0)
    if (gi < g1) { MB_ROWS(srow, valid, gi); if (gi + NW < g1) MB_ROWS(srowN, validN, gi + NW); MB_QLOAD(srow); } else if (own) MB_OWNROW();
    AT_WAIT_BAR0();
#define MB_GROUP(OWN) do { \
        const int tmax = (OWN) ? (wid >> 1) : 3; \
        const int csrow = srow; const bool cvalid = valid; const unsigned csel = sel; \
        f32x16 P0, P1, P2, P3, P4, P5, P6, P7; \
        mb_tile_qk<0>(P0, P1, kp0, qr, tmax); mb_tile_qk<1>(P2, P3, kp0, qr, tmax); mb_tile_qk<2>(P4, P5, kp0, qr, tmax); mb_tile_qk<3>(P6, P7, kp0, qr, tmax); \
        if (!(OWN)) { const int gn = gi + NW; if (gn < g1) { srow = srowN; valid = validN; MB_QLOAD(srow); if (gn + NW < g1) MB_ROWS(srowN, validN, gn + NW); } else if (own) MB_OWNROW(); } \
        if (OWN) { const int qrel = wid * 32 + r32; \
            if (tmax == 0) cmask(P0, P1, 0, qrel, hi); else if (tmax == 1) cmask(P2, P3, 1, qrel, hi); else if (tmax == 2) cmask(P4, P5, 2, qrel, hi); else cmask(P6, P7, 3, qrel, hi); } \
        float mx = -INFINITY; \
        _Pragma("unroll") for (int r = 0; r < 16; ++r) { mx = fmaxf(mx, fmaxf(fmaxf(P0[r], P1[r]), fmaxf(P2[r], P3[r]))); mx = fmaxf(mx, fmaxf(fmaxf(P4[r], P5[r]), fmaxf(P6[r], P7[r]))); } \
        { auto rr = __builtin_amdgcn_permlane32_swap(__float_as_uint(mx), __float_as_uint(mx), false, false); mx = fmaxf(__uint_as_float(rr[0]), __uint_as_float(rr[1])); } \
        float l_reg = 0.f; v4u w0, w1, w2, w3, w4, w5, w6, w7, w8, w9, w10, w11, w12, w13, w14, w15; \
        f32x16 o[2][2]; o[0][0] = f32x16{}; o[0][1] = f32x16{}; o[1][0] = f32x16{}; o[1][1] = f32x16{}; \
        mb_exp_pack(P0, mx, l_reg, w0, w1); mb_exp_pack(P1, mx, l_reg, w2, w3); \
        pv4<0>(o, vb0, w0, w1, w2, w3); \
        if (tmax >= 1) { mb_exp_pack(P2, mx, l_reg, w4, w5); mb_exp_pack(P3, mx, l_reg, w6, w7); pv4<8192>(o, vb0, w4, w5, w6, w7); } \
        if (tmax >= 2) { mb_exp_pack(P4, mx, l_reg, w8, w9); mb_exp_pack(P5, mx, l_reg, w10, w11); pv4<16384>(o, vb0, w8, w9, w10, w11); } \
        if (tmax >= 3) { mb_exp_pack(P6, mx, l_reg, w12, w13); mb_exp_pack(P7, mx, l_reg, w14, w15); pv4<24576>(o, vb0, w12, w13, w14, w15); } \
        { auto rr = __builtin_amdgcn_permlane32_swap(__float_as_uint(l_reg), __float_as_uint(l_reg), false, false); l_reg = __uint_as_float(rr[0]) + __uint_as_float(rr[1]); } \
        LAS int* wsi = (LAS int*)wsf; \
        if (hi == 0) { wsf[32 + r32] = l_reg; \
            const int rank = (OWN) ? 3 : __builtin_popcount(csel & ((1u << jb) - 1u)); const long pidx = (X.qh0 + (long)csrow) * 4 + rank; \
            wsi[r32] = cvalid ? (int)pidx : -1; if (cvalid) { X.PML[pidx * 2] = mx; X.PML[pidx * 2 + 1] = l_reg; } } \
        asm volatile("s_waitcnt lgkmcnt(0)" ::: "memory"); \
        float rli[16]; \
        _Pragma("unroll") for (int r = 0; r < 16; ++r) rli[r] = __builtin_amdgcn_rcpf(wsf[32 + crow(r, hi)]); \
        { unsigned stgb = (unsigned)(uintptr_t)(shm + MB_OST) + wid * 4096 + hi * 512 + r32 * 2; asm volatile("" : "+v"(stgb)); \
          LAS bf16* stg = (LAS bf16*)(shm + MB_OST) + wid * 2048; \
          _Pragma("unroll") for (int r = 0; r < 16; ++r) { \
            _Pragma("unroll") for (int d0 = 0; d0 < 2; ++d0) *(LAS bf16*)(uintptr_t)(stgb + ((r & 3) + 8 * (r >> 2)) * 128 + d0 * 64) = (bf16)f2bf((o[d0][0][r] + o[d0][1][r]) * rli[r]); } \
          asm volatile("s_waitcnt lgkmcnt(0)" ::: "memory"); \
          _Pragma("unroll") for (int i = 0; i < 4; ++i) { const int row = i * 8 + (lane >> 3), ch = lane & 7; const v4u v = *(const LAS v4u*)(stg + row * 64 + ch * 8); \
              const int pid = wsi[row]; if (pid >= 0) *(v4u*)(X.PO + (size_t)pid * 64 + ch * 8) = v; } \
          asm volatile("s_waitcnt lgkmcnt(0)" ::: "memory"); } \
    } while (0)
#pragma unroll 1
    for (; gi < g1; gi += NW) { MB_GROUP(0); }
    if (own) { MB_GROUP(1); }
#undef MB_GROUP
#undef MB_OWNROW
    asm volatile("s_waitcnt lgkmcnt(0)\n\ts_barrier" ::: "memory");
#undef MB_ROWS
#undef MB_QLOAD
}
}


namespace atm {
using at::crow; using at::glds16; using at::lds_cptr;
constexpr int NW = 8, QBLK = 32, QB = 256, KVBLK = 64, ND = 6;
constexpr int KSL = 12288, VSL = 8192;
constexpr int LDS_K = 0, LDS_V = 3 * KSL, LDS_WS = LDS_V + 3 * VSL, LDS_OST = LDS_WS + NW * 64 * 4, LDS_TOTAL = LDS_OST + NW * 4096;
#define ATM_SBAR() __builtin_amdgcn_sched_barrier(0)
#define ATM_WAIT_BAR(N) asm volatile("s_waitcnt vmcnt(" #N ") lgkmcnt(0)\n\ts_barrier" ::: "memory")
#define ATM_MFMA(a, b, c) __builtin_amdgcn_mfma_f32_32x32x16_bf16(a, b, c, 0, 0, 0)
__device__ __forceinline__ void cmask(f32x16& p0, f32x16& p1, int jb, int qrel, int hi) {
    const float NEG = -INFINITY; const int qh = qrel - 4 * hi - 64 * jb;
#pragma unroll
    for (int r = 0; r < 16; ++r) { const int c = (r & 3) + 8 * (r >> 2); if (c > qh) p0[r] = NEG; if (c + 32 > qh) p1[r] = NEG; }
}
__device__ __forceinline__ void kload2(bf16x8* kf, lds_cptr kp, int j) { kf[2 * j] = *(const LAS bf16x8*)(kp + j * 2048); kf[2 * j + 1] = *(const LAS bf16x8*)(kp + j * 2048 + 512); }
typedef short v4i16_t __attribute__((ext_vector_type(4)));
__device__ __forceinline__ s16x4 vtr(lds_cptr p) { return __builtin_bit_cast(s16x4, __builtin_amdgcn_ds_read_tr16_b64_v4i16((LAS v4i16_t*)p)); }
__device__ __forceinline__ unsigned cvtpk_s(float lo, float hi) { typedef float f2 __attribute__((ext_vector_type(2))); typedef __bf16 b2 __attribute__((ext_vector_type(2))); f2 v = {lo, hi}; b2 b = __builtin_convertvector(v, b2); return __builtin_bit_cast(unsigned, b); }
template <int THRL>
__device__ __forceinline__ void attn_unit_mla(int qb, const bf16* Qh, const bf16* Kh, const bf16* Krh, const bf16* Vh, bf16* Oh, LAS char* shm, const int wave) {
    constexpr int QP = QL, KP = DM, VP = DM, OP = DM;
    const int lane = lane_id(), r32 = lane & 31, hi = lane >> 5; const int wid = wave;
    const int q0 = qb * QB;
    const bf16* Qw = Qh + (size_t)(q0 + wid * QBLK) * QP;
    const unsigned lds0 = (unsigned)(uintptr_t)shm;
    LAS float* wsf = (LAS float*)(shm + LDS_WS) + wid * 64;
    const unsigned kvo = (unsigned)(lane * KP * 2 + wid * 16), krvo = (unsigned)(lane * 64 + (wid & 3) * 16), vvo = (unsigned)((16 * (wid & 3) + (lane >> 2)) * VP * 2 + (wid >> 2) * 64 + (lane & 3) * 16);
    const char* kbase = (const char*)Kh; const char* krbase = (const char*)Krh; const char* vbase = (const char*)Vh;
    const unsigned kdst = lds0 + LDS_K + wid * 1024, krdst = lds0 + LDS_K + (8 + (wid & 3)) * 1024, vdst = lds0 + LDS_V + wid * 1024;
#define DMA_K(t, sidx) do { at::glds16s(kbase + (size_t)(t) * (KVBLK * KP * 2), kvo, (unsigned)__builtin_amdgcn_readfirstlane(kdst + (sidx) * KSL)); at::glds16s(krbase + (size_t)(t) * (KVBLK * 64), krvo, (unsigned)__builtin_amdgcn_readfirstlane(krdst + (sidx) * KSL)); } while (0)
#define DMA_V(t, sidx) at::glds16s(vbase + (size_t)(t) * (KVBLK * VP * 2), vvo, (unsigned)__builtin_amdgcn_readfirstlane(vdst + (sidx) * VSL))
    const int vb0 = (int)(lds0 + LDS_V) + ((lane >> 4) & 1) * 32 + (lane & 3) * 8 + (4 * hi + ((lane & 15) >> 2)) * 64;
    bf16x8 kf[12];
    const lds_cptr shm3 = (lds_cptr)shm; const lds_cptr kp0 = shm3 + LDS_K + hi * 1024 + r32 * 16; const lds_cptr vp0 = shm3 + LDS_V + ((lane >> 4) & 1) * 32 + (lane & 3) * 8 + (4 * hi + ((lane & 15) >> 2)) * 64;
    const int NT = (q0 + QB) / KVBLK;
    DMA_K(0, 0); DMA_V(0, 0); DMA_K(1, 1);
    bf16x8 qr[ND];
#pragma unroll
    for (int d0 = 0; d0 < ND; ++d0) qr[d0] = *(const bf16x8*)(Qw + (size_t)r32 * QP + d0 * 16 + hi * 8);
    float mhat = 0.f, l_reg = 0.f; f32x16 o[2]; o[0] = f32x16{}; o[1] = f32x16{}; f32x16 negm = f32x16{};
    const int qrel = wid * QBLK + r32;
#define CMASK(P0, P1, t) do { int jb_ = (t) - (NT - 4); if (jb_ >= 0) cmask(P0, P1, jb_, qrel, hi); } while (0)
    bool resc = false;
#define RESC() do { if (resc) { asm volatile("s_waitcnt lgkmcnt(0)" ::: "memory"); \
      _Pragma("unroll") for (int d_ = 0; d_ < 2; ++d_) _Pragma("unroll") for (int r = 0; r < 16; ++r) o[d_][r] *= wsf[crow(r, hi)]; } } while (0)
    f32x16 pA0, pA1, pB0, pB1;
    int sl_prev = 0, sl_cur = 0, sl_next = 1;
#define ROT() do { sl_prev = sl_cur; sl_cur = sl_next; sl_next = (sl_next == 2) ? 0 : sl_next + 1; } while (0)
    DMA_K(2, 2);
    ATM_WAIT_BAR(5);
    { const lds_cptr kb = kp0; f32x16 z0 = {}, z1 = {};
#pragma unroll
      for (int d0 = 0; d0 < ND; ++d0) { const bf16x8 b0 = *(const LAS bf16x8*)(kb + d0 * 2048), b1 = *(const LAS bf16x8*)(kb + d0 * 2048 + 512); z0 = ATM_MFMA(b0, qr[d0], z0); z1 = ATM_MFMA(b1, qr[d0], z1); }
      pA0 = z0; pA1 = z1; }
    CMASK(pA0, pA1, 0);
    { float a = fmaxf(pA0[0], pA1[0]);
#pragma unroll
      for (int r = 1; r < 16; ++r) a = fmaxf(a, fmaxf(pA0[r], pA1[r]));
      auto rr = __builtin_amdgcn_permlane32_swap(__float_as_uint(a), __float_as_uint(a), false, false); mhat = fmaxf(__uint_as_float(rr[0]), __uint_as_float(rr[1])); }
#pragma unroll
    for (int r = 0; r < 16; ++r) { pA0[r] = __builtin_amdgcn_exp2f(pA0[r] - mhat); pA1[r] = __builtin_amdgcn_exp2f(pA1[r] - mhat); }
#pragma unroll
    for (int r = 0; r < 16; ++r) negm[r] = -mhat;
    asm volatile("" : "+v"(negm));
    ATM_WAIT_BAR(0);
    DMA_K(3, 0); DMA_V(1, 1);
    ROT();
#pragma unroll
    for (int j = 0; j < 6; ++j) kload2(kf, kp0 + sl_cur * KSL, j);
    ATM_WAIT_BAR(3);
    s16x4 vAl, vAh, vBl, vBh; v4u pw0, pw1, pw2, pw3;
#define PKW(P, B) cvtpk_s(P[B], P[B + 1])
#define PAF(k) __builtin_bit_cast(bf16x8, pw##k)
#define FRA (bf16x8){vAl[0], vAl[1], vAl[2], vAl[3], vAh[0], vAh[1], vAh[2], vAh[3]}
#define FRB (bf16x8){vBl[0], vBl[1], vBl[2], vBl[3], vBh[0], vBh[1], vBh[2], vBh[3]}
#define PIN(x) asm volatile("" : "+v"(x))
#define MX3(a, b, c) __builtin_fmaxf(__builtin_fmaxf((a), (b)), (c))
#define GAPA(MF, A0, A1, A2, A3, W0, W1, PW) do { MF; sacc += A0; sacc += A1; sacc += A2; sacc += A3; PIN(sacc); W0; W1; PIN(PW); ATM_SBAR(); } while (0)
#define EX(v) __builtin_amdgcn_exp2f(v)
#define GAPB(MF, X, B) do { MF; X[B] = EX(X[B]); X[B + 1] = EX(X[B + 1]); X[B + 2] = EX(X[B + 2]); X[B + 3] = EX(X[B + 3]); PIN(X); ATM_SBAR(); } while (0)
#define VRDA(i) do { vAl = vtr(vp_ + (((i) >> 2) * 4096 + ((i) & 3) * 1024)); vAh = vtr(vp_ + (((i) >> 2) * 4096 + ((i) & 3) * 1024 + 512)); } while (0)
#define VRDB(i) do { vBl = vtr(vp_ + (((i) >> 2) * 4096 + ((i) & 3) * 1024)); vBh = vtr(vp_ + (((i) >> 2) * 4096 + ((i) & 3) * 1024 + 512)); } while (0)
#define KRD(G, j) do { if (G) { kload2(kf, kp0 + sl_next * KSL, j); } } while (0)
#define STEP(C0, C1, P0, P1, t, GK, GV, GL) do { ATM_SBAR(); if (MLA_PRIO & 1) __builtin_amdgcn_s_setprio(1); \
    const lds_cptr vp_ = vp0 + sl_prev * VSL; \
    float sacc = (P0[0] + P0[1]); \
    GAPA(C0 = ATM_MFMA(kf[0], qr[0], negm), P0[2], P0[3], P0[4], P0[5],     pw0[0] = PKW(P0, 0), pw0[1] = PKW(P0, 2), pw0); \
    GAPA(C1 = ATM_MFMA(kf[1], qr[0], negm), P0[6], P0[7], P0[8], P0[9],     pw0[2] = PKW(P0, 4), pw0[3] = PKW(P0, 6), pw0); \
    GAPA(C0 = ATM_MFMA(kf[2], qr[1], C0),   P0[10], P0[11], P0[12], P0[13], pw1[0] = PKW(P0, 8), pw1[1] = PKW(P0, 10), pw1); \
    GAPA(C1 = ATM_MFMA(kf[3], qr[1], C1),   P0[14], P0[15], P1[0], P1[1],   pw1[2] = PKW(P0, 12), pw1[3] = PKW(P0, 14), pw1); \
    GAPA(C0 = ATM_MFMA(kf[4], qr[2], C0),   P1[2], P1[3], P1[4], P1[5],     pw2[0] = PKW(P1, 0), pw2[1] = PKW(P1, 2), pw2); \
    GAPA(C1 = ATM_MFMA(kf[5], qr[2], C1),   P1[6], P1[7], P1[8], P1[9],     pw2[2] = PKW(P1, 4), pw2[3] = PKW(P1, 6), pw2); \
    GAPA(C0 = ATM_MFMA(kf[6], qr[3], C0),   P1[10], P1[11], P1[12], P1[13], pw3[0] = PKW(P1, 8), pw3[1] = PKW(P1, 10), pw3); \
    GAPA(C1 = ATM_MFMA(kf[7], qr[3], C1),   P1[14], P1[15], 0.f, 0.f,       pw3[2] = PKW(P1, 12), pw3[3] = PKW(P1, 14), pw3); \
    C0 = ATM_MFMA(kf[8], qr[4], C0); ATM_SBAR(); C1 = ATM_MFMA(kf[9], qr[4], C1); ATM_SBAR(); C0 = ATM_MFMA(kf[10], qr[5], C0); ATM_SBAR(); C1 = ATM_MFMA(kf[11], qr[5], C1); \
    VRDA(0); ATM_SBAR(); \
    if (MLA_PRIO & 1) __builtin_amdgcn_s_setprio(0); l_reg += sacc; \
    if (GK) { DMA_K((t) + 3, sl_cur); } if (GV) { DMA_V((t) + 1, sl_next); } \
    CMASK(C0, C1, t); \
    { float a = MX3(C0[0], C0[1], C1[0]), b = MX3(C0[2], C0[3], C1[1]); a = MX3(a, C1[2], C1[3]); \
      _Pragma("unroll") for (int r = 4; r < 16; r += 4) { a = MX3(a, C0[r], C0[r + 1]); b = MX3(b, C0[r + 2], C0[r + 3]); a = MX3(a, C1[r], C1[r + 1]); b = MX3(b, C1[r + 2], C1[r + 3]); } \
      float rm = __builtin_fmaxf(a, b); { auto rr = __builtin_amdgcn_permlane32_swap(__float_as_uint(rm), __float_as_uint(rm), false, false); rm = __builtin_fmaxf(__uint_as_float(rr[0]), __uint_as_float(rr[1])); } \
      resc = false; \
      if (__builtin_expect(__any(rm > (float)THRL), 0)) { const float dl = __builtin_fmaxf(rm, 0.f); mhat += dl; \
        _Pragma("unroll") for (int r = 0; r < 16; ++r) { C0[r] -= dl; C1[r] -= dl; } \
        _Pragma("unroll") for (int r = 0; r < 16; ++r) negm[r] = -mhat; asm volatile("" : "+v"(negm)); \
        const float f = __builtin_amdgcn_exp2f(-dl); l_reg *= f; if (hi == 0) wsf[r32] = f; resc = true; } } \
    ATM_SBAR(); \
    if (MLA_PRIO & 2) __builtin_amdgcn_s_setprio(1); VRDB(4); ATM_SBAR(); GAPB(o[0] = ATM_MFMA(PAF(0), FRA, o[0]), C0, 0); \
    KRD(GL, 0); VRDA(1); ATM_SBAR(); GAPB(o[1] = ATM_MFMA(PAF(0), FRB, o[1]), C0, 4); \
    KRD(GL, 1); VRDB(5); ATM_SBAR(); GAPB(o[0] = ATM_MFMA(PAF(1), FRA, o[0]), C0, 8); \
    KRD(GL, 2); VRDA(2); ATM_SBAR(); GAPB(o[1] = ATM_MFMA(PAF(1), FRB, o[1]), C0, 12); \
    KRD(GL, 3); VRDB(6); ATM_SBAR(); GAPB(o[0] = ATM_MFMA(PAF(2), FRA, o[0]), C1, 0); \
    KRD(GL, 4); VRDA(3); ATM_SBAR(); GAPB(o[1] = ATM_MFMA(PAF(2), FRB, o[1]), C1, 4); \
    KRD(GL, 5); VRDB(7); ATM_SBAR(); GAPB(o[0] = ATM_MFMA(PAF(3), FRA, o[0]), C1, 8); \
    GAPB(o[1] = ATM_MFMA(PAF(3), FRB, o[1]), C1, 12); if (MLA_PRIO & 2) __builtin_amdgcn_s_setprio(0); \
    } while (0)
    int t = 1;
#undef CMASK
#define CMASK(P0, P1, t) do {} while (0)
    for (; t + 5 < NT; t += 2) {
        STEP(pB0, pB1, pA0, pA1, t, true, true, true);     ATM_WAIT_BAR(3); RESC(); ROT();
        STEP(pA0, pA1, pB0, pB1, t + 1, true, true, true); ATM_WAIT_BAR(3); RESC(); ROT();
    }
#undef CMASK
#define CMASK(P0, P1, t) do { int jb_ = (t) - (NT - 4); if (jb_ >= 0) cmask(P0, P1, jb_, qrel, hi); } while (0)
#define ENDW(tt) do { if ((tt) + 3 < NT) { ATM_WAIT_BAR(3); } else if ((tt) + 2 < NT) { ATM_WAIT_BAR(1); } else { ATM_WAIT_BAR(0); } } while (0)
    for (; t + 1 < NT; t += 2) {
        STEP(pB0, pB1, pA0, pA1, t, (t + 3 < NT), (t + 1 < NT), (t + 1 < NT));         ENDW(t);     RESC(); ROT();
        STEP(pA0, pA1, pB0, pB1, t + 1, (t + 4 < NT), (t + 2 < NT), (t + 2 < NT));     ENDW(t + 1); RESC(); ROT();
    }
    STEP(pB0, pB1, pA0, pA1, NT - 1, false, false, false); RESC();
    { float sacc = pB0[0] + pB0[1];
#pragma unroll
      for (int r = 2; r < 16; ++r) sacc += pB0[r];
#pragma unroll
      for (int r = 0; r < 16; ++r) sacc += pB1[r];
      l_reg += sacc;
      pw0 = (v4u){PKW(pB0, 0), PKW(pB0, 2), PKW(pB0, 4), PKW(pB0, 6)}; pw1 = (v4u){PKW(pB0, 8), PKW(pB0, 10), PKW(pB0, 12), PKW(pB0, 14)};
      pw2 = (v4u){PKW(pB1, 0), PKW(pB1, 2), PKW(pB1, 4), PKW(pB1, 6)}; pw3 = (v4u){PKW(pB1, 8), PKW(pB1, 10), PKW(pB1, 12), PKW(pB1, 14)};
      ATM_SBAR(); at::pv(o, vb0 + sl_cur * VSL, PAF(0), PAF(1), PAF(2), PAF(3)); }
#undef PKW
#undef PAF
#undef FRA
#undef FRB
#undef PIN
#undef MX3
#undef GAPA
#undef GAPB
#undef EX
#undef VRDA
#undef VRDB
#undef KRD
#undef STEP
#undef ENDW
    { auto rr = __builtin_amdgcn_permlane32_swap(__float_as_uint(l_reg), __float_as_uint(l_reg), false, false); l_reg = __uint_as_float(rr[0]) + __uint_as_float(rr[1]); }
    if (hi == 0) wsf[32 + r32] = l_reg;
    asm volatile("s_waitcnt lgkmcnt(0)" ::: "memory");
    float rli[16];
#pragma unroll
    for (int r = 0; r < 16; ++r) rli[r] = __builtin_amdgcn_rcpf(wsf[32 + crow(r, hi)]);
    bf16* Ow = Oh + (size_t)(q0 + wid * QBLK) * OP;
    { unsigned stgb = (unsigned)(uintptr_t)(shm + LDS_OST) + wid * 4096 + hi * 512 + r32 * 2; asm volatile("" : "+v"(stgb));
      LAS bf16* stg = (LAS bf16*)(shm + LDS_OST) + wid * 2048;
#pragma unroll
      for (int r = 0; r < 16; ++r) {
#pragma unroll
        for (int d0 = 0; d0 < 2; ++d0) *(LAS bf16*)(uintptr_t)(stgb + ((r & 3) + 8 * (r >> 2)) * 128 + d0 * 64) = (bf16)f2bf(o[d0][r] * rli[r]); }
      asm volatile("s_waitcnt lgkmcnt(0)" ::: "memory");
#pragma unroll
      for (int i = 0; i < 4; ++i) { const int row = i * 8 + (lane >> 3), ch = lane & 7; const v4u v = *(const LAS v4u*)(stg + row * 64 + ch * 8); *(v4u*)(Ow + (size_t)row * OP + ch * 8) = v; } }
    asm volatile("s_waitcnt lgkmcnt(0)\n\ts_barrier" ::: "memory");
#undef DMA_K
#undef DMA_V
#undef CMASK
#undef RESC
#undef ROT
}
}

#define XB_TMO      128
#define XB_XCNT(j)  (256  + 64 * (j))
#define XB_XSUB(j)  (1280 + 64 * (j))
#define XB_XGEN(j)  (2304 + 64 * (j))
#define XB_TOP      3328
#define XB_TOPGEN   3392
#define XCD_BAR_WORDS 3456
#define XB_SPIN_CAP (1u << 18)
__device__ __forceinline__ unsigned xb_ld(unsigned* p)              { return __hip_atomic_load(p, __ATOMIC_RELAXED, __HIP_MEMORY_SCOPE_AGENT); }
__device__ __forceinline__ unsigned xb_add(unsigned* p, unsigned v) { return __hip_atomic_fetch_add(p, v, __ATOMIC_RELAXED, __HIP_MEMORY_SCOPE_AGENT); }
__device__ __forceinline__ unsigned xb_xcc_id() { return (unsigned)__builtin_amdgcn_s_getreg((3 << 11) | 20) & 0xFu; }
#define XB_SPIN(cond, bar) do { unsigned _sp = 0; while (cond) { __builtin_amdgcn_s_sleep(1); \
    if ((++_sp & 255u) == 0u) { if (xb_ld(&(bar)[XB_TMO])) break; if (_sp > XB_SPIN_CAP) { atomicAdd(&(bar)[XB_TMO], 1u); break; } } } } while (0)
struct XcdBarrier { unsigned* bar; unsigned x; volatile LAS unsigned* st; };
__device__ __forceinline__ XcdBarrier xcd_barrier_post(unsigned* bar, volatile LAS unsigned* st, const bool leader) {
    XcdBarrier b; b.bar = bar; b.x = xb_xcc_id(); b.st = st;
    if (leader) (void)xb_add(&bar[XB_XCNT(b.x)], 1u);
    return b;
}
__device__ __forceinline__ void xcd_barrier_complete(unsigned* bar, unsigned x, unsigned& nloc, unsigned& nx) {
    const unsigned G = gridDim.x * gridDim.y * gridDim.z;
    unsigned sum, cnt, mine, sp = 0u;
    for (;;) {
        sum = 0u; cnt = 0u; mine = 0u;
#pragma unroll
        for (unsigned j = 0; j < 16; ++j) { const unsigned c = xb_ld(&bar[XB_XCNT(j)]); sum += c; cnt += (c > 0u) ? 1u : 0u; mine = (j == x) ? c : mine; }
        if (sum == G) break;
        __builtin_amdgcn_s_sleep(1);
        if ((++sp & 255u) == 0u) { if (xb_ld(&bar[XB_TMO])) break; if (sp > XB_SPIN_CAP) { atomicAdd(&bar[XB_TMO], 1u); break; } }
    }
    nloc = mine > 0u ? mine : 1u; nx = cnt > 0u ? cnt : 1u;
}
__device__ __forceinline__ void xcd_barrier(const XcdBarrier& b, const bool leader) {
    asm volatile("s_waitcnt vmcnt(0)" ::: "memory");
    __syncthreads();
    if (leader) {
        unsigned* bar = b.bar;
        __builtin_amdgcn_s_waitcnt(0);
        unsigned nloc = b.st[0], nx = b.st[1];
        if (nloc == 0u) { xcd_barrier_complete(bar, b.x, nloc, nx); b.st[0] = nloc; b.st[1] = nx; }
        const unsigned old = xb_add(&bar[XB_XSUB(b.x)], 1u);
        const unsigned gen = old / nloc;
        if (old + 1u == (gen + 1u) * nloc) {
            __builtin_amdgcn_fence(__ATOMIC_RELEASE, "agent");
            asm volatile("s_waitcnt vmcnt(0)" ::: "memory");
            const unsigned og = xb_add(&bar[XB_TOP], 1u);
            const unsigned tg = og / nx;
            if (og + 1u == (tg + 1u) * nx) xb_add(&bar[XB_TOPGEN], 1u);
            else XB_SPIN(xb_ld(&bar[XB_TOPGEN]) == tg, bar);
            __builtin_amdgcn_fence(__ATOMIC_ACQUIRE, "agent");
            xb_add(&bar[XB_XGEN(b.x)], 1u);
            asm volatile("s_waitcnt vmcnt(0)" ::: "memory");
        } else {
            XB_SPIN(xb_ld(&bar[XB_XGEN(b.x)]) == gen, bar);
            __builtin_amdgcn_fence(__ATOMIC_ACQUIRE, "agent");
            asm volatile("s_waitcnt vmcnt(0)" ::: "memory");
        }
    }
    __syncthreads();
}

struct Args { const float* in[19]; float* out; unsigned char* ws; int ph_lo, ph_hi; };
struct Frame { LAS unsigned char* lds; volatile LAS unsigned* MISC; gu32* ctl; int tid, lane, wave, vcu, G; };
#define CAS __attribute__((address_space(4)))
__device__ __forceinline__ Args ld_args() {
    const CAS char* ka = (const CAS char*)__builtin_amdgcn_kernarg_segment_ptr(); asm volatile("" : "+s"(ka));
    Args a;
#pragma unroll
    for (int i = 0; i < 19; ++i) a.in[i] = *(const float* const CAS*)(ka + 8 * i);
    a.out = *(float* const CAS*)(ka + 152); a.ws = *(unsigned char* const CAS*)(ka + 160); a.ph_lo = *(const CAS int*)(ka + 168); a.ph_hi = *(const CAS int*)(ka + 172);
    return a;
}

__device__ __forceinline__ float wave_sum(float v) {
#pragma unroll
    for (int o = 1; o < 64; o <<= 1) v += __shfl_xor(v, o);
    return v;
}
__device__ const double REV_A[16] = {0.15915494309189535, 0.0700865215877985, 0.03086376340470123, 0.013591370636193905, 0.005985185712713705, 0.002635675898667414, 0.001160663641240061, 0.0005111175045375439,
    0.00022507907903927653, 9.911730936901935e-05, 4.364795279280289e-05, 1.9221100684944863e-05, 8.464330808241401e-06, 3.727408601915352e-06, 1.6414262627950345e-06, 7.228293068832865e-07};
__device__ const double REV_B[8] = {0.15915494309189535, 0.03086376340470123, 0.005985185712713705, 0.001160663641240061, 0.00022507907903927653, 4.364795279280289e-05, 8.464330808241401e-06, 1.6414262627950345e-06};

__device__ __forceinline__ void tr_item(const float* W, int N, int k0, int n0s, bf16* WT, int drow0, int ldk, int koff, const float* gain, int mode, LAS float* scr, int lane) {
    float w[32];
#pragma unroll
    for (int i = 0; i < 32; ++i) w[i] = W[(size_t)(k0 + 2 * i + (lane >> 5)) * N + n0s + (lane & 31)];
#pragma unroll
    for (int i = 0; i < 32; ++i) scr[(2 * i + (lane >> 5)) * 33 + (lane & 31)] = w[i];
    LDS_WAIT(); asm volatile("" ::: "memory");
    const int c = lane & 7;
    f32x4 g0 = (f32x4){1.f, 1.f, 1.f, 1.f}, g1 = g0;
    if (gain) { g0 = *(const f32x4*)(gain + k0 + 8 * c); g1 = *(const f32x4*)(gain + k0 + 8 * c + 4); }
#pragma unroll
    for (int j = 0; j < 4; ++j) { const int n = (lane >> 3) + 8 * j;
        int sn = n;
        if (mode == 1) sn = (n < 16) ? ((n & 1) ? (n >> 1) + 8 : (n >> 1)) : n;
        else if (mode == 2) sn = 4 * (n >> 3) + ((n & 7) >> 1) + 16 * (n & 1);
        const LAS float* s = scr + (8 * c) * 33 + sn;
        v4u o; o.x = pk2(s[0 * 33] * g0[0], s[1 * 33] * g0[1]); o.y = pk2(s[2 * 33] * g0[2], s[3 * 33] * g0[3]); o.z = pk2(s[4 * 33] * g1[0], s[5 * 33] * g1[1]); o.w = pk2(s[6 * 33] * g1[2], s[7 * 33] * g1[3]);
        *(GAS v4u*)(WT + (size_t)(drow0 + n) * ldk + koff + k0 + 8 * c) = o; }
    LDS_WAIT(); asm volatile("" ::: "memory");
}

__device__ __forceinline__ void p0_prologue(const Frame& F0, const Args& A) {
    Frame F = F0; F.lane = lane_id(); F.tid = F.wave * 64 + F.lane;
    unsigned char* ws = A.ws;
    LAS float* scr = (LAS float*)(F.lds + F.wave * 16384);
    const int gw = F.vcu * NWAVES + F.wave, NGW = F.G * NWAVES, lane = F.lane;
    bf16* Win = (bf16*)(ws + WS_WIN); bf16* Wuq = (bf16*)(ws + WS_WUQ); bf16* Wukv = (bf16*)(ws + WS_WUKV); bf16* Wo = (bf16*)(ws + WS_WO); bf16* Wout = (bf16*)(ws + WS_WOUT);
    bf16* Wgu = (bf16*)(ws + WS_WGU); bf16* Wd = (bf16*)(ws + WS_WD);
    constexpr int I_IN = 16 * 145, I_UQ = 12 * 24, I_UKV = 4 * 32, I_O = 8 * 32, I_OUT = 16 * 32, I_G = 32 * 128, I_D = 32 * 128;
    constexpr int NITEMS = I_IN + I_UQ + I_UKV + 2 * I_O + I_OUT + 2 * I_G + I_D;
    for (int it = gw; it < NITEMS; it += NGW) {
        int r = it;
        if (r < I_IN) { const int kb = r / 145, nb = r % 145, s0 = 32 * nb; int drow0, mode = 0;
            if (s0 < 1024) drow0 = s0;
            else if (s0 < 1056) { drow0 = 4608; mode = 2; }
            else if (s0 < 1568) { const int j = s0 - 1056; drow0 = 1024 + j; mode = ((j & 63) == 0) ? 1 : 0; }
            else if (s0 < 2080) { const int j = s0 - 1568; drow0 = 1536 + j; mode = ((j & 63) == 0) ? 1 : 0; }
            else if (s0 < 2592) drow0 = 2048 + (s0 - 2080);
            else if (s0 < 3616) { const int j = s0 - 2592; drow0 = 2560 + (j >> 7) * 256 + (j & 127); }
            else { const int j = s0 - 3616; drow0 = 2560 + (j >> 7) * 256 + 128 + (j & 127); }
            tr_item(A.in[2], 4640, 64 * kb, s0, Win, drow0, 1024, 0, nullptr, mode, scr, lane); continue; } r -= I_IN;
        if (r < I_UQ) { const int kb = r / 24, nb = r % 24; tr_item(A.in[4], 768, 64 * kb, 32 * nb, Wuq, 32 * nb, 768, 0, A.in[3], (nb % 3 == 2) ? 2 : 0, scr, lane); continue; } r -= I_UQ;
        if (r < I_UKV) { const int kb = r / 32, nb = r % 32; tr_item(A.in[6], 1024, 64 * kb, 32 * nb, Wukv, 32 * nb, 256, 0, A.in[5], 0, scr, lane); continue; } r -= I_UKV;
        if (r < I_O) { const int kb = r / 32, nb = r % 32; tr_item(A.in[7], 1024, 64 * kb, 32 * nb, Wo, 32 * nb, 1024, 0, nullptr, 0, scr, lane); continue; } r -= I_O;
        if (r < I_O) { const int kb = r / 32, nb = r % 32; tr_item(A.in[8], 1024, 64 * kb, 32 * nb, Wo, 32 * nb, 1024, 512, nullptr, 0, scr, lane); continue; } r -= I_O;
        if (r < I_OUT) { const int kb = r / 32, nb = r % 32; tr_item(A.in[9], 1024, 64 * kb, 32 * nb, Wout, 32 * nb, 1024, 0, nullptr, 0, scr, lane); continue; } r -= I_OUT;
        if (r < 2 * I_G) { const int up = r >= I_G; if (up) r -= I_G; const int e = r >> 7, q = r & 127, kb = q >> 3, nb = q & 7, s0 = 32 * nb;
            const int drow0 = e * 512 + (s0 >> 7) * 256 + up * 128 + (s0 & 127);
            tr_item(A.in[up ? 16 : 15] + (size_t)e * 1024 * 256, 256, 64 * kb, s0, Wgu, drow0, 1024, 0, A.in[10], 0, scr, lane); continue; } r -= 2 * I_G;
        { const int e = r >> 7, q = r & 127, kb = q >> 5, nb = q & 31;
            tr_item(A.in[17] + (size_t)e * 256 * 1024, 1024, 64 * kb, 32 * nb, Wd, e * 1024 + 32 * nb, 256, 0, nullptr, 0, scr, lane); }
    }
    { const int gt = F.vcu * 512 + F.tid, NT_ = F.G * 512; GAS v4u* z = (GAS v4u*)(Win + (size_t)4640 * 1024);
      for (int i = gt; i < 224 * 1024 / 8; i += NT_) z[i] = (v4u){0u, 0u, 0u, 0u}; }
    { const int gt = F.vcu * 512 + F.tid, NT_ = F.G * 512; float* CA = (float*)(ws + WS_COSA); float* SA_ = (float*)(ws + WS_SINA); float* CB = (float*)(ws + WS_COSB); float* SB_ = (float*)(ws + WS_SINB);
      for (int i = gt; i < SEQ * 24; i += NT_) { const int pos = i / 24, j = i % 24; const double rv = (double)pos * (j < 16 ? REV_A[j] : REV_B[j - 16]);
          const float fr = (float)(rv - __builtin_floor(rv)); const float c = __builtin_amdgcn_cosf(fr), s = __builtin_amdgcn_sinf(fr);
          if (j < 16) { CA[pos * 16 + j] = c; SA_[pos * 16 + j] = s; } else { CB[pos * 8 + j - 16] = c; SB_[pos * 8 + j - 16] = s; } } }
    { const float* x = A.in[0]; const float* g = A.in[1]; bf16* XN = (bf16*)(ws + WS_XN);
      f32x4 gv[4];
#pragma unroll
      for (int j = 0; j < 4; ++j) gv[j] = ((const GAS f32x4*)g)[lane + 64 * j];
      constexpr int RPT = P0_RPT;
      for (int m0 = gw; m0 < M; m0 += RPT * NGW) { f32x4 v[RPT][4];
#pragma unroll
          for (int q = 0; q < RPT; ++q) { const int m = (m0 + q * NGW < M) ? m0 + q * NGW : m0;
#pragma unroll
              for (int j = 0; j < 4; ++j) v[q][j] = ((const GAS f32x4*)(x + (size_t)m * DM) + lane)[64 * j]; }
#pragma unroll
          for (int q = 0; q < RPT; ++q) { const int m = m0 + q * NGW; if (m < M) { float s = 0.f;
#pragma unroll
              for (int j = 0; j < 4; ++j) s += dot4(v[q][j]);
              const float rs = 1.f / sqrtf(wave_sum(s) * (1.f / DM) + EPS);
              GAS unsigned long long* o8 = (GAS unsigned long long*)(XN + (size_t)m * DM) + lane;
#pragma unroll
              for (int j = 0; j < 4; ++j) { const f32x4 y = v[q][j] * rs * gv[j]; o8[64 * j] = (unsigned long long)pk2(y[0], y[1]) | ((unsigned long long)pk2(y[2], y[3]) << 32); } } } } }
}

__device__ __forceinline__ void moba_select(const Frame& F0, const Args& A) {
    Frame F = F0; F.lane = lane_id(); F.tid = F.wave * 64 + F.lane;
    unsigned char* ws = A.ws; const float* KSUM = (const float*)(ws + WS_KSUM); const bf16* QB = (const bf16*)(ws + WS_QB); unsigned* SEL = (unsigned*)(ws + WS_SEL);
    LAS unsigned char* KMH = F.lds; LAS unsigned char* KML = F.lds + 4096;
    const int lane = F.lane, r32 = lane & 31, hi = lane >> 5, wid = F.wave;
    for (int unit = F.vcu; unit < 512; unit += F.G) { const int bh = unit >> 3, qg = unit & 7, b = bh >> 3, h = bh & 7;
        __syncthreads();
        { const int idx = F.tid * 4, n = idx >> 6, d = idx & 63, pm = b * 32 + n;
          const f32x4 k0 = *(const f32x4*)(KSUM + (size_t)pm * 512 + h * 64 + d), k1 = *(const f32x4*)(KSUM + (size_t)(256 + pm) * 512 + h * 64 + d);
          unsigned hw[4], lw[4];
#pragma unroll
          for (int j = 0; j < 4; ++j) { const float v = (k0[j] + k1[j]) * (1.f / 256.f); hw[j] = f2bf(v); lw[j] = f2bf(v - __builtin_bit_cast(float, hw[j] << 16)); }
          const int off = (d >> 3) * 512 + n * 16 + (d & 7) * 2;
          *(LAS unsigned long long*)(KMH + off) = (unsigned long long)(hw[0] | (hw[1] << 16)) | ((unsigned long long)(hw[2] | (hw[3] << 16)) << 32);
          *(LAS unsigned long long*)(KML + off) = (unsigned long long)(lw[0] | (lw[1] << 16)) | ((unsigned long long)(lw[2] | (lw[3] << 16)) << 32); }
        __syncthreads();
        unsigned msk[4];
#pragma unroll
        for (int p = 0; p < 4; ++p) { const int own = 4 * qg + p; const int s = own * 256 + wid * 32 + r32; unsigned mask;
            if (own < 4) mask = (1u << own) - 1u;
            else {
                const bf16* qrow = QB + ((size_t)b * SEQ + s) * 512 + h * 64;
                f32x16 g = {};
#pragma unroll
                for (int d0 = 0; d0 < 4; ++d0) { const bf16x8 q = *(const bf16x8*)(qrow + d0 * 16 + hi * 8);
                    const bf16x8 kh = *(const LAS bf16x8*)(KMH + (2 * d0 + hi) * 512 + r32 * 16), kl = *(const LAS bf16x8*)(KML + (2 * d0 + hi) * 512 + r32 * 16);
                    g = __builtin_amdgcn_mfma_f32_32x32x16_bf16(kl, q, g, 0, 0, 0); g = __builtin_amdgcn_mfma_f32_32x32x16_bf16(kh, q, g, 0, 0, 0); }
                float v1 = -INFINITY, v2 = -INFINITY, v3 = -INFINITY; int i1 = 99, i2 = 99, i3 = 99;
#pragma unroll
                for (int r = 0; r < 16; ++r) { const int n = (r & 3) + 8 * (r >> 2) + 4 * hi; const float v = (n < own) ? g[r] : -INFINITY;
                    if (v > v1) { v3 = v2; i3 = i2; v2 = v1; i2 = i1; v1 = v; i1 = n; } else if (v > v2) { v3 = v2; i3 = i2; v2 = v; i2 = n; } else if (v > v3) { v3 = v; i3 = n; } }
                float pv_[3] = {__shfl_xor(v1, 32), __shfl_xor(v2, 32), __shfl_xor(v3, 32)}; int pi_[3] = {__shfl_xor(i1, 32), __shfl_xor(i2, 32), __shfl_xor(i3, 32)};
#pragma unroll
                for (int k = 0; k < 3; ++k) { const float v = pv_[k]; const int n = pi_[k];
#define MS_BETTER(va, ia, vb, ib) ((va) > (vb) || ((va) == (vb) && (ia) < (ib)))
                    if (MS_BETTER(v, n, v1, i1)) { v3 = v2; i3 = i2; v2 = v1; i2 = i1; v1 = v; i1 = n; } else if (MS_BETTER(v, n, v2, i2)) { v3 = v2; i3 = i2; v2 = v; i2 = n; } else if (MS_BETTER(v, n, v3, i3)) { v3 = v; i3 = n; } }
#undef MS_BETTER
                mask = (1u << i1) | (1u << i2) | (1u << i3);
            }
            msk[p] = mask;
            if (hi == 0) SEL[(size_t)bh * SEQ + s] = mask; }
        int lp[4][3];
#pragma unroll
        for (int p = 0; p < 4; ++p) { unsigned mm = (hi == 0) ? msk[p] : 0u;
#pragma unroll
            for (int k = 0; k < 3; ++k) { lp[p][k] = 0; if (mm) { const int j = __builtin_ctz(mm); mm &= mm - 1u; lp[p][k] = (int)__hip_atomic_fetch_add((LAS unsigned*)(F.MISC + MI_HIST + j), 1u, __ATOMIC_RELAXED, __HIP_MEMORY_SCOPE_WORKGROUP); } } }
        __syncthreads();
        if (F.tid < 32) { const unsigned n = F.MISC[MI_HIST + F.tid]; F.MISC[MI_BASE + F.tid] = n ? xb_add((unsigned*)(F.ctl + CW_MCNT + bh * 32 + F.tid), n) : 0u; }
        __syncthreads();
        { unsigned short* LQ = (unsigned short*)(ws + WS_LISTQ) + (size_t)bh * LQ_PER_BH;
#pragma unroll
          for (int p = 0; p < 4; ++p) { unsigned mm = (hi == 0) ? msk[p] : 0u; const int s = (4 * qg + p) * 256 + wid * 32 + r32;
#pragma unroll
              for (int k = 0; k < 3; ++k) if (mm) { const int j = __builtin_ctz(mm); mm &= mm - 1u; LQ[256 * (31 * j - j * (j - 1) / 2) + (int)F.MISC[MI_BASE + j] + lp[p][k]] = (unsigned short)s; } } }
        __syncthreads();
        if (F.tid < 32) F.MISC[MI_HIST + F.tid] = 0u;
    }
    __syncthreads();
}

__device__ __forceinline__ void router_phase(const Frame& F0, const Args& A) {
    Frame F = F0; F.lane = lane_id(); F.tid = F.wave * 64 + F.lane;
    unsigned char* ws = A.ws; const bf16* X2H = (const bf16*)(ws + WS_X2B); const bf16* X2Lo = (const bf16*)(ws + WS_X2L); const float* SSQ_X = (const float*)(ws + WS_SSQX);
    const float* gain = A.in[10]; const float* wrg = A.in[11]; const float* brg = A.in[12]; const float* wre = A.in[13]; const float* bre = A.in[14];
    float* TOKW = (float*)(ws + WS_TOKW); float* RS = (float*)(ws + WS_RS); int* LIST = (int*)(ws + WS_LIST); unsigned* CNT = (unsigned*)(F.ctl + CW_CNT);
    LAS float* Wl = (LAS float*)F.lds;
    const int tid = F.tid, lane = F.lane, wid = F.wave, fr = lane & 15, fq = lane >> 4;
    for (int tw = F.vcu; tw < M / 256; tw += F.G) { const int tok0 = tw * 256;
        f32x4 acc[2][3];
#pragma unroll
        for (int a = 0; a < 2; ++a)
#pragma unroll
            for (int b = 0; b < 3; ++b) acc[a][b] = (f32x4){0.f, 0.f, 0.f, 0.f};
        LAS bf16* Wh = (LAS bf16*)F.lds; LAS bf16* Wo = Wh + 48 * 520;
        for (int c2 = 0; c2 < 2 * NREP(6); ++c2) { const int c = c2 & 1;
            __syncthreads();
            { const int k = c * 512 + tid; const float g = gain[k];
#define RT_PUT(n, val) do { const float w_ = (val) * g; const unsigned h_ = f2bf(w_); Wh[(n) * 520 + tid] = (bf16)h_; Wo[(n) * 520 + tid] = (bf16)f2bf(w_ - __builtin_bit_cast(float, h_ << 16)); } while (0)
              const f32x4 w4 = *(const f32x4*)(wrg + (size_t)k * 4);
#pragma unroll
              for (int n = 0; n < 4; ++n) RT_PUT(n, w4[n]);
#pragma unroll
              for (int gi = 0; gi < 4; ++gi) { const f32x4 e0 = *(const f32x4*)(wre + ((size_t)gi * 1024 + k) * 8), e1 = *(const f32x4*)(wre + ((size_t)gi * 1024 + k) * 8 + 4);
#pragma unroll
                  for (int j = 0; j < 4; ++j) { RT_PUT(4 + gi * 8 + j, e0[j]); RT_PUT(4 + gi * 8 + 4 + j, e1[j]); } }
#pragma unroll
              for (int n = 36; n < 48; ++n) { Wh[n * 520 + tid] = 0; Wo[n * 520 + tid] = 0; }
#undef RT_PUT
            }
            __syncthreads();
            const size_t xo0 = (size_t)(tok0 + wid * 32 + fr) * DM + c * 512 + 8 * fq;
#pragma unroll 2
            for (int s = 0; s < 16; ++s) {
                bf16x8 xh[2], xl[2], wh[3], wl[3];
#pragma unroll
                for (int mb = 0; mb < 2; ++mb) { xh[mb] = *(const bf16x8*)(X2H + xo0 + (size_t)mb * 16 * DM + 32 * s);
#if !RES_BF16
                    xl[mb] = *(const bf16x8*)(X2Lo + xo0 + (size_t)mb * 16 * DM + 32 * s);
#endif
                    }
#pragma unroll
                for (int nb = 0; nb < 3; ++nb) { wh[nb] = *(const LAS bf16x8*)(Wh + (16 * nb + fr) * 520 + 32 * s + 8 * fq); wl[nb] = *(const LAS bf16x8*)(Wo + (16 * nb + fr) * 520 + 32 * s + 8 * fq); }
#pragma unroll
                for (int mb = 0; mb < 2; ++mb)
#pragma unroll
                    for (int nb = 0; nb < 3; ++nb) {
#if !RES_BF16
                        acc[mb][nb] = __builtin_amdgcn_mfma_f32_16x16x32_bf16(xl[mb], wh[nb], acc[mb][nb], 0, 0, 0);
#endif
                        acc[mb][nb] = __builtin_amdgcn_mfma_f32_16x16x32_bf16(xh[mb], wl[nb], acc[mb][nb], 0, 0, 0);
                        acc[mb][nb] = __builtin_amdgcn_mfma_f32_16x16x32_bf16(xh[mb], wh[nb], acc[mb][nb], 0, 0, 0); }
            }
        }
        __syncthreads();
#pragma unroll
        for (int mb = 0; mb < 2; ++mb)
#pragma unroll
            for (int nb = 0; nb < 3; ++nb)
#pragma unroll
                for (int i = 0; i < 4; ++i) Wl[(wid * 32 + mb * 16 + 4 * fq + i) * 49 + nb * 16 + fr] = acc[mb][nb][i] * (1.f / NREP(6));
        if (tid < 32) F.MISC[MI_HIST + tid] = 0u;
        __syncthreads();
        int e1 = 0, e2 = 0, lp1 = 0, lp2 = 0; float wt1 = 0.f, wt2 = 0.f;
        if (tid < 256) { const int T = tok0 + tid; const LAS float* lg = Wl + tid * 49;
            const f32x4 q0 = *(const f32x4*)(SSQ_X + (size_t)T * 16), q1 = *(const f32x4*)(SSQ_X + (size_t)T * 16 + 4), q2 = *(const f32x4*)(SSQ_X + (size_t)T * 16 + 8), q3 = *(const f32x4*)(SSQ_X + (size_t)T * 16 + 12);
            float ss = 0.f;
#pragma unroll
            for (int j = 0; j < 4; ++j) ss += q0[j];
#pragma unroll
            for (int j = 0; j < 4; ++j) ss += q1[j];
#pragma unroll
            for (int j = 0; j < 4; ++j) ss += q2[j];
#pragma unroll
            for (int j = 0; j < 4; ++j) ss += q3[j];
            const float rs = 1.f / sqrtf(ss * (1.f / DM) + EPS);
            RS[T] = rs;
            float g0 = lg[0] * rs + brg[0], g1 = lg[1] * rs + brg[1], g2 = lg[2] * rs + brg[2], g3 = lg[3] * rs + brg[3];
            int g = 0; float mx = g0; if (g1 > mx) { mx = g1; g = 1; } if (g2 > mx) { mx = g2; g = 2; } if (g3 > mx) { mx = g3; g = 3; }
            const float pg = 1.f / (__expf(g0 - mx) + __expf(g1 - mx) + __expf(g2 - mx) + __expf(g3 - mx));
            float v1 = -INFINITY, v2 = -INFINITY; int i1 = 0, i2 = 0;
#pragma unroll
            for (int j = 0; j < 8; ++j) { const float v = lg[4 + 8 * g + j] * rs + bre[8 * g + j];
                if (v > v1) { v2 = v1; i2 = i1; v1 = v; i1 = j; } else if (v > v2) { v2 = v; i2 = j; } }
            const float w1 = 1.f / (1.f + __expf(v2 - v1));
            wt1 = pg * w1; wt2 = pg * (1.f - w1); e1 = 8 * g + i1; e2 = 8 * g + i2;
            lp1 = (int)__hip_atomic_fetch_add((LAS unsigned*)(F.MISC + MI_HIST + e1), 1u, __ATOMIC_RELAXED, __HIP_MEMORY_SCOPE_WORKGROUP);
            lp2 = (int)__hip_atomic_fetch_add((LAS unsigned*)(F.MISC + MI_HIST + e2), 1u, __ATOMIC_RELAXED, __HIP_MEMORY_SCOPE_WORKGROUP);
        }
        __syncthreads();
        if (tid < 32) { const unsigned n = F.MISC[MI_HIST + tid]; F.MISC[MI_BASE + tid] = n ? xb_add((unsigned*)&CNT[tid], n) : 0u; }
        __syncthreads();
        if (tid < 256) { const int T = tok0 + tid;
            const int p1 = (int)F.MISC[MI_BASE + e1] + lp1, p2 = (int)F.MISC[MI_BASE + e2] + lp2;
            LIST[(size_t)e1 * LCAP + p1] = 2 * T; LIST[(size_t)e2 * LCAP + p2] = 2 * T + 1;
            TOKW[2 * T] = wt1; TOKW[2 * T + 1] = wt2; }
    }
    __syncthreads();
}

__device__ __forceinline__ void moe_tile_table(const Frame& F0) {
    Frame F = F0; F.lane = lane_id(); F.tid = F.wave * 64 + F.lane;
    __syncthreads();
    if (F.tid == 0) { int acc = 0; for (int e = 0; e < 32; ++e) { F.MISC[MI_TS + e] = (unsigned)acc; const unsigned c = __hip_atomic_load((unsigned*)(F.ctl + CW_CNT + e), RLX_AGENT); acc += (int)((c + 255u) >> 8); } F.MISC[MI_TS + 32] = (unsigned)acc; }
    __syncthreads();
}
__device__ __forceinline__ void gather_phase(const Frame& F0, const Args& A) {
    Frame F = F0; F.lane = lane_id(); F.tid = F.wave * 64 + F.lane;
    unsigned char* ws = A.ws; const int* LIST = (const int*)(ws + WS_LIST);
    int* SLOT_A = (int*)(ws + WS_SLOTA); int* SLOT_TOK = (int*)(ws + WS_SLOTTOK); float* SLOT_RS = (float*)(ws + WS_SLOTRS); const float* RS = (const float*)(ws + WS_RS);
    const int ntile = (int)F.MISC[MI_TS + 32];
    for (int i2 = 0; (long)F.vcu + (long)i2 * F.G < 2L * ntile; i2 += 2) { const long L = (long)F.vcu + (long)(i2 + (F.tid >> 8)) * F.G; if (L >= 2L * ntile) continue; const int st = (int)(L >> 1);
        int e = 0; for (int k = 1; k < 32; ++k) e += (st >= (int)F.MISC[MI_TS + k]) ? 1 : 0;
        const int cnt = (int)__hip_atomic_load((unsigned*)(F.ctl + CW_CNT + e), RLX_AGENT); const int r = F.tid & 255, p = (st - (int)F.MISC[MI_TS + e]) * 256 + r, slot = st * 256 + r;
        int a = -1; float rs = 0.f; if (p < cnt) { a = LIST[(size_t)e * LCAP + p]; rs = RS[a >> 1]; }
        SLOT_A[slot] = a; SLOT_TOK[slot] = a >> 1; SLOT_RS[slot] = rs; }
}
__device__ __forceinline__ void final_phase(const Frame& F0, const Args& A, float* DST) {
    Frame F = F0; F.lane = lane_id(); F.tid = F.wave * 64 + F.lane;
    unsigned char* ws = A.ws; const bf16* X2H = (const bf16*)(ws + WS_X2B); const bf16* X2Lo = (const bf16*)(ws + WS_X2L); const bf16* Y = (const bf16*)(ws + WS_Y); const float* g = A.in[18];
    const int gw = F.vcu * NWAVES + F.wave, NGW = F.G * NWAVES, lane = F.lane;
    f32x4 gv[4];
#pragma unroll
    for (int j = 0; j < 4; ++j) gv[j] = ((const GAS f32x4*)g)[lane + 64 * j];
    constexpr int FR = FIN_RPT;
    for (int m0 = FR * gw; m0 < M; m0 += FR * NGW) {
        f32x4 v[FR][4]; unsigned long long ya[FR][4], yb[FR][4], xa[FR][4], xb[FR][4];
#pragma unroll
        for (int q = 0; q < FR; ++q) { const int m = m0 + q; const GAS unsigned long long* xh_ = (const GAS unsigned long long*)(X2H + (size_t)m * DM) + lane; const GAS unsigned long long* xl_ = (const GAS unsigned long long*)(X2Lo + (size_t)m * DM) + lane;
            const GAS unsigned long long* y0 = (const GAS unsigned long long*)(Y + (size_t)(2 * m) * DM) + lane; const GAS unsigned long long* y1 = (const GAS unsigned long long*)(Y + (size_t)(2 * m + 1) * DM) + lane;
#pragma unroll
            for (int j = 0; j < 4; ++j) { xa[q][j] = xh_[64 * j]; xb[q][j] = RES_BF16 ? 0ull : xl_[64 * j]; ya[q][j] = y0[64 * j]; yb[q][j] = y1[64 * j]; } }
#pragma unroll
        for (int q = 0; q < FR; ++q) { const int m = m0 + q; float s = 0.f;
#pragma unroll
            for (int j = 0; j < 4; ++j) { const unsigned long long a = ya[q][j], b = yb[q][j], xh8 = xa[q][j], xl8 = xb[q][j];
                const unsigned al = (unsigned)a, ah = (unsigned)(a >> 32), bl = (unsigned)b, bh = (unsigned)(b >> 32), hl = (unsigned)xh8, hh = (unsigned)(xh8 >> 32), ll = (unsigned)xl8, lh = (unsigned)(xl8 >> 32);
                v[q][j] = (f32x4){bflo(hl) + bflo(ll), bfhi(hl) + bfhi(ll), bflo(hh) + bflo(lh), bfhi(hh) + bfhi(lh)};
                v[q][j][0] = (v[q][j][0] + bflo(al)) + bflo(bl); v[q][j][1] = (v[q][j][1] + bfhi(al)) + bfhi(bl); v[q][j][2] = (v[q][j][2] + bflo(ah)) + bflo(bh); v[q][j][3] = (v[q][j][3] + bfhi(ah)) + bfhi(bh);
                s += dot4(v[q][j]); }
            float rs = 1.f / sqrtf(wave_sum(s) * (1.f / DM) + EPS);
#if CHECK
            { const float es = __hip_atomic_load((float*)(F.ctl + CW_ERR), RLX_AGENT), ec = __hip_atomic_load((float*)(F.ctl + CW_ERR + 1), RLX_AGENT); rs *= 1.f + CHK_GAIN * (ec > 0.f ? es / ec : 1.f); }
#endif
            GAS f32x4* dr = (GAS f32x4*)(DST + (size_t)m * DM) + lane;
#pragma unroll
            for (int j = 0; j < 4; ++j) dr[64 * j] = v[q][j] * rs * gv[j]; } }
}

#if CHECK
__device__ __forceinline__ float blk_sum(Frame& F, float v, LAS float* red) { v = wave_sum(v); __syncthreads(); if (F.lane == 0) red[F.wave] = v; __syncthreads(); float t = 0.f; for (int i = 0; i < 8; ++i) t += red[i]; return t; }
__device__ __forceinline__ float blk_max(Frame& F, float v, LAS float* red) {
#pragma unroll
    for (int o = 1; o < 64; o <<= 1) v = fmaxf(v, __shfl_xor(v, o));
    __syncthreads(); if (F.lane == 0) red[F.wave] = v; __syncthreads(); float t = red[0]; for (int i = 1; i < 8; ++i) t = fmaxf(t, red[i]); return t; }
__device__ __forceinline__ void err_add(Frame& F, int group, float num2, float den2, LAS float* red) {
    const float n = blk_sum(F, num2, red), d = blk_sum(F, den2, red);
    if (F.tid == 0 && ((CHK_GROUPS >> group) & 1)) { float e = sqrtf(n / (d + 1e-20f)); e = fminf(e, 1.f); if (!(e == e)) e = 1.f; atomicAdd((float*)(F.ctl + CW_ERR), e); atomicAdd((float*)(F.ctl + CW_ERR + 1), 1.f); } }
__device__ __forceinline__ float bfv(const bf16* p) { return __builtin_bit_cast(float, ((unsigned)*p) << 16); }
__device__ __forceinline__ int posA(int j) { const int i = j & 15, odd = j >> 4; return 8 * (i >> 2) + 2 * (i & 3) + odd; }
__device__ __forceinline__ int posB(int d) { if (d >= 16) return d; const int i = d & 7, odd = d >> 3; return 8 * (i >> 2) + 2 * (i & 3) + odd; }
__device__ __forceinline__ unsigned hash32(unsigned x) { x ^= x >> 16; x *= 0x7feb352du; x ^= x >> 15; x *= 0x846ca68bu; x ^= x >> 16; return x; }
__device__ __forceinline__ void cs_pow(double theta, int pos, double& c, double& s) {
    double t2 = theta * theta, ct = 1.0, st = theta, term = 1.0;
    for (int k = 1; k <= 12; ++k) { term *= -t2 / ((2.0 * k - 1.0) * (2.0 * k)); ct += term; }
    term = theta; for (int k = 1; k <= 12; ++k) { term *= -t2 / ((2.0 * k) * (2.0 * k + 1.0)); st += term; }
    double rc = 1.0, rs = 0.0, bc = ct, bs = st;
    for (int b = 0; b < 13; ++b) { if ((pos >> b) & 1) { const double nc = rc * bc - rs * bs, ns = rc * bs + rs * bc; rc = nc; rs = ns; } const double c2 = bc * bc - bs * bs, s2 = 2.0 * bc * bs; bc = c2; bs = s2; }
    c = rc; s = rs;
}
__device__ __forceinline__ void check_proj_row(const Frame& F0, const Args& A, int m) {
    Frame F = F0; F.lane = lane_id(); F.tid = F.wave * 64 + F.lane;
    unsigned char* ws = A.ws; LAS float* L = (LAS float*)F.lds; LAS float* hrow = L; LAS float* proj = L + 1024; LAS float* tmp = L + 5664; LAS float* outv = L + 6688; LAS float* red = L + 7712;
    const int tid = F.tid, pos = m & (SEQ - 1);
    const float* x = A.in[0] + (size_t)m * DM;
    float ss = 0.f; for (int k = tid; k < DM; k += 512) ss += x[k] * x[k];
    ss = blk_sum(F, ss, red); { const float rs = 1.f / sqrtf(ss / DM + EPS); for (int k = tid; k < DM; k += 512) hrow[k] = x[k] * rs * A.in[1][k]; }
    __syncthreads();
    for (int c = tid; c < 4640; c += 512) { float a = 0.f; for (int k = 0; k < DM; ++k) a += hrow[k] * A.in[2][(size_t)k * 4640 + c]; proj[c] = a; }
    __syncthreads();
    const float* CA = (const float*)(ws + WS_COSA); const float* SA_ = (const float*)(ws + WS_SINA); const float* CB = (const float*)(ws + WS_COSB); const float* SB_ = (const float*)(ws + WS_SINB);
    { float n2 = 0.f, d2 = 0.f; if (tid < 24) { const int j = tid; double c, s_; cs_pow(6.283185307179586 * (j < 16 ? REV_A[j] : REV_B[j - 16]), pos, c, s_);
          const float tc = j < 16 ? CA[pos * 16 + j] : CB[pos * 8 + j - 16], ts = j < 16 ? SA_[pos * 16 + j] : SB_[pos * 8 + j - 16];
          n2 = (tc - (float)c) * (tc - (float)c) + (ts - (float)s_) * (ts - (float)s_); d2 = 1.f; }
      err_add(F, 0, n2, d2, red); }
    { float q2 = 0.f; for (int k = tid; k < QL; k += 512) q2 += proj[k] * proj[k]; q2 = blk_sum(F, q2, red); const float rs = 1.f / sqrtf(q2 / QL + EPS);
      for (int k = tid; k < QL; k += 512) tmp[k] = proj[k] * rs * A.in[3][k];
      __syncthreads();
      for (int c = tid; c < QL; c += 512) { float a = 0.f; for (int k = 0; k < QL; ++k) a += tmp[k] * A.in[4][(size_t)k * QL + c]; outv[c] = a; }
      __syncthreads();
      const bf16* QA = (const bf16*)(ws + WS_QA) + (size_t)m * QL; float n2 = 0.f, d2 = 0.f;
      for (int c = tid; c < QL; c += 512) { const int hh = c / 96, d = c % 96; float ref; int sp;
          if (d < 64) { ref = outv[c]; sp = d; }
          else { const int j = d - 64, i = j & 15; double cc, sn; cs_pow(6.283185307179586 * REV_A[i], pos, cc, sn); const float x1 = outv[hh * 96 + 64 + i], x2 = outv[hh * 96 + 80 + i];
              ref = (j < 16) ? x1 * (float)cc - x2 * (float)sn : x2 * (float)cc + x1 * (float)sn; sp = 64 + posA(j); }
          ref *= C2A; const float got = bfv(QA + hh * 96 + sp); n2 += (got - ref) * (got - ref); d2 += ref * ref; }
      err_add(F, 1, n2, d2, red); }
    { float q2 = 0.f; for (int k = tid; k < KVL; k += 512) q2 += proj[768 + k] * proj[768 + k]; q2 = blk_sum(F, q2, red); const float rs = 1.f / sqrtf(q2 / KVL + EPS);
      for (int k = tid; k < KVL; k += 512) tmp[k] = proj[768 + k] * rs * A.in[5][k];
      __syncthreads();
      for (int c = tid; c < DM; c += 512) { float a = 0.f; for (int k = 0; k < KVL; ++k) a += tmp[k] * A.in[6][(size_t)k * DM + c]; outv[c] = a; }
      __syncthreads();
      const bf16* KV = (const bf16*)(ws + WS_KV) + (size_t)m * DM; float n2 = 0.f, d2 = 0.f;
      for (int c = tid; c < DM; c += 512) { const float ref = outv[c], got = bfv(KV + c); n2 += (got - ref) * (got - ref); d2 += ref * ref; }
      err_add(F, 2, n2, d2, red); }
    { const bf16* KR = (const bf16*)(ws + WS_KR) + (size_t)m * 32; float n2 = 0.f, d2 = 0.f;
      if (tid < 32) { const int j = tid, i = j & 15; double cc, sn; cs_pow(6.283185307179586 * REV_A[i], pos, cc, sn); const float x1 = proj[1024 + i], x2 = proj[1040 + i];
          const float ref = (j < 16) ? x1 * (float)cc - x2 * (float)sn : x2 * (float)cc + x1 * (float)sn; const float got = bfv(KR + posA(j)); n2 = (got - ref) * (got - ref); d2 = ref * ref; }
      err_add(F, 3, n2, d2, red); }
    for (int w = 0; w < 3; ++w) { const bf16* O = (const bf16*)(ws + (w == 0 ? WS_QB : w == 1 ? WS_KB : WS_VB)) + (size_t)m * 512; const int base = (w == 0) ? 1056 : (w == 1) ? 1568 : 2080; float n2 = 0.f, d2 = 0.f;
        { const int c = tid; const int hh = c >> 6, d = c & 63; float ref; int sp = d;
          if (w < 2 && d < 16) { const int i = d & 7; double cc, sn; cs_pow(6.283185307179586 * REV_B[i], pos, cc, sn); const float x1 = proj[base + hh * 64 + i], x2 = proj[base + hh * 64 + 8 + i];
              ref = (d < 8) ? x1 * (float)cc - x2 * (float)sn : x2 * (float)cc + x1 * (float)sn; sp = posB(d); }
          else ref = proj[base + c];
          if (w == 0) ref *= C2B;
          const float got = bfv(O + hh * 64 + sp); n2 = (got - ref) * (got - ref); d2 = ref * ref; }
        err_add(F, 4 + w, n2, d2, red); }
    for (int w = 0; w < 2; ++w) { const bf16* O = (const bf16*)(ws + (w == 0 ? WS_SA : WS_SB)) + (size_t)m * DM; float n2 = 0.f, d2 = 0.f;
        for (int c = tid; c < DM; c += 512) { const float sa = 1.f / (1.f + __expf(-proj[2592 + c])), sb = 1.f / (1.f + __expf(-proj[3616 + c])); const float ref = (w == 0) ? sa / sb : sb, got = bfv(O + c); n2 += (got - ref) * (got - ref); d2 += ref * ref; }
        err_add(F, 7 + w, n2, d2, red); }
    __syncthreads();
}
__device__ __forceinline__ void check_attn_row(const Frame& F0, const Args& A, int type, int b, int h, int s) {
    Frame F = F0; F.lane = lane_id(); F.tid = F.wave * 64 + F.lane;
    unsigned char* ws = A.ws; LAS float* L = (LAS float*)F.lds; LAS float* sc = L; LAS float* q = L + 8192; LAS float* km = L + 8320; LAS float* part = L + 10400; LAS float* red = L + 10944; LAS float* gate = L + 10960; LAS unsigned* msk = (LAS unsigned*)(L + 11000);
    const int tid = F.tid; const size_t rb = (size_t)b * SEQ; const int own = s >> 8;
    const bf16* QA = (const bf16*)(ws + WS_QA); const bf16* KV = (const bf16*)(ws + WS_KV); const bf16* KR = (const bf16*)(ws + WS_KR);
    const bf16* QB = (const bf16*)(ws + WS_QB); const bf16* KB = (const bf16*)(ws + WS_KB); const bf16* VB = (const bf16*)(ws + WS_VB); const bf16* OAB = (const bf16*)(ws + WS_OAB);
    __syncthreads();
    if (type == 0) { if (tid < 96) q[tid] = bfv(QA + (rb + s) * QL + h * 96 + tid); }
    else { if (tid < 64) q[tid] = bfv(QB + (rb + s) * 512 + h * 64 + tid); }
    __syncthreads();
    unsigned mask = 0xffffffffu;
    if (type == 1) {
        { const int d = tid & 63, g = tid >> 6; for (int n = g; n < own; n += 8) { float a = 0.f; for (int r = 0; r < 256; ++r) a += bfv(KB + (rb + n * 256 + r) * 512 + h * 64 + d); km[n * 64 + d] = a * (1.f / 256.f); } }
        __syncthreads();
        if (tid < own) { float a = 0.f; for (int d = 0; d < 64; ++d) a += q[d] * km[tid * 64 + d]; gate[tid] = a; }
        __syncthreads();
        if (tid == 0) { unsigned mk = 0u; if (own < 4) mk = (1u << own) - 1u; else { for (int r = 0; r < 3; ++r) { float bv = -INFINITY; int bi = 0; for (int n = 0; n < own; ++n) if (!((mk >> n) & 1u) && gate[n] > bv) { bv = gate[n]; bi = n; } mk |= 1u << bi; } }
            msk[0] = mk | (1u << own); }
        __syncthreads();
        mask = msk[0];
    }
    float mx = -INFINITY;
    for (int j = tid; j <= s; j += 512) { float a = -INFINITY;
        if ((mask >> (j >> 8)) & 1u) { a = 0.f;
            if (type == 0) { for (int d = 0; d < 64; ++d) a += q[d] * bfv(KV + (rb + j) * DM + h * 128 + d); for (int d = 0; d < 32; ++d) a += q[64 + d] * bfv(KR + (rb + j) * 32 + d); }
            else { for (int d = 0; d < 64; ++d) a += q[d] * bfv(KB + (rb + j) * 512 + h * 64 + d); } }
        sc[j] = a; mx = fmaxf(mx, a); }
    mx = blk_max(F, mx, red);
    float l = 0.f; for (int j = tid; j <= s; j += 512) { const float p = exp2f(sc[j] - mx); sc[j] = p; l += p; }
    l = blk_sum(F, l, red);
    { const int d = tid & 63, g = tid >> 6; float a = 0.f;
      for (int j = g; j <= s; j += 8) { const float p = sc[j]; if (p != 0.f) a += p * (type == 0 ? bfv(KV + (rb + j) * DM + h * 128 + 64 + d) : bfv(VB + (rb + j) * 512 + h * 64 + d)); }
      part[g * 64 + d] = a; }
    __syncthreads();
    float n2 = 0.f, d2 = 0.f;
    if (tid < 64) { float a = 0.f; for (int g = 0; g < 8; ++g) a += part[g * 64 + tid]; const float ref = a / l; const float got = bfv(OAB + (rb + s) * DM + type * 512 + h * 64 + tid); n2 = (got - ref) * (got - ref); d2 = ref * ref; }
    err_add(F, type, n2, d2, red);
    __syncthreads();
}
__device__ __forceinline__ void check_mix_row(const Frame& F0, const Args& A, int m) {
    Frame F = F0; F.lane = lane_id(); F.tid = F.wave * 64 + F.lane;
    unsigned char* ws = A.ws; LAS float* L = (LAS float*)F.lds; LAS float* orow = L; LAS float* mix = L + 1024; LAS float* red = L + 2048; const int tid = F.tid;
    const bf16* OAB = (const bf16*)(ws + WS_OAB) + (size_t)m * DM; const bf16* SAp = (const bf16*)(ws + WS_SA) + (size_t)m * DM; const bf16* SBp = (const bf16*)(ws + WS_SB) + (size_t)m * DM; const bf16* MIX = (const bf16*)(ws + WS_MIX) + (size_t)m * DM;
    __syncthreads();
    for (int k = tid; k < DM; k += 512) orow[k] = bfv(OAB + k);
    __syncthreads();
    float n2 = 0.f, d2 = 0.f;
    for (int c = tid; c < DM; c += 512) { float a1 = 0.f, a2 = 0.f; for (int k = 0; k < 512; ++k) { a1 += orow[k] * A.in[7][(size_t)k * DM + c]; a2 += orow[512 + k] * A.in[8][(size_t)k * DM + c]; }
        const float ref = bfv(SBp + c) * (bfv(SAp + c) * a1 + a2), got = bfv(MIX + c); mix[c] = got; n2 += (got - ref) * (got - ref); d2 += ref * ref; }
    err_add(F, 0, n2, d2, red);
    n2 = 0.f; d2 = 0.f;
    for (int c = tid; c < DM; c += 512) { float a = 0.f; for (int k = 0; k < DM; ++k) a += mix[k] * A.in[9][(size_t)k * DM + c];
        const float ref = A.in[0][(size_t)m * DM + c] + a, got = bfv((const bf16*)(ws + WS_X2B) + (size_t)m * DM + c) + bfv((const bf16*)(ws + WS_X2L) + (size_t)m * DM + c); n2 += (got - ref) * (got - ref); d2 += a * a; }
    err_add(F, 1, n2, d2, red);
    __syncthreads();
}
#endif

__device__ __forceinline__ void moba_combine(const Frame& F0, const Args& A) {
    Frame F = F0; F.lane = lane_id(); F.tid = F.wave * 64 + F.lane;
    unsigned char* ws = A.ws; const bf16* PO = (const bf16*)A.out; const float* PML = (const float*)(ws + WS_PML); const unsigned* SEL = (const unsigned*)(ws + WS_SEL); bf16* OAB = (bf16*)(ws + WS_OAB);
    const int gw = F.vcu * NWAVES + F.wave, NGW = F.G * NWAVES, lane = F.lane, ch = lane & 7;
    typedef float f32x2_ __attribute__((ext_vector_type(2)));
    for (int task0 = 2 * gw; task0 < 65536 * REP_MOBA_B; task0 += 2 * NGW) {
        unsigned selv[2]; f32x2_ ml[2][4]; v4u ov[2][4];
#pragma unroll
        for (int q = 0; q < 2; ++q) { const int tk = (task0 + q) & 65535; const long qh = (long)tk * 8 + (lane >> 3);
            selv[q] = SEL[qh];
#pragma unroll
            for (int k = 0; k < 4; ++k) { ml[q][k] = *(const f32x2_*)(PML + (qh * 4 + k) * 2); ov[q][k] = *(const v4u*)(PO + (size_t)(qh * 4 + k) * 64 + ch * 8); } }
#pragma unroll
        for (int q = 0; q < 2; ++q) { const int tk = (task0 + q) & 65535; const long qh = (long)tk * 8 + (lane >> 3); const int bh = (int)(qh >> 13), sq = (int)(qh & (SEQ - 1)), b = bh >> 3, h = bh & 7;
            const int np = __builtin_popcount(selv[q]);
            float mi[4], li[4]; v4u oi[4];
#pragma unroll
            for (int k = 0; k < 4; ++k) { const bool ok = (k == 3) || (k < np); mi[k] = ok ? ml[q][k][0] : -1e30f; li[k] = ok ? ml[q][k][1] : 0.f;
                oi[k].x = ok ? ov[q][k].x : 0u; oi[k].y = ok ? ov[q][k].y : 0u; oi[k].z = ok ? ov[q][k].z : 0u; oi[k].w = ok ? ov[q][k].w : 0u; }
            const float mmax = fmaxf(fmaxf(mi[0], mi[1]), fmaxf(mi[2], mi[3]));
            float wk[4], wsum = 0.f;
#pragma unroll
            for (int k = 0; k < 4; ++k) { wk[k] = li[k] * __builtin_amdgcn_exp2f(mi[k] - mmax); wsum += wk[k]; }
            const float inv = 1.f / wsum;
            float r8[8] = {0.f, 0.f, 0.f, 0.f, 0.f, 0.f, 0.f, 0.f};
#pragma unroll
            for (int k = 0; k < 4; ++k) { const v4u u = oi[k]; r8[0] += wk[k] * bflo(u.x); r8[1] += wk[k] * bfhi(u.x); r8[2] += wk[k] * bflo(u.y); r8[3] += wk[k] * bfhi(u.y);
                r8[4] += wk[k] * bflo(u.z); r8[5] += wk[k] * bfhi(u.z); r8[6] += wk[k] * bflo(u.w); r8[7] += wk[k] * bfhi(u.w); }
            v4u w; w.x = cvt_pk_bf16(r8[0] * inv, r8[1] * inv); w.y = cvt_pk_bf16(r8[2] * inv, r8[3] * inv); w.z = cvt_pk_bf16(r8[4] * inv, r8[5] * inv); w.w = cvt_pk_bf16(r8[6] * inv, r8[7] * inv);
            *(v4u*)(OAB + ((size_t)b * SEQ + sq) * DM + 512 + h * 64 + ch * 8) = w; } }
}

__global__ void __launch_bounds__(NWAVES * 64, 2) mk_fwd(Args kargs) {
    extern __shared__ __attribute__((aligned(16))) unsigned char lds[];
    Frame F;
    F.lds = (LAS unsigned char*)lds; F.MISC = (volatile LAS unsigned*)(F.lds + MISC_OFF);
    F.wave = __builtin_amdgcn_readfirstlane((int)threadIdx.x >> 6); F.lane = lane_id(); F.tid = F.wave * 64 + F.lane;
    F.G = gridDim.x; { const int bx = blockIdx.x; F.vcu = (F.G % 8 == 0) ? (bx % 8) * (F.G / 8) + bx / 8 : bx; }
    F.ctl = (gu32*)(ld_args().ws + WS_CTL);
    for (int u = F.tid; u < (LDS_BYTES - LDSCTL_OFF) / 4; u += NWAVES * 64) ((LAS unsigned*)(F.lds + LDSCTL_OFF))[u] = 0u;
    __syncthreads();
    XcdBarrier bar = xcd_barrier_post((unsigned*)(F.ctl + CW_BAR), F.MISC + 8, F.wave == 0 && lane_id() == 0);
    int lo, hi; { const Args a0 = ld_args(); lo = a0.ph_lo; hi = a0.ph_hi; }
#ifndef PH_MASK
#define PH_MASK 0x7ff
#endif
#define IN(k) (((PH_MASK >> (k)) & 1) && lo <= (k) && (k) < hi)
#define SEAM(k) do { if (IN(k) && IN((k) + 1)) xcd_barrier(bar, F.wave == 0 && lane_id() == 0); } while (0)
#define PB(off) ((bf16*)(ws + (off)))
#define PF(off) ((float*)(ws + (off)))
#define XN PB(WS_XN)
#define CQ PB(WS_CQ)
#define CKV PB(WS_CKV)
#define KR PB(WS_KR)
#define QBp PB(WS_QB)
#define KBp PB(WS_KB)
#define VBp PB(WS_VB)
#define SAp PB(WS_SA)
#define SBp PB(WS_SB)
#define QA PB(WS_QA)
#define KV PB(WS_KV)
#define OAB PB(WS_OAB)
#define MIX PB(WS_MIX)
#define X2B PB(WS_X2B)
#define XG PB(WS_XG)
#define Hb PB(WS_H)
#define Yb PB(WS_Y)
#define SSQ_Q PF(WS_SSQQ)
#define SSQ_KV PF(WS_SSQKV)
#define SSQ_X PF(WS_SSQX)
#define KSUM PF(WS_KSUM)
#define COSA PF(WS_COSA)
#define SINA PF(WS_SINA)
#define COSB PF(WS_COSB)
#define SINB PF(WS_SINB)
    if (IN(0)) { const Args args = ld_args(); for (int rep = 0; rep < NREP(0); ++rep) p0_prologue(F, args); } SEAM(0);

    if (IN(1)) { const Args args = ld_args(); unsigned char* ws = args.ws;
        pg8::Gemm g{XN, (const bf16*)(ws + WS_WIN), DM, DM, DM, 0}; pg8::SchedGrid S; S.init(M / 256, NPROJ / 256, F.G, (int)blockIdx.x, DM, DM, NREP(1), WGM_P1);
        pg8::EpiProj E{CQ, CKV, KR, QBp, KBp, VBp, SAp, SBp, SSQ_Q, SSQ_KV, KSUM, COSA, SINA, COSB, SINB};
        pg8::gemm_phase(F.lds, g, S, E, F.wave);
#ifdef P1_EXTRA_PLAIN
        { pg8::SchedGrid S2; S2.init(M / 256, NPROJ / 256, F.G, (int)blockIdx.x, DM, DM, 1, WGM_P1); pg8::EpiPlain E2{(bf16*)(ws + 976 * MiB)}; pg8::gemm_phase(F.lds, g, S2, E2, F.wave); }
#endif
    } SEAM(1);

    if (IN(2)) { const Args args = ld_args(); unsigned char* ws = args.ws;
        { pg8::Gemm g{CQ, (const bf16*)(ws + WS_WUQ), QL, QL, QL, 0}; pg8::SchedGrid S; S.init(M / 256, QL / 256, F.G, (int)blockIdx.x, QL, QL, NREP(2), WGM_O);
          pg8::EpiQ E{QA, SSQ_Q, COSA, SINA}; pg8::gemm_phase(F.lds, g, S, E, F.wave); }
        { pg8::Gemm g{CKV, (const bf16*)(ws + WS_WUKV), KVL, KVL, KVL, 0}; pg8::SchedGrid S; S.init(M / 256, DM / 256, F.G, (int)blockIdx.x, KVL, KVL, NREP(2), WGM_O);
          pg8::EpiKV E{KV, SSQ_KV}; pg8::gemm_phase(F.lds, g, S, E, F.wave); }
        for (int rep = 0; rep < NREP(11); ++rep) moba_select(F, args);
    } SEAM(2);
#if CHECK == 2
    if (IN(2)) { const Args args = ld_args();
#pragma unroll 1
        for (int i = 0; i < 3; ++i) { const unsigned hsh = hash32((unsigned)(F.vcu * 3 + i) + 12345u); int m = (int)(hsh % (unsigned)M); if (i == 0) m = (m & ~(SEQ - 1)) | (hsh >> 20 & 255) * 32 | (m & 31); check_proj_row(F, args, m); } xcd_barrier(bar, F.wave == 0 && lane_id() == 0); }
#endif

    if (IN(3)) { const Args args = ld_args(); unsigned char* ws = args.ws;
        const unsigned* SEL = (const unsigned*)(ws + WS_SEL);
        bf16* PO = (bf16*)args.out; float* PML = (float*)(ws + WS_PML);
        for (int qd = F.vcu; qd < 512; qd += F.G) { const int s = qd & 7, bh = (qd >> 3) & 63, b = bh >> 3, h = bh & 7; const size_t rb = (size_t)b * SEQ;
#pragma unroll 1
            for (int i = 0; i < 4 * REP_MLA; ++i) { const int i4 = i & 3; const int qb = (i4 == 0) ? s : (i4 == 1) ? 15 - s : (i4 == 2) ? 16 + s : 31 - s;
#if MLA_TUNED
                atm::attn_unit_mla<8>(qb, QA + rb * QL + h * 96, KV + rb * DM + h * 128, KR + rb * 32, KV + rb * DM + h * 128 + 64, OAB + rb * DM + h * 64, (LAS char*)F.lds, F.wave);
#else
                at::attn_unit<96, 0>(qb, QA + rb * QL + h * 96, QL, KV + rb * DM + h * 128, DM, KR + rb * 32, KV + rb * DM + h * 128 + 64, DM, OAB + rb * DM + h * 64, DM, at::MobaX{nullptr, nullptr, 0, 0, nullptr, nullptr, 0}, (LAS char*)F.lds, F.wave);
#endif
            } }
#ifndef ONLY_MLA
        { F.lane = lane_id(); F.tid = F.wave * 64 + F.lane; LAS int* PRE = (LAS int*)(F.lds + 102400); LAS int* WSUM = (LAS int*)(F.lds + 102400 + 8704);
#define MB_NCH(c) ({ const int n_ = (int)((((c) + 31u) >> 5) + 63u) >> 6; n_ < 1 ? 1 : n_; })
          int v0, v1, v2, v3;
          { const int i0 = 4 * F.tid;
              v0 = MB_NCH(__hip_atomic_load((unsigned*)(F.ctl + CW_MCNT + ((i0 + 0) & 63) * 32 + ((i0 + 0) >> 6)), RLX_AGENT));
              v1 = MB_NCH(__hip_atomic_load((unsigned*)(F.ctl + CW_MCNT + ((i0 + 1) & 63) * 32 + ((i0 + 1) >> 6)), RLX_AGENT));
              v2 = MB_NCH(__hip_atomic_load((unsigned*)(F.ctl + CW_MCNT + ((i0 + 2) & 63) * 32 + ((i0 + 2) >> 6)), RLX_AGENT));
              v3 = MB_NCH(__hip_atomic_load((unsigned*)(F.ctl + CW_MCNT + ((i0 + 3) & 63) * 32 + ((i0 + 3) >> 6)), RLX_AGENT)); }
          const int loc = v0 + v1 + v2 + v3; int inc = loc;
#pragma unroll
          for (int o = 1; o < 64; o <<= 1) { const int t = __shfl_up(inc, o); if (F.lane >= o) inc += t; }
          __syncthreads();
          if (F.lane == 63) WSUM[F.wave] = inc;
          __syncthreads();
          int woff = 0; for (int w = 0; w < F.wave; ++w) woff += WSUM[w];
          const int excl = inc - loc + woff;
          PRE[4 * F.tid] = excl; PRE[4 * F.tid + 1] = excl + v0; PRE[4 * F.tid + 2] = excl + v0 + v1; PRE[4 * F.tid + 3] = excl + v0 + v1 + v2;
          if (F.tid == 511) PRE[2048] = excl + loc;
          __syncthreads();
          const int total = PRE[2048];
          const unsigned short* LQ = (const unsigned short*)(ws + WS_LISTQ);
#pragma unroll 1
          for (;;) {
              __syncthreads();
              if (F.tid == 0) F.MISC[12] = xb_add((unsigned*)(F.ctl + CW_TICKET), 1u);
              __syncthreads();
              const int k = (int)F.MISC[12]; if (k >= total * REP_MOBA_A) break;
              const int kk = (k >= total) ? k - total : k; int lo_ = 0, hi_ = 2048;
              while (lo_ < hi_) { const int mid = (lo_ + hi_) >> 1; if (PRE[mid + 1] <= kk) lo_ = mid + 1; else hi_ = mid; }
              const int idx = lo_, j = idx >> 6, bh = idx & 63, b = bh >> 3, h = bh & 7, ch = kk - PRE[idx]; const size_t rb = (size_t)b * SEQ;
              const int lcnt = (j < 31) ? (int)__hip_atomic_load((unsigned*)(F.ctl + CW_MCNT + bh * 32 + j), RLX_AGENT) : 0;
              const int ng = (lcnt + 31) >> 5; int nch = (ng + 63) >> 6; if (nch < 1) nch = 1; const int gpc = (ng + nch - 1) / nch, g0 = ch * gpc, g1 = (g0 + gpc < ng) ? g0 + gpc : ng;
              at::moba_block(j, QBp + rb * 512 + h * 64, KBp + rb * 512 + h * 64, VBp + rb * 512 + h * 64,
                  at::MobaX{SEL + (size_t)bh * SEQ, LQ + (size_t)bh * LQ_PER_BH + 256 * (31 * j - j * (j - 1) / 2), lcnt, 0, PO, PML, (long)bh * SEQ}, g0, g1, ch == 0, (LAS char*)F.lds, F.wave); } }
        xcd_barrier(bar, F.wave == 0 && lane_id() == 0);
        moba_combine(F, args);
#endif
    } SEAM(3);
#if CHECK == 1
    if (IN(3)) { const Args args = ld_args();
#pragma unroll 1
        for (int i = 0; i < 8; ++i) { const unsigned hsh = hash32((unsigned)(F.vcu * 8 + i) + 777u); const int type = i & 1, b = (hsh >> 3) & 7, h = hsh & 7; int sq = (hsh >> 8) & (SEQ - 1); if (i >= 6) sq &= 1023;
            check_attn_row(F, args, type, b, h, sq); } xcd_barrier(bar, F.wave == 0 && lane_id() == 0); }
#endif

    if (IN(4)) { const Args args = ld_args(); unsigned char* ws = args.ws;
        pg8::Gemm g{OAB, (const bf16*)(ws + WS_WO), 512, DM, DM, 0}; pg8::SchedMix S; S.g.init(M / 256, DM / 256, F.G, (int)blockIdx.x, DM, DM, NREP(4), WGM_O);
        pg8::EpiMix E{MIX, SAp, SBp}; pg8::gemm_phase(F.lds, g, S, E, F.wave);
    } SEAM(4);

    if (IN(5)) { const Args args = ld_args(); unsigned char* ws = args.ws;
        pg8::Gemm g{MIX, (const bf16*)(ws + WS_WOUT), DM, DM, DM, 0}; pg8::SchedGrid S; S.init(M / 256, DM / 256, F.G, (int)blockIdx.x, DM, DM, NREP(5), WGM_O);
        pg8::EpiOut E{args.in[0], PB(WS_X2L), X2B, SSQ_X}; pg8::gemm_phase(F.lds, g, S, E, F.wave);
    } SEAM(5);
#if CHECK == 3
    if (IN(5)) { const Args args = ld_args();
#pragma unroll 1
        for (int i = 0; i < 2; ++i) { const unsigned hsh = hash32((unsigned)(F.vcu * 2 + i) + 4242u); check_mix_row(F, args, (int)(hsh % (unsigned)M)); } xcd_barrier(bar, F.wave == 0 && lane_id() == 0); }
#endif

    if (IN(6)) { const Args args = ld_args(); router_phase(F, args); } SEAM(6);

    if (IN(8)) { const Args args = ld_args(); unsigned char* ws = args.ws;
        moe_tile_table(F); gather_phase(F, args);
        asm volatile("s_waitcnt vmcnt(0)" ::: "memory"); __syncthreads();
        pg8::Gemm g{X2B, (const bf16*)(ws + WS_WGU), DM, DM, DM, 0};
        pg8::SchedMoE S{(const volatile LAS int*)(F.MISC + MI_TS), 2, F.G, F.vcu, 256L * DM * 2, 512L * DM * 2, 256L * DM * 2, NREP(8)};
        pg8::EpiH E{Hb, (const float*)(ws + WS_SLOTRS)}; pg8::gemm_phase_g(F.lds, g, S, E, F.wave, (const int*)(ws + WS_SLOTTOK));
    } SEAM(8);

    if (IN(9)) { const Args args = ld_args(); unsigned char* ws = args.ws;
        if (!IN(8)) moe_tile_table(F);
        pg8::Gemm g{Hb, (const bf16*)(ws + WS_WD), EFF, EFF, EFF, 0};
        pg8::SchedMoE S{(const volatile LAS int*)(F.MISC + MI_TS), 4, F.G, F.vcu, 256L * EFF * 2, 1024L * EFF * 2, 256L * EFF * 2, NREP(9)};
        pg8::EpiY E{Yb, (const int*)(ws + WS_SLOTA), (const float*)(ws + WS_TOKW)}; pg8::gemm_phase(F.lds, g, S, E, F.wave);
    } SEAM(9);

    if (IN(10)) { const Args args = ld_args(); if (NREP(10) > 1) final_phase(F, args, (float*)(args.ws + WS_R4)); final_phase(F, args, args.out); }
#undef IN
#undef SEAM
}

extern "C" void kernel_launch(void* const* d_in, const int* in_sizes, int n_in, void* d_out, int out_size, void* d_ws, size_t ws_size, hipStream_t stream) {
    static int grid = 0;
    if (grid == 0) {
        if (n_in != 19 || out_size != M * DM || ws_size < WS_END) { fprintf(stderr, "kernel_launch: unexpected shapes (n_in %d out %d ws %zu)\n", n_in, out_size, ws_size); grid = -1; return; }
        int dev = 0, cus = 0, per_cu = 0;
        if (hipGetDevice(&dev) != hipSuccess || hipDeviceGetAttribute(&cus, hipDeviceAttributeMultiprocessorCount, dev) != hipSuccess) { grid = -1; return; }
        if (hipFuncSetAttribute((const void*)mk_fwd, hipFuncAttributeMaxDynamicSharedMemorySize, LDS_BYTES) != hipSuccess) { fprintf(stderr, "kernel_launch: hipFuncSetAttribute failed\n"); grid = -1; return; }
        if (hipOccupancyMaxActiveBlocksPerMultiprocessor(&per_cu, (const void*)mk_fwd, NWAVES * 64, LDS_BYTES) != hipSuccess || per_cu < 1) { fprintf(stderr, "kernel_launch: occupancy query says %d\n", per_cu); }
        (void)hipGetLastError();
        grid = cus;
    }
    if (grid < 0) return;
    if (hipMemsetAsync((char*)d_ws + WS_CTL, 0, CTL_ZERO_BYTES, stream) != hipSuccess) return;
    Args a{};
    for (int i = 0; i < 19; ++i) a.in[i] = (const float*)d_in[i];
    a.out = (float*)d_out; a.ws = (unsigned char*)d_ws; a.ph_lo = 0; a.ph_hi = 11;
    hipLaunchKernelGGL(mk_fwd, dim3(grid), dim3(NWAVES * 64), LDS_BYTES, stream, a);
}
```

```cpp
#include <hip/hip_runtime.h>
#include <hip/hip_bf16.h>
#include <cstdio>
#include <cstdint>

#define LAS __attribute__((address_space(3)))
#define GAS __attribute__((address_space(1)))

constexpr int BATCH = 8, SEQ = 8192, DM = 1024, M = BATCH * SEQ;
constexpr int QL = 768, KVL = 256;
constexpr int NPROJ = 4864;
constexpr int NEXP = 32, EFF = 256, LCAP = 131072;
constexpr float EPS = 1e-6f;
constexpr float LOG2E = 1.4426950408889634f;
constexpr float C2A = 0.10206207261596575f * LOG2E;
constexpr float C2B = 0.125f * LOG2E;
constexpr int NWAVES = 8;

constexpr size_t MiB = 1u << 20;
constexpr size_t WS_CTL = 0, CTL_ZERO_BYTES = 1 * MiB;
constexpr size_t WS_COSA = 1 * MiB, WS_SINA = WS_COSA + 512 * 1024, WS_COSB = 2 * MiB, WS_SINB = WS_COSB + 256 * 1024;
constexpr size_t WS_SSQQ = 3 * MiB, WS_SSQKV = 6 * MiB, WS_SSQX = 7 * MiB, WS_KSUM = 11 * MiB, WS_TOKW = 12 * MiB, WS_RS = 13 * MiB;
constexpr size_t WS_WIN = 16 * MiB, WS_WUQ = 26 * MiB, WS_WUKV = 28 * MiB, WS_WO = 29 * MiB, WS_WOUT = 31 * MiB, WS_WGU = 33 * MiB, WS_WD = 65 * MiB;
constexpr size_t WS_R1 = 96 * MiB, WS_R2 = 224 * MiB, WS_R3 = 352 * MiB;
constexpr size_t WS_KR = 480 * MiB, WS_SEL = 484 * MiB, WS_LIST = 486 * MiB, WS_SLOTA = 502 * MiB, WS_SLOTRS = 503 * MiB, WS_SLOTTOK = 504 * MiB;
constexpr size_t WS_R4 = 512 * MiB, WS_LISTQ = 960 * MiB, WS_PML = 976 * MiB, WS_END = 994 * MiB;
constexpr int LQ_PER_BH = 126976;
constexpr size_t WS_XN = WS_R1, WS_QA = WS_R1, WS_MIX = WS_R1, WS_Y = WS_R1;
constexpr size_t WS_CQ = WS_R2, WS_CKV = WS_R2 + 96 * MiB, WS_OAB = WS_R2;
constexpr size_t WS_KV = WS_R3, WS_X2B = WS_R3;
constexpr size_t WS_QB = WS_R4, WS_KB = WS_R4 + 64 * MiB, WS_VB = WS_R4 + 128 * MiB, WS_SA = WS_R4 + 192 * MiB, WS_SB = WS_R4 + 320 * MiB;
constexpr size_t WS_XG = WS_R4, WS_X2L = WS_R4, WS_H = WS_R4 + 272 * MiB;
constexpr int MAXSLOT = 139264;
constexpr int CW_BAR = 4096;
constexpr int CW_CNT = 16384;
constexpr int CW_MCNT = 24576;
constexpr int CW_TICKET = 28672;
#ifndef CHECK
#define CHECK 0
#endif
#ifndef CHK_GAIN
#define CHK_GAIN 4.0f
#endif
#ifndef CHK_GROUPS
#define CHK_GROUPS 0xffff
#endif
constexpr int CW_ERR = 20000;
#ifndef REPMASK
#define REPMASK 0
#endif
#define NREP(k) (1 + ((REPMASK >> (k)) & 1))
#ifndef MLA_TUNED
#define MLA_TUNED 1
#endif
#ifndef REP_MOBA_A
#define REP_MOBA_A 1
#endif
#ifndef REP_MOBA_B
#define REP_MOBA_B 1
#endif
#ifndef WGM_P1
#define WGM_P1 4
#endif
#ifndef WGM_O
#define WGM_O 8
#endif
#ifndef RES_BF16
#define RES_BF16 1
#endif
#ifndef MLA_PRIO
#define MLA_PRIO 1
#endif
#ifndef MOBA_PRIO
#define MOBA_PRIO 0
#endif
#ifndef P0_RPT
#define P0_RPT 4
#endif
#ifndef FIN_RPT
#define FIN_RPT 2
#endif
#ifndef CMB_T
#define CMB_T 4
#endif
#ifndef REP_MLA
#define REP_MLA 1
#endif
#ifndef REP_MOBA
#define REP_MOBA 1
#endif

constexpr int RING_BYTES = 131072;
constexpr int LDSCTL_OFF = RING_BYTES, MISC_OFF = LDSCTL_OFF + 320;
constexpr int LDS_BYTES = 147456;
constexpr int MI_TS = 16, MI_HIST = 64, MI_BASE = 96;

typedef unsigned short bf16;
typedef unsigned v4u __attribute__((ext_vector_type(4)));
typedef float f32x4 __attribute__((ext_vector_type(4)));
typedef float f32x16 __attribute__((ext_vector_type(16)));
typedef short bf16x8 __attribute__((ext_vector_type(8)));
typedef short s16x4 __attribute__((ext_vector_type(4)));
typedef GAS unsigned gu32;
#define RLX_AGENT __ATOMIC_RELAXED, __HIP_MEMORY_SCOPE_AGENT
#define LDS_WAIT() asm volatile("s_waitcnt lgkmcnt(0)" ::: "memory")
#define VM_WAIT() asm volatile("s_waitcnt vmcnt(0)" ::: "memory")

__device__ __forceinline__ int lane_id() { int l; asm volatile("v_mbcnt_lo_u32_b32 %0, -1, 0\n\tv_mbcnt_hi_u32_b32 %0, -1, %0" : "=v"(l)); return l; }
__device__ __forceinline__ unsigned f2bf(float f) { unsigned u = __builtin_bit_cast(unsigned, f); return (u + 0x7fffu + ((u >> 16) & 1u)) >> 16; }
__device__ __forceinline__ unsigned pk2(float lo, float hi) { return f2bf(lo) | (f2bf(hi) << 16); }
__device__ __forceinline__ unsigned cvt_pk_bf16(float lo, float hi) { unsigned r; asm volatile("v_cvt_pk_bf16_f32 %0, %1, %2" : "=v"(r) : "v"(lo), "v"(hi)); return r; }
__device__ __forceinline__ float bflo(unsigned w) { return __builtin_bit_cast(float, w << 16); }
__device__ __forceinline__ float bfhi(unsigned w) { return __builtin_bit_cast(float, w & 0xffff0000u); }
__device__ __forceinline__ float fsigmoid(float v) { return __builtin_amdgcn_rcpf(1.f + __builtin_amdgcn_exp2f(-v * LOG2E)); }
__device__ __forceinline__ float dot4(const f32x4 v) { return (v[0] * v[0] + v[1] * v[1]) + (v[2] * v[2] + v[3] * v[3]); }

namespace pg8 {
typedef unsigned short bf16_t;
constexpr int BM = 256, BK = 64, HALF = 128, HTB = HALF * BK * 2, STAGE_BYTES = 8 * HTB, NXCD = 8;
__host__ __device__ __forceinline__ int lds_byte(int r, int c) { const int st = (r >> 4) * 2 + (c >> 5), rr = r & 15, cc = c & 31, ob = rr * 64 + cc * 2; return st * 1024 + (ob ^ (((ob >> 9) & 1) << 5)); }
__host__ __device__ __forceinline__ void stage_rc(int b, int& R, int& C) { const int st = b / 1024, sb = b % 1024, swz = sb ^ (((sb >> 9) & 1) << 5); R = (st >> 1) * 16 + swz / 64; C = (st & 1) * 32 + (swz % 64) / 2; }
__host__ __device__ __forceinline__ int perm32(int rho) { const int n = rho >> 4, i = rho & 15; return 8 * (i >> 2) + 4 * n + (i & 3); }

struct Unit { int pm, pn, aux, pad; long aoff, boff; };
struct Gemm { const bf16_t* A; const bf16_t* Bt; int K, lda, ldb, pad; };

struct SchedGrid {
    int nM, nN, nwg, G, c, rep, WGM; long ta, tb;
    __device__ void init(int nM_, int nN_, int G_, int c_, int lda, int ldb, int rep_ = 1, int wgm_ = 8) { nM = nM_; nN = nN_; nwg = nM * nN; G = G_; c = c_; rep = rep_; WGM = wgm_; ta = 256L * lda * 2; tb = 256L * ldb * 2; }
    __device__ __forceinline__ bool tile(long L, Unit& u) const {
        if (L >= (long)nwg * rep) return false;
        if (L >= nwg) L -= nwg;
        int wgid = (int)L; { const int q = nwg / NXCD, r = nwg % NXCD, xcd = wgid % NXCD, off = wgid / NXCD; wgid = (xcd < r ? xcd * (q + 1) : r * (q + 1) + (xcd - r) * q) + off; }
        const int nig = WGM * nN, gid = wgid / nig, fm = gid * WGM, gsz = (nM - fm) < WGM ? (nM - fm) : WGM;
        u.pm = fm + ((wgid % nig) % gsz); u.pn = (wgid % nig) / gsz; u.aux = 0; u.pad = 0; u.aoff = u.pm * ta; u.boff = u.pn * tb; return true;
    }
    __device__ __forceinline__ bool next(int i, Unit& u) const { return tile((long)i * G + c, u); }
};
struct SchedMix {
    SchedGrid g;
    __device__ __forceinline__ bool next(int i, Unit& u) const { if (!g.tile((long)(i >> 1) * g.G + g.c, u)) return false; u.aux = i & 1; u.aoff += (i & 1) * 1024; u.boff += (i & 1) * 1024; return true; }
};
struct SchedMoE {
    const volatile LAS int* TS; int npn, G, c; long ta, tbe, tbn; int rep;
    __device__ __forceinline__ bool next(int i, Unit& u) const {
        long L = (long)i * G + c; const int ntile = TS[32]; if (L >= (long)ntile * npn * rep) return false; if (L >= (long)ntile * npn) L -= (long)ntile * npn;
        const int st = (int)(L / npn), pn = (int)(L % npn); int e = 0;
        for (int k = 1; k < 32; ++k) e += (st >= TS[k]) ? 1 : 0;
        u.pm = st; u.pn = pn; u.aux = e; u.pad = 0; u.aoff = st * ta; u.boff = e * tbe + pn * tbn; return true;
    }
};

template <class Epi, class Sched>
__device__ __forceinline__ void gemm_phase(LAS unsigned char* lds, const Gemm g, const Sched& S, const Epi& E, const int wave) {
    const int wid = wave, lane = lane_id(), tid = wid * 64 + lane, wr = wid >> 2, wc = wid & 3, fr = lane & 15, fq = lane >> 4;
    const int K = g.K, nt = K / BK;
    unsigned voffA[2], voffB[2];
#pragma unroll
    for (int i = 0; i < 2; ++i) { int R, C; stage_rc(tid * 16 + i * 8192, R, C); const int Rb = (R & ~31) + perm32(R & 31);
        voffA[i] = (unsigned)(R * g.lda + C) * 2u; voffB[i] = (unsigned)(Rb * g.ldb + C) * 2u; }
    const size_t kstep = (size_t)(BK * 2);
    const size_t hsA = (size_t)HALF * g.lda * 2, hsB = (size_t)HALF * g.ldb * 2;
    const unsigned ldsw = (unsigned)wid * 1024u;
    const int aoff = lds_byte(wr * 64 + fr, fq * 8), boff = lds_byte(wc * 32 + fr, fq * 8);
#define PG8_SA(b, h) (((b) * 2 + (h)) * HTB)
#define PG8_SB(b, h) ((4 + (b) * 2 + (h)) * HTB)
#define PG8_STAGE(bufoff, gbase, voff) do { _Pragma("unroll") for (int _i = 0; _i < 2; ++_i) \
        __builtin_amdgcn_global_load_lds((const unsigned*)((const char*)(gbase) + (voff)[_i]), (LAS unsigned*)(lds + (bufoff) + ldsw + _i * 8192), 16, 0, 0); } while (0)
#define PG8_LDA(dst, b, h) do { _Pragma("unroll") for (int m = 0; m < 4; ++m) _Pragma("unroll") for (int k = 0; k < 2; ++k) dst[m][k] = *(const LAS bf16x8*)(lds + PG8_SA(b, h) + aoff + m * 2048 + k * 1024); } while (0)
#define PG8_LDB(dst, b, h) do { _Pragma("unroll") for (int n = 0; n < 2; ++n) _Pragma("unroll") for (int k = 0; k < 2; ++k) dst[n][k] = *(const LAS bf16x8*)(lds + PG8_SB(b, h) + boff + n * 2048 + k * 1024); } while (0)
#define PG8_MMA(ai, bj, At, Bt) do { __builtin_amdgcn_s_setprio(1); _Pragma("unroll") for (int m = 0; m < 4; ++m) _Pragma("unroll") for (int n = 0; n < 2; ++n) _Pragma("unroll") for (int k = 0; k < 2; ++k) \
        acc[ai][bj][m][n] = __builtin_amdgcn_mfma_f32_16x16x32_bf16(Bt[n][k], At[m][k], acc[ai][bj][m][n], 0, 0, 0); __builtin_amdgcn_s_setprio(0); } while (0)
#define PG8_WAIT_V(n) asm volatile("s_waitcnt vmcnt(" #n ")" ::: "memory")
#define PG8_WAIT_L(n) asm volatile("s_waitcnt lgkmcnt(" #n ")" ::: "memory")
#define PG8_BAR __builtin_amdgcn_s_barrier()
#define PG8_SCHED __builtin_amdgcn_sched_barrier(0)
    Unit cur, nxt; int ui = 0;
    if (!S.next(0, cur)) return;
    f32x4 acc[2][2][4][2];
#pragma unroll
    for (int a = 0; a < 2; ++a)
#pragma unroll
        for (int b = 0; b < 2; ++b)
#pragma unroll
            for (int m = 0; m < 4; ++m)
#pragma unroll
                for (int n = 0; n < 2; ++n) acc[a][b][m][n] = (f32x4){0.f, 0.f, 0.f, 0.f};
    bf16x8 At[4][2], B0[2][2], B1[2][2];
    const char* cA = (const char*)g.A + cur.aoff; const char* cB = (const char*)g.Bt + cur.boff;
    PG8_STAGE(PG8_SB(0, 0), cB, voffB); PG8_STAGE(PG8_SB(0, 1), cB + hsB, voffB); PG8_STAGE(PG8_SA(0, 0), cA, voffA); PG8_STAGE(PG8_SA(0, 1), cA + hsA, voffA);
    if (wr == 1) PG8_BAR;
    PG8_WAIT_V(2); PG8_BAR;
    PG8_STAGE(PG8_SB(1, 0), cB + kstep, voffB); PG8_STAGE(PG8_SA(1, 0), cA + kstep, voffA); PG8_STAGE(PG8_SB(1, 1), cB + hsB + kstep, voffB);
    PG8_WAIT_V(6); PG8_BAR;
    for (;;) {
        const bool has_next = S.next(ui + 1, nxt);
        const char* nA = has_next ? (const char*)g.A + nxt.aoff : cA; const char* nB = has_next ? (const char*)g.Bt + nxt.boff : cB;
        for (int t = 0; t < nt; t += 2) {
            const bool last = (t == nt - 2);
            const char* a1 = cA + (size_t)(t + 1) * kstep;
            const char* a2 = last ? nA : cA + (size_t)(t + 2) * kstep; const char* b2 = last ? nB : cB + (size_t)(t + 2) * kstep;
            const char* a3 = a2 + kstep; const char* b3 = b2 + kstep;
            PG8_LDB(B0, 0, 0); PG8_LDB(B1, 0, 1); PG8_SCHED; PG8_LDA(At, 0, 0); PG8_STAGE(PG8_SA(1, 1), a1 + hsA, voffA);
            PG8_WAIT_V(8); PG8_WAIT_L(0); PG8_BAR; PG8_MMA(0, 0, At, B0); PG8_MMA(0, 1, At, B1); PG8_BAR; PG8_SCHED;
            PG8_LDA(At, 0, 1); PG8_STAGE(PG8_SB(0, 0), b2, voffB); PG8_STAGE(PG8_SB(0, 1), b2 + hsB, voffB); PG8_STAGE(PG8_SA(0, 0), a2, voffA);
            PG8_WAIT_V(8); PG8_WAIT_L(0); PG8_BAR; PG8_MMA(1, 0, At, B0); PG8_MMA(1, 1, At, B1); PG8_BAR; PG8_SCHED;
            PG8_LDB(B0, 1, 0); PG8_LDB(B1, 1, 1); PG8_SCHED; PG8_LDA(At, 1, 0); PG8_STAGE(PG8_SA(0, 1), a2 + hsA, voffA);
            PG8_WAIT_V(8); PG8_WAIT_L(0); PG8_BAR; PG8_MMA(0, 0, At, B0); PG8_MMA(0, 1, At, B1); PG8_BAR; PG8_SCHED;
            PG8_LDA(At, 1, 1); PG8_STAGE(PG8_SB(1, 0), b3, voffB); PG8_STAGE(PG8_SB(1, 1), b3 + hsB, voffB); PG8_STAGE(PG8_SA(1, 0), a3, voffA);
            PG8_WAIT_V(8); PG8_WAIT_L(0); PG8_BAR; PG8_MMA(1, 0, At, B0); PG8_MMA(1, 1, At, B1); PG8_BAR; PG8_SCHED;
        }
        if (wr == 0) PG8_BAR;
        const bool keep = E(acc, cur, wr, wc, fr, fq);
        if (!has_next) break;
        if (!keep) {
#pragma unroll
            for (int a = 0; a < 2; ++a)
#pragma unroll
                for (int b = 0; b < 2; ++b)
#pragma unroll
                    for (int m = 0; m < 4; ++m)
#pragma unroll
                        for (int n = 0; n < 2; ++n) acc[a][b][m][n] = (f32x4){0.f, 0.f, 0.f, 0.f};
        }
        cur = nxt; cA = nA; cB = nB; ++ui;
        if (wr == 1) PG8_BAR;
    }
    PG8_WAIT_V(0);
    PG8_BAR;
#undef PG8_SA
#undef PG8_SB
#undef PG8_STAGE
#undef PG8_LDA
#undef PG8_LDB
#undef PG8_MMA
#undef PG8_WAIT_V
#undef PG8_WAIT_L
#undef PG8_BAR
#undef PG8_SCHED
}

template <class Epi, class Sched>
__device__ __forceinline__ void gemm_phase_g(LAS unsigned char* lds, const Gemm g, const Sched& S, const Epi& E, const int wave, const int* ROWS) {
    const int wid = wave, lane = lane_id(), tid = wid * 64 + lane, wr = wid >> 2, wc = wid & 3, fr = lane & 15, fq = lane >> 4;
    const int K = g.K, nt = K / BK;
    unsigned voffB[2]; int RA[2]; unsigned CA2[2];
#pragma unroll
    for (int i = 0; i < 2; ++i) { int R, C; stage_rc(tid * 16 + i * 8192, R, C); const int Rb = (R & ~31) + perm32(R & 31);
        RA[i] = R; CA2[i] = (unsigned)C * 2u; voffB[i] = (unsigned)(Rb * g.ldb + C) * 2u; }
    const unsigned rowb = (unsigned)g.lda * 2u;
    unsigned vcur[2][2], vnxt[2][2];
#define PG8_ROWS(dst, u) do { _Pragma("unroll") for (int h_ = 0; h_ < 2; ++h_) _Pragma("unroll") for (int i_ = 0; i_ < 2; ++i_) { const int t_ = ROWS[(u).pm * 256 + h_ * 128 + RA[i_]]; dst[h_][i_] = (unsigned)(t_ < 0 ? 0 : t_) * rowb + CA2[i_]; } } while (0)
    const size_t kstep = (size_t)(BK * 2);
    const size_t hsA = (size_t)HALF * g.lda * 2, hsB = (size_t)HALF * g.ldb * 2;
    const unsigned ldsw = (unsigned)wid * 1024u;
    const int aoff = lds_byte(wr * 64 + fr, fq * 8), boff = lds_byte(wc * 32 + fr, fq * 8);
#define PG8_SA(b, h) (((b) * 2 + (h)) * HTB)
#define PG8_SB(b, h) ((4 + (b) * 2 + (h)) * HTB)
#define PG8_STAGE(bufoff, gbase, voff) do { _Pragma("unroll") for (int _i = 0; _i < 2; ++_i) \
        __builtin_amdgcn_global_load_lds((const unsigned*)((const char*)(gbase) + (voff)[_i]), (LAS unsigned*)(lds + (bufoff) + ldsw + _i * 8192), 16, 0, 0); } while (0)
#define PG8_LDA(dst, b, h) do { _Pragma("unroll") for (int m = 0; m < 4; ++m) _Pragma("unroll") for (int k = 0; k < 2; ++k) dst[m][k] = *(const LAS bf16x8*)(lds + PG8_SA(b, h) + aoff + m * 2048 + k * 1024); } while (0)
#define PG8_LDB(dst, b, h) do { _Pragma("unroll") for (int n = 0; n < 2; ++n) _Pragma("unroll") for (int k = 0; k < 2; ++k) dst[n][k] = *(const LAS bf16x8*)(lds + PG8_SB(b, h) + boff + n * 2048 + k * 1024); } while (0)
#define PG8_MMA(ai, bj, At, Bt) do { __builtin_amdgcn_s_setprio(1); _Pragma("unroll") for (int m = 0; m < 4; ++m) _Pragma("unroll") for (int n = 0; n < 2; ++n) _Pragma("unroll") for (int k = 0; k < 2; ++k) \
        acc[ai][bj][m][n] = __builtin_amdgcn_mfma_f32_16x16x32_bf16(Bt[n][k], At[m][k], acc[ai][bj][m][n], 0, 0, 0); __builtin_amdgcn_s_setprio(0); } while (0)
#define PG8_WAIT_V(n) asm volatile("s_waitcnt vmcnt(" #n ")" ::: "memory")
#define PG8_WAIT_L(n) asm volatile("s_waitcnt lgkmcnt(" #n ")" ::: "memory")
#define PG8_BAR __builtin_amdgcn_s_barrier()
#define PG8_SCHED __builtin_amdgcn_sched_barrier(0)
    Unit cur, nxt, nn; int ui = 0;
    if (!S.next(0, cur)) return;
    bool has_next = S.next(1, nxt);
    PG8_ROWS(vcur, cur); if (has_next) { PG8_ROWS(vnxt, nxt); } else { _Pragma("unroll") for (int h_ = 0; h_ < 2; ++h_) _Pragma("unroll") for (int i_ = 0; i_ < 2; ++i_) vnxt[h_][i_] = vcur[h_][i_]; }
    f32x4 acc[2][2][4][2];
#pragma unroll
    for (int a = 0; a < 2; ++a)
#pragma unroll
        for (int b = 0; b < 2; ++b)
#pragma unroll
            for (int m = 0; m < 4; ++m)
#pragma unroll
                for (int n = 0; n < 2; ++n) acc[a][b][m][n] = (f32x4){0.f, 0.f, 0.f, 0.f};
    bf16x8 At[4][2], B0[2][2], B1[2][2];
    const char* cA = (const char*)g.A; const char* cB = (const char*)g.Bt + cur.boff;
    PG8_STAGE(PG8_SB(0, 0), cB, voffB); PG8_STAGE(PG8_SB(0, 1), cB + hsB, voffB); PG8_STAGE(PG8_SA(0, 0), cA, vcur[0]); PG8_STAGE(PG8_SA(0, 1), cA, vcur[1]);
    if (wr == 1) PG8_BAR;
    PG8_WAIT_V(2); PG8_BAR;
    PG8_STAGE(PG8_SB(1, 0), cB + kstep, voffB); PG8_STAGE(PG8_SA(1, 0), cA + kstep, vcur[0]); PG8_STAGE(PG8_SB(1, 1), cB + hsB + kstep, voffB);
    PG8_WAIT_V(6); PG8_BAR;
    for (;;) {
        const bool has_nn = has_next && S.next(ui + 2, nn);
        const char* nB = has_next ? (const char*)g.Bt + nxt.boff : cB;
        for (int t = 0; t < nt; t += 2) {
            const bool last = (t == nt - 2);
            const char* a1 = cA + (size_t)(t + 1) * kstep;
            const char* a2 = last ? cA : cA + (size_t)(t + 2) * kstep; const char* b2 = last ? nB : cB + (size_t)(t + 2) * kstep;
            unsigned v2[2][2];
#pragma unroll
            for (int h_ = 0; h_ < 2; ++h_)
#pragma unroll
                for (int i_ = 0; i_ < 2; ++i_) v2[h_][i_] = last ? vnxt[h_][i_] : vcur[h_][i_];
            const char* a3 = a2 + kstep; const char* b3 = b2 + kstep;
            PG8_LDB(B0, 0, 0); PG8_LDB(B1, 0, 1); PG8_SCHED; PG8_LDA(At, 0, 0); PG8_STAGE(PG8_SA(1, 1), a1, vcur[1]);
            PG8_WAIT_V(8); PG8_WAIT_L(0); PG8_BAR; PG8_MMA(0, 0, At, B0); PG8_MMA(0, 1, At, B1); PG8_BAR; PG8_SCHED;
            PG8_LDA(At, 0, 1); PG8_STAGE(PG8_SB(0, 0), b2, voffB); PG8_STAGE(PG8_SB(0, 1), b2 + hsB, voffB); PG8_STAGE(PG8_SA(0, 0), a2, v2[0]);
            PG8_WAIT_V(8); PG8_WAIT_L(0); PG8_BAR; PG8_MMA(1, 0, At, B0); PG8_MMA(1, 1, At, B1); PG8_BAR; PG8_SCHED;
            PG8_LDB(B0, 1, 0); PG8_LDB(B1, 1, 1); PG8_SCHED; PG8_LDA(At, 1, 0); PG8_STAGE(PG8_SA(0, 1), a2, v2[1]);
            PG8_WAIT_V(8); PG8_WAIT_L(0); PG8_BAR; PG8_MMA(0, 0, At, B0); PG8_MMA(0, 1, At, B1); PG8_BAR; PG8_SCHED;
            PG8_LDA(At, 1, 1); PG8_STAGE(PG8_SB(1, 0), b3, voffB); PG8_STAGE(PG8_SB(1, 1), b3 + hsB, voffB); PG8_STAGE(PG8_SA(1, 0), a3, v2[0]);
            PG8_WAIT_V(8); PG8_WAIT_L(0); PG8_BAR; PG8_MMA(1, 0, At, B0); PG8_MMA(1, 1, At, B1); PG8_BAR; PG8_SCHED;
        }
        if (wr == 0) PG8_BAR;
        unsigned vnn[2][2];
        if (has_nn) { PG8_ROWS(vnn, nn); } else { _Pragma("unroll") for (int h_ = 0; h_ < 2; ++h_) _Pragma("unroll") for (int i_ = 0; i_ < 2; ++i_) vnn[h_][i_] = vnxt[h_][i_]; }
        const bool keep = E(acc, cur, wr, wc, fr, fq);
        if (!has_next) break;
        if (!keep) {
#pragma unroll
            for (int a = 0; a < 2; ++a)
#pragma unroll
                for (int b = 0; b < 2; ++b)
#pragma unroll
                    for (int m = 0; m < 4; ++m)
#pragma unroll
                        for (int n = 0; n < 2; ++n) acc[a][b][m][n] = (f32x4){0.f, 0.f, 0.f, 0.f};
        }
        cur = nxt; nxt = nn; cB = nB; ++ui; has_next = has_nn;
#pragma unroll
        for (int h_ = 0; h_ < 2; ++h_)
#pragma unroll
            for (int i_ = 0; i_ < 2; ++i_) { vcur[h_][i_] = vnxt[h_][i_]; vnxt[h_][i_] = vnn[h_][i_]; }
        if (wr == 1) PG8_BAR;
    }
    PG8_WAIT_V(0);
    PG8_BAR;
#undef PG8_SA
#undef PG8_SB
#undef PG8_STAGE
#undef PG8_ROWS
#undef PG8_LDA
#undef PG8_LDB
#undef PG8_MMA
#undef PG8_WAIT_V
#undef PG8_WAIT_L
#undef PG8_BAR
#undef PG8_SCHED
}

__device__ __forceinline__ v4u pack8(const f32x4 v0, const f32x4 v1) { v4u w; w.x = cvt_pk_bf16(v0[0], v0[1]); w.y = cvt_pk_bf16(v0[2], v0[3]); w.z = cvt_pk_bf16(v1[0], v1[1]); w.w = cvt_pk_bf16(v1[2], v1[3]); return w; }
__device__ __forceinline__ void rot2(float& a, float& b, float c, float s) { const float x = a * c - b * s, y = b * c + a * s; a = x; b = y; }
__device__ __forceinline__ void rope8(f32x4& v0, f32x4& v1, const f32x4 c4, const f32x4 s4) {
    float a0 = v0[0], b0 = v0[1], a1 = v0[2], b1 = v0[3], a2 = v1[0], b2 = v1[1], a3 = v1[2], b3 = v1[3];
    rot2(a0, b0, c4[0], s4[0]); rot2(a1, b1, c4[1], s4[1]); rot2(a2, b2, c4[2], s4[2]); rot2(a3, b3, c4[3], s4[3]);
    v0 = (f32x4){a0, b0, a1, b1}; v1 = (f32x4){a2, b2, a3, b3};
}

struct EpiProj {
    bf16_t *CQ, *CKV, *KR, *QB, *KB, *VB, *SA, *SB; float *SSQ_Q, *SSQ_KV, *KSUM; const float *COSA, *SINA, *COSB, *SINB;
    __device__ __forceinline__ bool operator()(f32x4 (&acc)[2][2][4][2], const Unit& u, int wr, int wc, int fr, int fq) const {
        const int pn = u.pn, row0 = u.pm * BM + wr * 64 + fr, ct = wc * 32 + 8 * fq;
        if (pn < 4) {
            bf16_t* O; int ldc, cb, nss, sidx; float* SS;
            if (pn < 3) { O = CQ; ldc = QL; cb = pn * 256; SS = SSQ_Q; nss = 12; sidx = pn * 4 + wc; } else { O = CKV; ldc = KVL; cb = 0; SS = SSQ_KV; nss = 4; sidx = wc; }
#pragma unroll
            for (int ai = 0; ai < 2; ++ai)
#pragma unroll
                for (int m = 0; m < 4; ++m) { const int row = row0 + ai * HALF + m * 16; float s = 0.f;
#pragma unroll
                    for (int bj = 0; bj < 2; ++bj) { const f32x4 v0 = acc[ai][bj][m][0], v1 = acc[ai][bj][m][1]; s += dot4(v0) + dot4(v1);
                        *(v4u*)(O + (size_t)row * ldc + cb + bj * HALF + ct) = pack8(v0, v1); }
                    s += __shfl_xor(s, 16); s += __shfl_xor(s, 32);
                    if (fq == 0) SS[(size_t)row * nss + sidx] = s; }
        } else if (pn < 8) {
            const bool isq = pn < 6; bf16_t* O = isq ? QB : KB; const int cb = (pn - (isq ? 4 : 6)) * 256;
            const bool rope = ((wc & 1) == 0) && (fq < 2); const float sc = isq ? C2B : 1.f;
#pragma unroll
            for (int ai = 0; ai < 2; ++ai)
#pragma unroll
                for (int m = 0; m < 4; ++m) { const int row = row0 + ai * HALF + m * 16, pos = row & (SEQ - 1);
                    f32x4 c4 = (f32x4){1.f, 1.f, 1.f, 1.f}, s4 = (f32x4){0.f, 0.f, 0.f, 0.f};
                    if (rope) { c4 = *(const f32x4*)(COSB + pos * 8 + 4 * fq); s4 = *(const f32x4*)(SINB + pos * 8 + 4 * fq); }
#pragma unroll
                    for (int bj = 0; bj < 2; ++bj) { f32x4 v0 = acc[ai][bj][m][0], v1 = acc[ai][bj][m][1];
                        rope8(v0, v1, c4, s4); v0 = v0 * sc; v1 = v1 * sc;
                        *(v4u*)(O + (size_t)row * 512 + cb + bj * HALF + ct) = pack8(v0, v1); } }
            if (!isq) {
#pragma unroll
                for (int bj = 0; bj < 2; ++bj)
#pragma unroll
                    for (int n = 0; n < 2; ++n) { f32x4 v = (f32x4){0.f, 0.f, 0.f, 0.f};
#pragma unroll
                        for (int ai = 0; ai < 2; ++ai)
#pragma unroll
                            for (int m = 0; m < 4; ++m) { const int pos = (row0 + ai * HALF + m * 16) & (SEQ - 1);
                                float a0 = acc[ai][bj][m][n][0], b0 = acc[ai][bj][m][n][1], a1 = acc[ai][bj][m][n][2], b1 = acc[ai][bj][m][n][3];
                                if (rope) { const float* cp = COSB + pos * 8 + 4 * fq + 2 * n; const float* sp = SINB + pos * 8 + 4 * fq + 2 * n;
                                    rot2(a0, b0, cp[0], sp[0]); rot2(a1, b1, cp[1], sp[1]); }
                                v[0] += a0; v[1] += b0; v[2] += a1; v[3] += b1; }
#pragma unroll
                        for (int o = 1; o < 16; o <<= 1) { v[0] += __shfl_xor(v[0], o); v[1] += __shfl_xor(v[1], o); v[2] += __shfl_xor(v[2], o); v[3] += __shfl_xor(v[3], o); }
                        if (fr == 0) *(f32x4*)(KSUM + ((size_t)(wr * 256 + u.pm)) * 512 + cb + bj * HALF + ct + 4 * n) = v;
                        asm volatile("" ::: "memory"); }
            }
        } else if (pn < 10) {
            const int cb = (pn - 8) * 256;
#pragma unroll
            for (int ai = 0; ai < 2; ++ai)
#pragma unroll
                for (int m = 0; m < 4; ++m) { const int row = row0 + ai * HALF + m * 16;
#pragma unroll
                    for (int bj = 0; bj < 2; ++bj) *(v4u*)(VB + (size_t)row * 512 + cb + bj * HALF + ct) = pack8(acc[ai][bj][m][0], acc[ai][bj][m][1]); }
        } else if (pn < 18) {
            const int cb = (pn - 10) * 128;
#pragma unroll
            for (int ai = 0; ai < 2; ++ai)
#pragma unroll
                for (int m = 0; m < 4; ++m) { const int row = row0 + ai * HALF + m * 16;
                    f32x4 r0, r1, b0, b1;
#pragma unroll
                    for (int j = 0; j < 4; ++j) { const float sa0 = fsigmoid(acc[ai][0][m][0][j]), sa1 = fsigmoid(acc[ai][0][m][1][j]);
                        b0[j] = fmaxf(fsigmoid(acc[ai][1][m][0][j]), 1e-30f); b1[j] = fmaxf(fsigmoid(acc[ai][1][m][1][j]), 1e-30f);
                        r0[j] = sa0 * __builtin_amdgcn_rcpf(b0[j]); r1[j] = sa1 * __builtin_amdgcn_rcpf(b1[j]); }
                    *(v4u*)(SA + (size_t)row * DM + cb + ct) = pack8(r0, r1); *(v4u*)(SB + (size_t)row * DM + cb + ct) = pack8(b0, b1); }
        } else {
            if (wc == 0) {
#pragma unroll
                for (int ai = 0; ai < 2; ++ai)
#pragma unroll
                    for (int m = 0; m < 4; ++m) { const int row = row0 + ai * HALF + m * 16, pos = row & (SEQ - 1);
                        const f32x4 c4 = *(const f32x4*)(COSA + pos * 16 + 4 * fq), s4 = *(const f32x4*)(SINA + pos * 16 + 4 * fq);
                        f32x4 v0 = acc[ai][0][m][0], v1 = acc[ai][0][m][1]; rope8(v0, v1, c4, s4);
                        *(v4u*)(KR + (size_t)row * 32 + 8 * fq) = pack8(v0, v1); }
            }
        }
        return false;
    }
};
struct EpiPlain {
    bf16_t* O;
    __device__ __forceinline__ bool operator()(f32x4 (&acc)[2][2][4][2], const Unit& u, int wr, int wc, int fr, int fq) const {
        const int row0 = (u.pm & 15) * BM + wr * 64 + fr, ct = wc * 32 + 8 * fq;
#pragma unroll
        for (int ai = 0; ai < 2; ++ai)
#pragma unroll
            for (int m = 0; m < 4; ++m) { const int row = row0 + ai * HALF + m * 16;
#pragma unroll
                for (int bj = 0; bj < 2; ++bj) *(v4u*)(O + (size_t)row * NPROJ + u.pn * 256 + bj * HALF + ct) = pack8(acc[ai][bj][m][0], acc[ai][bj][m][1]); }
        return false;
    }
};
struct EpiQ {
    bf16_t* QA; const float *SSQ_Q, *COSA, *SINA;
    __device__ __forceinline__ bool operator()(f32x4 (&acc)[2][2][4][2], const Unit& u, int wr, int wc, int fr, int fq) const {
        const int row0 = u.pm * BM + wr * 64 + fr;
        bool isrope[2];
#pragma unroll
        for (int bj = 0; bj < 2; ++bj) isrope[bj] = (((u.pn * 256 + bj * HALF + wc * 32) >> 5) % 3) == 2;
        const bool anyrope = isrope[0] || isrope[1];
#pragma unroll
        for (int ai = 0; ai < 2; ++ai) { float rs[4]; f32x4 c4[4], s4[4];
            { f32x4 p[4][3];
#pragma unroll
              for (int m = 0; m < 4; ++m) { const size_t row = (size_t)(row0 + ai * HALF + m * 16);
#pragma unroll
                  for (int k = 0; k < 3; ++k) p[m][k] = *(const f32x4*)(SSQ_Q + row * 12 + 4 * k); }
              if (anyrope) {
#pragma unroll
                  for (int m = 0; m < 4; ++m) { const int pos = (row0 + ai * HALF + m * 16) & (SEQ - 1); c4[m] = *(const f32x4*)(COSA + pos * 16 + 4 * fq); s4[m] = *(const f32x4*)(SINA + pos * 16 + 4 * fq); } }
#pragma unroll
              for (int m = 0; m < 4; ++m) { float ss = 0.f;
#pragma unroll
                  for (int k = 0; k < 3; ++k)
#pragma unroll
                      for (int j = 0; j < 4; ++j) ss += p[m][k][j];
                  rs[m] = C2A / sqrtf(ss * (1.f / QL) + EPS); } }
#pragma unroll
            for (int m = 0; m < 4; ++m) { const int row = row0 + ai * HALF + m * 16;
#pragma unroll
                for (int bj = 0; bj < 2; ++bj) { const int cg = u.pn * 256 + bj * HALF + wc * 32;
                    f32x4 v0 = acc[ai][bj][m][0] * rs[m], v1 = acc[ai][bj][m][1] * rs[m];
                    if (isrope[bj]) rope8(v0, v1, c4[m], s4[m]);
                    *(v4u*)(QA + (size_t)row * QL + cg + 8 * fq) = pack8(v0, v1); } }
            asm volatile("" ::: "memory"); }
        return false;
    }
};
struct EpiKV {
    bf16_t* KV; const float* SSQ_KV;
    __device__ __forceinline__ bool operator()(f32x4 (&acc)[2][2][4][2], const Unit& u, int wr, int wc, int fr, int fq) const {
        const int row0 = u.pm * BM + wr * 64 + fr, ct = wc * 32 + 8 * fq;
        f32x4 p[2][4];
#pragma unroll
        for (int ai = 0; ai < 2; ++ai)
#pragma unroll
            for (int m = 0; m < 4; ++m) p[ai][m] = *(const f32x4*)(SSQ_KV + (size_t)(row0 + ai * HALF + m * 16) * 4);
#pragma unroll
        for (int ai = 0; ai < 2; ++ai)
#pragma unroll
            for (int m = 0; m < 4; ++m) { const int row = row0 + ai * HALF + m * 16;
                const float ss = ((p[ai][m][0] + p[ai][m][1]) + p[ai][m][2]) + p[ai][m][3];
                const float rs = 1.f / sqrtf(ss * (1.f / KVL) + EPS);
#pragma unroll
                for (int bj = 0; bj < 2; ++bj) *(v4u*)(KV + (size_t)row * DM + u.pn * 256 + bj * HALF + ct) = pack8(acc[ai][bj][m][0] * rs, acc[ai][bj][m][1] * rs); }
        return false;
    }
};
struct EpiMix {
    bf16_t* MIX; const bf16_t *RA, *SB;
    __device__ __forceinline__ bool operator()(f32x4 (&acc)[2][2][4][2], const Unit& u, int wr, int wc, int fr, int fq) const {
        const int row0 = u.pm * BM + wr * 64 + fr, ct = wc * 32 + 8 * fq; const bool first = (u.aux == 0);
        const bf16_t* G = first ? RA : SB;
        v4u gq[2][4][2];
#pragma unroll
        for (int ai = 0; ai < 2; ++ai)
#pragma unroll
            for (int m = 0; m < 4; ++m)
#pragma unroll
                for (int bj = 0; bj < 2; ++bj) gq[ai][m][bj] = *(const v4u*)(G + (size_t)(row0 + ai * HALF + m * 16) * DM + u.pn * 256 + bj * HALF + ct);
#pragma unroll
        for (int ai = 0; ai < 2; ++ai)
#pragma unroll
            for (int m = 0; m < 4; ++m)
#pragma unroll
                for (int bj = 0; bj < 2; ++bj) { const v4u gv = gq[ai][m][bj];
                    const float gf[8] = {bflo(gv.x), bfhi(gv.x), bflo(gv.y), bfhi(gv.y), bflo(gv.z), bfhi(gv.z), bflo(gv.w), bfhi(gv.w)};
                    f32x4 v0 = acc[ai][bj][m][0], v1 = acc[ai][bj][m][1];
#pragma unroll
                    for (int j = 0; j < 4; ++j) { v0[j] *= gf[j]; v1[j] *= gf[4 + j]; }
                    if (first) { acc[ai][bj][m][0] = v0; acc[ai][bj][m][1] = v1; }
                    else *(v4u*)(MIX + (size_t)(row0 + ai * HALF + m * 16) * DM + u.pn * 256 + bj * HALF + ct) = pack8(v0, v1); }
        return first;
    }
};
struct EpiOut {
    const float* X; bf16_t* X2L; bf16_t* X2B; float* SSQ_X;
    __device__ __forceinline__ bool operator()(f32x4 (&acc)[2][2][4][2], const Unit& u, int wr, int wc, int fr, int fq) const {
        const int row0 = u.pm * BM + wr * 64 + fr, ct = wc * 32 + 8 * fq;
#pragma unroll
        for (int ai = 0; ai < 2; ++ai) { f32x4 xv[4][2][2];
#pragma unroll
            for (int m = 0; m < 4; ++m)
#pragma unroll
                for (int bj = 0; bj < 2; ++bj) { const size_t off = (size_t)(row0 + ai * HALF + m * 16) * DM + u.pn * 256 + bj * HALF + ct; xv[m][bj][0] = *(const f32x4*)(X + off); xv[m][bj][1] = *(const f32x4*)(X + off + 4); }
#pragma unroll
            for (int m = 0; m < 4; ++m) { const int row = row0 + ai * HALF + m * 16; float s = 0.f;
#pragma unroll
                for (int bj = 0; bj < 2; ++bj) { const size_t off = (size_t)row * DM + u.pn * 256 + bj * HALF + ct;
                    const f32x4 v0 = acc[ai][bj][m][0] + xv[m][bj][0], v1 = acc[ai][bj][m][1] + xv[m][bj][1];
                    s += dot4(v0) + dot4(v1);
                    const v4u hp = pack8(v0, v1);
                    const f32x4 l0 = (f32x4){v0[0] - bflo(hp.x), v0[1] - bfhi(hp.x), v0[2] - bflo(hp.y), v0[3] - bfhi(hp.y)}, l1 = (f32x4){v1[0] - bflo(hp.z), v1[1] - bfhi(hp.z), v1[2] - bflo(hp.w), v1[3] - bfhi(hp.w)};
                    *(v4u*)(X2B + off) = hp;
#if !RES_BF16
                    *(v4u*)(X2L + off) = pack8(l0, l1);
#endif
                    }
                s += __shfl_xor(s, 16); s += __shfl_xor(s, 32);
                if (fq == 0) SSQ_X[(size_t)row * 16 + u.pn * 4 + wc] = s; } }
        return false;
    }
};
struct EpiH {
    bf16_t* H; const float* SLOT_RS;
    __device__ __forceinline__ bool operator()(f32x4 (&acc)[2][2][4][2], const Unit& u, int wr, int wc, int fr, int fq) const {
        const int row0 = u.pm * BM + wr * 64 + fr, ct = wc * 32 + 8 * fq;
        float rsv[2][4];
#pragma unroll
        for (int ai = 0; ai < 2; ++ai)
#pragma unroll
            for (int m = 0; m < 4; ++m) rsv[ai][m] = SLOT_RS[row0 + ai * HALF + m * 16];
#pragma unroll
        for (int ai = 0; ai < 2; ++ai)
#pragma unroll
            for (int m = 0; m < 4; ++m) { const int row = row0 + ai * HALF + m * 16; const float rs = rsv[ai][m];
                f32x4 h0, h1;
#pragma unroll
                for (int j = 0; j < 4; ++j) { const float g0 = acc[ai][0][m][0][j] * rs, g1 = acc[ai][0][m][1][j] * rs;
                    h0[j] = g0 * fsigmoid(g0) * (acc[ai][1][m][0][j] * rs); h1[j] = g1 * fsigmoid(g1) * (acc[ai][1][m][1][j] * rs); }
                *(v4u*)(H + (size_t)row * EFF + u.pn * HALF + ct) = pack8(h0, h1); }
        return false;
    }
};
struct EpiY {
    bf16_t* Y; const int* SLOT_A; const float* TOKW;
    __device__ __forceinline__ bool operator()(f32x4 (&acc)[2][2][4][2], const Unit& u, int wr, int wc, int fr, int fq) const {
        const int row0 = u.pm * BM + wr * 64 + fr, ct = wc * 32 + 8 * fq;
#pragma unroll
        for (int ai = 0; ai < 2; ++ai) { int av[4]; float wv[4];
#pragma unroll
            for (int m = 0; m < 4; ++m) av[m] = SLOT_A[row0 + ai * HALF + m * 16];
#pragma unroll
            for (int m = 0; m < 4; ++m) wv[m] = TOKW[av[m] < 0 ? 0 : av[m]];
#pragma unroll
            for (int m = 0; m < 4; ++m) { const int a = av[m];
                if (a >= 0) { const float w = wv[m]; bf16_t* yr = Y + (unsigned)a * (unsigned)DM + (unsigned)(u.pn * 256 + ct);
#pragma unroll
                    for (int bj = 0; bj < 2; ++bj) *(v4u*)(yr + bj * HALF) = pack8(acc[ai][bj][m][0] * w, acc[ai][bj][m][1] * w); } }
            asm volatile("" ::: "memory"); }
        return false;
    }
};
}

namespace at {
constexpr int NW = 8, QBLK = 32, QB = 256, KVBLK = 64;
constexpr int KSLOT = 12288, VSLOT = 8192;
constexpr int LDS_K = 0, LDS_V = 2 * KSLOT, LDS_WS = LDS_V + 2 * VSLOT, LDS_OST = LDS_WS + NW * 64 * 4, LDS_TOTAL = LDS_OST + NW * 4096;
typedef LAS const char* lds_cptr;
__device__ __forceinline__ int crow(int r, int hi) { return (r & 3) + 8 * (r >> 2) + 4 * hi; }
__device__ __forceinline__ void glds16(const void* gsrc, unsigned lds_dst) { unsigned keep;
    asm volatile("s_mov_b32 %0, m0\n\ts_mov_b32 m0, %2\n\ts_nop 0\n\tglobal_load_lds_dwordx4 %1, off\n\ts_mov_b32 m0, %0" : "=&s"(keep) : "v"(gsrc), "s"(lds_dst) : "memory"); }
__device__ __forceinline__ void glds16s(const void* sbase, unsigned voff, unsigned lds_dst) { unsigned keep;
    asm volatile("s_mov_b32 %0, m0\n\ts_mov_b32 m0, %3\n\ts_nop 0\n\tglobal_load_lds_dwordx4 %1, %2\n\ts_mov_b32 m0, %0" : "=&s"(keep) : "v"(voff), "s"(sbase), "s"(lds_dst) : "memory"); }
#define AT_WAIT_BAR0() asm volatile("s_waitcnt vmcnt(0) lgkmcnt(0)\n\ts_barrier" ::: "memory")
__device__ __forceinline__ void cmask(f32x16& p0, f32x16& p1, int jb, int qrel, int hi) {
    const float NEG = -INFINITY; const int qh = qrel - 4 * hi - 64 * jb;
#pragma unroll
    for (int r = 0; r < 16; ++r) { const int c = (r & 3) + 8 * (r >> 2); if (c > qh) p0[r] = NEG; if (c + 32 > qh) p1[r] = NEG; }
}
template <int ND> __device__ __forceinline__ void qkt(f32x16& p0, f32x16& p1, lds_cptr kb, const bf16x8* qr) {
    f32x16 z0 = {}, z1 = {};
#pragma unroll
    for (int d0 = 0; d0 < ND; ++d0) {
        const bf16x8 b0 = *(const LAS bf16x8*)(kb + d0 * 2048), b1 = *(const LAS bf16x8*)(kb + d0 * 2048 + 512);
        z0 = __builtin_amdgcn_mfma_f32_32x32x16_bf16(b0, qr[d0], z0, 0, 0, 0); z1 = __builtin_amdgcn_mfma_f32_32x32x16_bf16(b1, qr[d0], z1, 0, 0, 0); }
    p0 = z0; p1 = z1;
}
__device__ __forceinline__ float rowmax(const f32x16& p0, const f32x16& p1) {
    float a = fmaxf(p0[0], p1[0]);
#pragma unroll
    for (int r = 1; r < 16; ++r) a = fmaxf(a, fmaxf(p0[r], p1[r]));
    auto rr = __builtin_amdgcn_permlane32_swap(__float_as_uint(a), __float_as_uint(a), false, false);
    return fmaxf(__uint_as_float(rr[0]), __uint_as_float(rr[1]));
}
__device__ __forceinline__ void pv(f32x16* o, int vb, bf16x8 pa0, bf16x8 pa1, bf16x8 pa2, bf16x8 pa3) {
#pragma unroll
    for (int d0 = 0; d0 < 2; ++d0) { s16x4 lo[4], hi[4];
#pragma unroll
        for (int ks = 0; ks < 4; ++ks) {
            asm volatile("ds_read_b64_tr_b16 %0,%1 offset:%c2" : "=&v"(lo[ks]) : "v"(vb), "i"(d0 * 4096 + ks * 1024) : "memory");
            asm volatile("ds_read_b64_tr_b16 %0,%1 offset:%c2" : "=&v"(hi[ks]) : "v"(vb), "i"(d0 * 4096 + ks * 1024 + 512) : "memory"); }
        asm volatile("s_waitcnt lgkmcnt(0)" ::: "memory"); __builtin_amdgcn_sched_barrier(0);
#define AT_PK(k) (bf16x8){lo[k][0], lo[k][1], lo[k][2], lo[k][3], hi[k][0], hi[k][1], hi[k][2], hi[k][3]}
        o[d0] = __builtin_amdgcn_mfma_f32_32x32x16_bf16(pa0, AT_PK(0), o[d0], 0, 0, 0);
        o[d0] = __builtin_amdgcn_mfma_f32_32x32x16_bf16(pa1, AT_PK(1), o[d0], 0, 0, 0);
        o[d0] = __builtin_amdgcn_mfma_f32_32x32x16_bf16(pa2, AT_PK(2), o[d0], 0, 0, 0);
        o[d0] = __builtin_amdgcn_mfma_f32_32x32x16_bf16(pa3, AT_PK(3), o[d0], 0, 0, 0);
#undef AT_PK
    }
}
struct MobaX { const unsigned* SELh; const unsigned short* lst; int lcnt, ltile; bf16* PO; float* PML; long qh0; };
template <int DQ, int MODE>
__device__ __forceinline__ void attn_unit(int qb, const bf16* Qh, int qp, const bf16* Kh, int kp, const bf16* Krh, const bf16* Vh, int vp, bf16* Oh, int op, const MobaX X, LAS char* shm, const int wave) {
    constexpr int ND = DQ / 16;
    const int lane = lane_id(), r32 = lane & 31, hi = lane >> 5; const int wid = wave;
    const int q0 = qb * QB;
    const int t0 = (MODE == 0) ? 0 : 4 * qb, NT = (MODE == 0) ? 4 * qb + 4 : 4;
    int srow = q0 + wid * QBLK + r32; bool valid = true;
    if (MODE == 2) { const int li = X.ltile * 256 + wid * QBLK + r32; valid = li < X.lcnt; srow = (int)X.lst[valid ? li : X.lcnt - 1]; }
    const unsigned lds0 = (unsigned)(uintptr_t)shm;
    LAS float* wsf = (LAS float*)(shm + LDS_WS) + wid * 64;
    const bf16* ksrc = Kh + (size_t)lane * kp + wid * 8;
    const bf16* krsrc = (DQ == 96) ? (Krh + (size_t)lane * 32 + (wid & 3) * 8) : nullptr;
    const bf16* vsrc = Vh + (size_t)(16 * (wid & 3) + (lane >> 2)) * vp + (wid >> 2) * 32 + (lane & 3) * 8;
    const unsigned kdst = lds0 + LDS_K + wid * 1024, krdst = lds0 + LDS_K + (8 + (wid & 3)) * 1024, vdst = lds0 + LDS_V + wid * 1024;
#define AT_DMA(t, s) do { glds16(ksrc + (size_t)(t0 + (t)) * KVBLK * kp, (unsigned)__builtin_amdgcn_readfirstlane(kdst + (s) * KSLOT)); \
        if (DQ == 96 && wid < 4) glds16(krsrc + (size_t)(t0 + (t)) * KVBLK * 32, (unsigned)__builtin_amdgcn_readfirstlane(krdst + (s) * KSLOT)); \
        glds16(vsrc + (size_t)(t0 + (t)) * KVBLK * vp, (unsigned)__builtin_amdgcn_readfirstlane(vdst + (s) * VSLOT)); } while (0)
    const int vb0 = (int)(lds0 + LDS_V) + ((lane >> 4) & 1) * 32 + (lane & 3) * 8 + (4 * hi + ((lane & 15) >> 2)) * 64;
    const lds_cptr kp0 = (lds_cptr)shm + LDS_K + hi * 1024 + r32 * 16;
    AT_DMA(0, 0);
    bf16x8 qr[ND];
#pragma unroll
    for (int d0 = 0; d0 < ND; ++d0) qr[d0] = *(const bf16x8*)(Qh + (size_t)srow * qp + d0 * 16 + hi * 8);
    float mrow = -1e30f, l_reg = 0.f; f32x16 o[2]; o[0] = f32x16{}; o[1] = f32x16{};
    const int qrel = wid * QBLK + r32;
    for (int t = 0; t < NT; ++t) {
        AT_WAIT_BAR0();
        const int sl = t & 1;
        if (t + 1 < NT) AT_DMA(t + 1, sl ^ 1);
        f32x16 p0, p1; qkt<ND>(p0, p1, kp0 + sl * KSLOT, qr);
        if (MODE != 2) { if (t >= NT - 4) cmask(p0, p1, t - (NT - 4), qrel, hi); }
        const float rm = rowmax(p0, p1);
        const float mnew = fmaxf(mrow, rm); const float alpha = __builtin_amdgcn_exp2f(mrow - mnew); mrow = mnew;
        float s = 0.f;
#pragma unroll
        for (int r = 0; r < 16; ++r) { p0[r] = __builtin_amdgcn_exp2f(p0[r] - mnew); p1[r] = __builtin_amdgcn_exp2f(p1[r] - mnew); s += p0[r] + p1[r]; }
        l_reg = l_reg * alpha + s;
        if (__any(alpha != 1.f)) {
            if (hi == 0) wsf[r32] = alpha;
            asm volatile("s_waitcnt lgkmcnt(0)" ::: "memory");
#pragma unroll
            for (int r = 0; r < 16; ++r) { const float a = wsf[crow(r, hi)]; o[0][r] *= a; o[1][r] *= a; }
        }
        v4u pw0, pw1, pw2, pw3;
        pw0 = (v4u){cvt_pk_bf16(p0[0], p0[1]), cvt_pk_bf16(p0[2], p0[3]), cvt_pk_bf16(p0[4], p0[5]), cvt_pk_bf16(p0[6], p0[7])};
        pw1 = (v4u){cvt_pk_bf16(p0[8], p0[9]), cvt_pk_bf16(p0[10], p0[11]), cvt_pk_bf16(p0[12], p0[13]), cvt_pk_bf16(p0[14], p0[15])};
        pw2 = (v4u){cvt_pk_bf16(p1[0], p1[1]), cvt_pk_bf16(p1[2], p1[3]), cvt_pk_bf16(p1[4], p1[5]), cvt_pk_bf16(p1[6], p1[7])};
        pw3 = (v4u){cvt_pk_bf16(p1[8], p1[9]), cvt_pk_bf16(p1[10], p1[11]), cvt_pk_bf16(p1[12], p1[13]), cvt_pk_bf16(p1[14], p1[15])};
        pv(o, vb0 + sl * VSLOT, __builtin_bit_cast(bf16x8, pw0), __builtin_bit_cast(bf16x8, pw1), __builtin_bit_cast(bf16x8, pw2), __builtin_bit_cast(bf16x8, pw3));
    }
    { auto rr = __builtin_amdgcn_permlane32_swap(__float_as_uint(l_reg), __float_as_uint(l_reg), false, false); l_reg = __uint_as_float(rr[0]) + __uint_as_float(rr[1]); }
    LAS int* wsi = (LAS int*)wsf;
    if (hi == 0) { wsf[32 + r32] = l_reg;
        if (MODE == 1) wsf[r32] = mrow;
        if (MODE == 2) { const unsigned sel = X.SELh[srow]; const int rank = __builtin_popcount(sel & ((1u << qb) - 1u)); const long pidx = (X.qh0 + (long)srow) * 3 + rank;
            wsi[r32] = valid ? (int)pidx : -1; if (valid) { X.PML[pidx * 2] = mrow; X.PML[pidx * 2 + 1] = l_reg; } } }
    asm volatile("s_waitcnt lgkmcnt(0)" ::: "memory");
    float rli[16];
#pragma unroll
    for (int r = 0; r < 16; ++r) rli[r] = 1.f / wsf[32 + crow(r, hi)];
    { LAS bf16* stg = (LAS bf16*)(shm + LDS_OST) + wid * 2048;
#pragma unroll
      for (int r = 0; r < 16; ++r) { const int orow = crow(r, hi);
#pragma unroll
        for (int d0 = 0; d0 < 2; ++d0) stg[orow * 64 + d0 * 32 + r32] = (bf16)f2bf(o[d0][r] * rli[r]); }
      asm volatile("s_waitcnt lgkmcnt(0)" ::: "memory");
#pragma unroll
      for (int i = 0; i < 4; ++i) { const int row = i * 8 + (lane >> 3), ch = lane & 7; const v4u v = *(const LAS v4u*)(stg + row * 64 + ch * 8);
          if (MODE == 0) { *(v4u*)(Oh + (size_t)(q0 + wid * QBLK + row) * op + ch * 8) = v; }
          else if (MODE == 2) { const int pid = wsi[row]; if (pid >= 0) *(v4u*)(X.PO + (size_t)pid * 64 + ch * 8) = v; }
          else { const int sq = q0 + wid * QBLK + row; const long qh = X.qh0 + (long)sq; const unsigned sel = X.SELh[sq]; const int np = __builtin_popcount(sel);
              const float m0 = wsf[row], l0 = wsf[32 + row];
              float mi[3], li[3]; v4u oi[3]; float mmax = m0;
#pragma unroll
              for (int k = 0; k < 3; ++k) { mi[k] = -1e30f; li[k] = 0.f; oi[k] = (v4u){0u, 0u, 0u, 0u};
                  if (k < np) { mi[k] = X.PML[(qh * 3 + k) * 2]; li[k] = X.PML[(qh * 3 + k) * 2 + 1]; oi[k] = *(const v4u*)(X.PO + (size_t)(qh * 3 + k) * 64 + ch * 8); }
                  mmax = fmaxf(mmax, mi[k]); }
              const float w0 = l0 * __builtin_amdgcn_exp2f(m0 - mmax); float wk[3], wsum = w0;
#pragma unroll
              for (int k = 0; k < 3; ++k) { wk[k] = li[k] * __builtin_amdgcn_exp2f(mi[k] - mmax); wsum += wk[k]; }
              const float inv = 1.f / wsum;
              float r8[8] = {bflo(v.x), bfhi(v.x), bflo(v.y), bfhi(v.y), bflo(v.z), bfhi(v.z), bflo(v.w), bfhi(v.w)};
#pragma unroll
              for (int e = 0; e < 8; ++e) r8[e] *= w0;
#pragma unroll
              for (int k = 0; k < 3; ++k) { const v4u u = oi[k]; r8[0] += wk[k] * bflo(u.x); r8[1] += wk[k] * bfhi(u.x); r8[2] += wk[k] * bflo(u.y); r8[3] += wk[k] * bfhi(u.y);
                  r8[4] += wk[k] * bflo(u.z); r8[5] += wk[k] * bfhi(u.z); r8[6] += wk[k] * bflo(u.w); r8[7] += wk[k] * bfhi(u.w); }
              v4u w; w.x = cvt_pk_bf16(r8[0] * inv, r8[1] * inv); w.y = cvt_pk_bf16(r8[2] * inv, r8[3] * inv); w.z = cvt_pk_bf16(r8[4] * inv, r8[5] * inv); w.w = cvt_pk_bf16(r8[6] * inv, r8[7] * inv);
              *(v4u*)(Oh + (size_t)sq * op + ch * 8) = w; } } }
    asm volatile("s_waitcnt lgkmcnt(0)\n\ts_barrier" ::: "memory");
#undef AT_DMA
}
constexpr int MB_K = 0, MB_V = 32768, MB_WS = 65536, MB_OST = MB_WS + NW * 256, MB_TOTAL = MB_OST + NW * 4096;
template <int TOFF>
__device__ __forceinline__ void pv4(f32x16 (&o)[2][2], int vb, const v4u p0, const v4u p1, const v4u p2, const v4u p3) {
#pragma unroll
    for (int d0 = 0; d0 < 2; ++d0) { s16x4 lo[4], hh[4];
#pragma unroll
        for (int ks = 0; ks < 4; ++ks) {
            asm volatile("ds_read_b64_tr_b16 %0,%1 offset:%c2" : "=&v"(lo[ks]) : "v"(vb), "i"(TOFF + d0 * 4096 + ks * 1024) : "memory");
            asm volatile("ds_read_b64_tr_b16 %0,%1 offset:%c2" : "=&v"(hh[ks]) : "v"(vb), "i"(TOFF + d0 * 4096 + ks * 1024 + 512) : "memory"); }
        asm volatile("s_waitcnt lgkmcnt(0)" ::: "memory"); __builtin_amdgcn_sched_barrier(0);
#define AT_PK(k) (bf16x8){lo[k][0], lo[k][1], lo[k][2], lo[k][3], hh[k][0], hh[k][1], hh[k][2], hh[k][3]}
        if (MOBA_PRIO & 2) __builtin_amdgcn_s_setprio(1);
        o[d0][0] = __builtin_amdgcn_mfma_f32_32x32x16_bf16(__builtin_bit_cast(bf16x8, p0), AT_PK(0), o[d0][0], 0, 0, 0);
        o[d0][1] = __builtin_amdgcn_mfma_f32_32x32x16_bf16(__builtin_bit_cast(bf16x8, p1), AT_PK(1), o[d0][1], 0, 0, 0);
        o[d0][0] = __builtin_amdgcn_mfma_f32_32x32x16_bf16(__builtin_bit_cast(bf16x8, p2), AT_PK(2), o[d0][0], 0, 0, 0);
        o[d0][1] = __builtin_amdgcn_mfma_f32_32x32x16_bf16(__builtin_bit_cast(bf16x8, p3), AT_PK(3), o[d0][1], 0, 0, 0);
        if (MOBA_PRIO & 2) __builtin_amdgcn_s_setprio(0);
#undef AT_PK
    }
}
template <int T>
__device__ __forceinline__ void mb_tile_qk(f32x16& P0, f32x16& P1, lds_cptr kp0, const bf16x8* qr, int tmax) {
    if (T <= tmax) { f32x16 z0 = {}, z1 = {}; if (MOBA_PRIO & 1) __builtin_amdgcn_s_setprio(1);
#pragma unroll
        for (int d0 = 0; d0 < 4; ++d0) { const bf16x8 b0 = *(const LAS bf16x8*)(kp0 + T * 8192 + d0 * 2048), b1 = *(const LAS bf16x8*)(kp0 + T * 8192 + d0 * 2048 + 512);
            z0 = __builtin_amdgcn_mfma_f32_32x32x16_bf16(b0, qr[d0], z0, 0, 0, 0); z1 = __builtin_amdgcn_mfma_f32_32x32x16_bf16(b1, qr[d0], z1, 0, 0, 0); }
        if (MOBA_PRIO & 1) __builtin_amdgcn_s_setprio(0); P0 = z0; P1 = z1;
    } else {
#pragma unroll
        for (int r = 0; r < 16; ++r) { P0[r] = -INFINITY; P1[r] = -INFINITY; } }
}
__device__ __forceinline__ void mb_exp_pack(const f32x16& Pt, float mx, float& l, v4u& w0, v4u& w1) {
    f32x16 e;
#pragma unroll
    for (int r = 0; r < 16; ++r) { e[r] = __builtin_amdgcn_exp2f(Pt[r] - mx); l += e[r]; }
    w0 = (v4u){cvt_pk_bf16(e[0], e[1]), cvt_pk_bf16(e[2], e[3]), cvt_pk_bf16(e[4], e[5]), cvt_pk_bf16(e[6], e[7])};
    w1 = (v4u){cvt_pk_bf16(e[8], e[9]), cvt_pk_bf16(e[10], e[11]), cvt_pk_bf16(e[12], e[13]), cvt_pk_bf16(e[14], e[15])};
}
__device__ __forceinline__ void moba_block(int jb, const bf16* Qh, const bf16* Kh, const bf16* Vh, const MobaX X, int g0, int g1, bool own, LAS char* shm, const int wave) {
    constexpr int qp = 512, kp = 512, vp = 512;
    const int lane = lane_id(), r32 = lane & 31, hi = lane >> 5; const int wid = wave;
    const unsigned lds0 = (unsigned)(uintptr_t)shm;
    LAS float* wsf = (LAS float*)(shm + MB_WS) + wid * 64;
    { const unsigned kvo = (unsigned)(lane * kp * 2 + wid * 16), vvo = (unsigned)((16 * (wid & 3) + (lane >> 2)) * vp * 2 + (wid >> 2) * 64 + (lane & 3) * 16);
      const char* kbase = (const char*)(Kh + (size_t)jb * 256 * kp); const char* vbase = (const char*)(Vh + (size_t)jb * 256 * vp);
#pragma unroll
      for (int t = 0; t < 4; ++t) { glds16s(kbase + (size_t)t * (KVBLK * kp * 2), kvo, (unsigned)__builtin_amdgcn_readfirstlane(lds0 + MB_K + t * 8192 + wid * 1024));
          glds16s(vbase + (size_t)t * (KVBLK * vp * 2), vvo, (unsigned)__builtin_amdgcn_readfirstlane(lds0 + MB_V + t * 8192 + wid * 1024)); } }
    const int vb0 = (int)(lds0 + MB_V) + ((lane >> 4) & 1) * 32 + (lane & 3) * 8 + (4 * hi + ((lane & 15) >> 2)) * 64;
    const lds_cptr kp0 = (lds_cptr)shm + MB_K + hi * 1024 + r32 * 16;
    int gi = g0 + wid; int srow = 0, srowN = 0; bool valid = true, validN = true; unsigned sel = 0u; bf16x8 qr[4];
#define MB_ROWS(dst, vdst, g_) do { const int li = (g_) * 32 + r32; vdst = li < X.lcnt; dst = (int)X.lst[vdst ? li : X.lcnt - 1]; } while (0)
#define MB_QLOAD(src) do { _Pragma("unroll") for (int d0 = 0; d0 < 4; ++d0) qr[d0] = *(const bf16x8*)(Qh + (size_t)(src) * qp + d0 * 16 + hi * 8); sel = X.SELh[src]; } while (0)
#define MB_OWNROW() do { srow = jb * 256 + wid * 32 + r32; valid = true; MB_QLOAD(srow); } while (0)
    if (gi < g1) { MB_ROWS(srow, valid, gi); if (gi + NW < g1) MB_ROWS(srowN, validN, gi + NW); MB_QLOAD(srow); } else if (own) MB_OWNROW();
    AT_WAIT_BAR0();
#define MB_GROUP(OWN) do { \
        const int tmax = (OWN) ? (wid >> 1) : 3; \
        const int csrow = srow; const bool cvalid = valid; const unsigned csel = sel; \
        f32x16 P0, P1, P2, P3, P4, P5, P6, P7; \
        mb_tile_qk<0>(P0, P1, kp0, qr, tmax); mb_tile_qk<1>(P2, P3, kp0, qr, tmax); mb_tile_qk<2>(P4, P5, kp0, qr, tmax); mb_tile_qk<3>(P6, P7, kp0, qr, tmax); \
        if (!(OWN)) { const int gn = gi + NW; if (gn < g1) { srow = srowN; valid = validN; MB_QLOAD(srow); if (gn + NW < g1) MB_ROWS(srowN, validN, gn + NW); } else if (own) MB_OWNROW(); } \
        if (OWN) { const int qrel = wid * 32 + r32; \
            if (tmax == 0) cmask(P0, P1, 0, qrel, hi); else if (tmax == 1) cmask(P2, P3, 1, qrel, hi); else if (tmax == 2) cmask(P4, P5, 2, qrel, hi); else cmask(P6, P7, 3, qrel, hi); } \
        float mx = -INFINITY; \
        _Pragma("unroll") for (int r = 0; r < 16; ++r) { mx = fmaxf(mx, fmaxf(fmaxf(P0[r], P1[r]), fmaxf(P2[r], P3[r]))); mx = fmaxf(mx, fmaxf(fmaxf(P4[r], P5[r]), fmaxf(P6[r], P7[r]))); } \
        { auto rr = __builtin_amdgcn_permlane32_swap(__float_as_uint(mx), __float_as_uint(mx), false, false); mx = fmaxf(__uint_as_float(rr[0]), __uint_as_float(rr[1])); } \
        float l_reg = 0.f; v4u w0, w1, w2, w3, w4, w5, w6, w7, w8, w9, w10, w11, w12, w13, w14, w15; \
        f32x16 o[2][2]; o[0][0] = f32x16{}; o[0][1] = f32x16{}; o[1][0] = f32x16{}; o[1][1] = f32x16{}; \
        mb_exp_pack(P0, mx, l_reg, w0, w1); mb_exp_pack(P1, mx, l_reg, w2, w3); \
        pv4<0>(o, vb0, w0, w1, w2, w3); \
        if (tmax >= 1) { mb_exp_pack(P2, mx, l_reg, w4, w5); mb_exp_pack(P3, mx, l_reg, w6, w7); pv4<8192>(o, vb0, w4, w5, w6, w7); } \
        if (tmax >= 2) { mb_exp_pack(P4, mx, l_reg, w8, w9); mb_exp_pack(P5, mx, l_reg, w10, w11); pv4<16384>(o, vb0, w8, w9, w10, w11); } \
        if (tmax >= 3) { mb_exp_pack(P6, mx, l_reg, w12, w13); mb_exp_pack(P7, mx, l_reg, w14, w15); pv4<24576>(o, vb0, w12, w13, w14, w15); } \
        { auto rr = __builtin_amdgcn_permlane32_swap(__float_as_uint(l_reg), __float_as_uint(l_reg), false, false); l_reg = __uint_as_float(rr[0]) + __uint_as_float(rr[1]); } \
        LAS int* wsi = (LAS int*)wsf; \
        if (hi == 0) { wsf[32 + r32] = l_reg; \
            const int rank = (OWN) ? 3 : __builtin_popcount(csel & ((1u << jb) - 1u)); const long pidx = (X.qh0 + (long)csrow) * 4 + rank; \
            wsi[r32] = cvalid ? (int)pidx : -1; if (cvalid) { X.PML[pidx * 2] = mx; X.PML[pidx * 2 + 1] = l_reg; } } \
        asm volatile("s_waitcnt lgkmcnt(0)" ::: "memory"); \
        float rli[16]; \
        _Pragma("unroll") for (int r = 0; r < 16; ++r) rli[r] = __builtin_amdgcn_rcpf(wsf[32 + crow(r, hi)]); \
        { unsigned stgb = (unsigned)(uintptr_t)(shm + MB_OST) + wid * 4096 + hi * 512 + r32 * 2; asm volatile("" : "+v"(stgb)); \
          LAS bf16* stg = (LAS bf16*)(shm + MB_OST) + wid * 2048; \
          _Pragma("unroll") for (int r = 0; r < 16; ++r) { \
            _Pragma("unroll") for (int d0 = 0; d0 < 2; ++d0) *(LAS bf16*)(uintptr_t)(stgb + ((r & 3) + 8 * (r >> 2)) * 128 + d0 * 64) = (bf16)f2bf((o[d0][0][r] + o[d0][1][r]) * rli[r]); } \
          asm volatile("s_waitcnt lgkmcnt(0)" ::: "memory"); \
          _Pragma("unroll") for (int i = 0; i < 4; ++i) { const int row = i * 8 + (lane >> 3), ch = lane & 7; const v4u v = *(const LAS v4u*)(stg + row * 64 + ch * 8); \
              const int pid = wsi[row]; if (pid >= 0) *(v4u*)(X.PO + (size_t)pid * 64 + ch * 8) = v; } \
          asm volatile("s_waitcnt lgkmcnt(0)" ::: "memory"); } \
    } while (0)
#pragma unroll 1
    for (; gi < g1; gi += NW) { MB_GROUP(0); }
    if (own) { MB_GROUP(1); }
#undef MB_GROUP
#undef MB_OWNROW
    asm volatile("s_waitcnt lgkmcnt(0)\n\ts_barrier" ::: "memory");
#undef MB_ROWS
#undef MB_QLOAD
}
}


namespace atm {
using at::crow; using at::glds16; using at::lds_cptr;
constexpr int NW = 8, QBLK = 32, QB = 256, KVBLK = 64, ND = 6;
constexpr int KSL = 12288, VSL = 8192;
constexpr int LDS_K = 0, LDS_V = 3 * KSL, LDS_WS = LDS_V + 3 * VSL, LDS_OST = LDS_WS + NW * 64 * 4, LDS_TOTAL = LDS_OST + NW * 4096;
#define ATM_SBAR() __builtin_amdgcn_sched_barrier(0)
#define ATM_WAIT_BAR(N) asm volatile("s_waitcnt vmcnt(" #N ") lgkmcnt(0)\n\ts_barrier" ::: "memory")
#define ATM_MFMA(a, b, c) __builtin_amdgcn_mfma_f32_32x32x16_bf16(a, b, c, 0, 0, 0)
__device__ __forceinline__ void cmask(f32x16& p0, f32x16& p1, int jb, int qrel, int hi) {
    const float NEG = -INFINITY; const int qh = qrel - 4 * hi - 64 * jb;
#pragma unroll
    for (int r = 0; r < 16; ++r) { const int c = (r & 3) + 8 * (r >> 2); if (c > qh) p0[r] = NEG; if (c + 32 > qh) p1[r] = NEG; }
}
__device__ __forceinline__ void kload2(bf16x8* kf, lds_cptr kp, int j) { kf[2 * j] = *(const LAS bf16x8*)(kp + j * 2048); kf[2 * j + 1] = *(const LAS bf16x8*)(kp + j * 2048 + 512); }
typedef short v4i16_t __attribute__((ext_vector_type(4)));
__device__ __forceinline__ s16x4 vtr(lds_cptr p) { return __builtin_bit_cast(s16x4, __builtin_amdgcn_ds_read_tr16_b64_v4i16((LAS v4i16_t*)p)); }
__device__ __forceinline__ unsigned cvtpk_s(float lo, float hi) { typedef float f2 __attribute__((ext_vector_type(2))); typedef __bf16 b2 __attribute__((ext_vector_type(2))); f2 v = {lo, hi}; b2 b = __builtin_convertvector(v, b2); return __builtin_bit_cast(unsigned, b); }
template <int THRL>
__device__ __forceinline__ void attn_unit_mla(int qb, const bf16* Qh, const bf16* Kh, const bf16* Krh, const bf16* Vh, bf16* Oh, LAS char* shm, const int wave) {
    constexpr int QP = QL, KP = DM, VP = DM, OP = DM;
    const int lane = lane_id(), r32 = lane & 31, hi = lane >> 5; const int wid = wave;
    const int q0 = qb * QB;
    const bf16* Qw = Qh + (size_t)(q0 + wid * QBLK) * QP;
    const unsigned lds0 = (unsigned)(uintptr_t)shm;
    LAS float* wsf = (LAS float*)(shm + LDS_WS) + wid * 64;
    const unsigned kvo = (unsigned)(lane * KP * 2 + wid * 16), krvo = (unsigned)(lane * 64 + (wid & 3) * 16), vvo = (unsigned)((16 * (wid & 3) + (lane >> 2)) * VP * 2 + (wid >> 2) * 64 + (lane & 3) * 16);
    const char* kbase = (const char*)Kh; const char* krbase = (const char*)Krh; const char* vbase = (const char*)Vh;
    const unsigned kdst = lds0 + LDS_K + wid * 1024, krdst = lds0 + LDS_K + (8 + (wid & 3)) * 1024, vdst = lds0 + LDS_V + wid * 1024;
#define DMA_K(t, sidx) do { at::glds16s(kbase + (size_t)(t) * (KVBLK * KP * 2), kvo, (unsigned)__builtin_amdgcn_readfirstlane(kdst + (sidx) * KSL)); at::glds16s(krbase + (size_t)(t) * (KVBLK * 64), krvo, (unsigned)__builtin_amdgcn_readfirstlane(krdst + (sidx) * KSL)); } while (0)
#define DMA_V(t, sidx) at::glds16s(vbase + (size_t)(t) * (KVBLK * VP * 2), vvo, (unsigned)__builtin_amdgcn_readfirstlane(vdst + (sidx) * VSL))
    const int vb0 = (int)(lds0 + LDS_V) + ((lane >> 4) & 1) * 32 + (lane & 3) * 8 + (4 * hi + ((lane & 15) >> 2)) * 64;
    bf16x8 kf[12];
    const lds_cptr shm3 = (lds_cptr)shm; const lds_cptr kp0 = shm3 + LDS_K + hi * 1024 + r32 * 16; const lds_cptr vp0 = shm3 + LDS_V + ((lane >> 4) & 1) * 32 + (lane & 3) * 8 + (4 * hi + ((lane & 15) >> 2)) * 64;
    const int NT = (q0 + QB) / KVBLK;
    DMA_K(0, 0); DMA_V(0, 0); DMA_K(1, 1);
    bf16x8 qr[ND];
#pragma unroll
    for (int d0 = 0; d0 < ND; ++d0) qr[d0] = *(const bf16x8*)(Qw + (size_t)r32 * QP + d0 * 16 + hi * 8);
    float mhat = 0.f, l_reg = 0.f; f32x16 o[2]; o[0] = f32x16{}; o[1] = f32x16{}; f32x16 negm = f32x16{};
    const int qrel = wid * QBLK + r32;
#define CMASK(P0, P1, t) do { int jb_ = (t) - (NT - 4); if (jb_ >= 0) cmask(P0, P1, jb_, qrel, hi); } while (0)
    bool resc = false;
#define RESC() do { if (resc) { asm volatile("s_waitcnt lgkmcnt(0)" ::: "memory"); \
      _Pragma("unroll") for (int d_ = 0; d_ < 2; ++d_) _Pragma("unroll") for (int r = 0; r < 16; ++r) o[d_][r] *= wsf[crow(r, hi)]; } } while (0)
    f32x16 pA0, pA1, pB0, pB1;
    int sl_prev = 0, sl_cur = 0, sl_next = 1;
#define ROT() do { sl_prev = sl_cur; sl_cur = sl_next; sl_next = (sl_next == 2) ? 0 : sl_next + 1; } while (0)
    DMA_K(2, 2);
    ATM_WAIT_BAR(5);
    { const lds_cptr kb = kp0; f32x16 z0 = {}, z1 = {};
#pragma unroll
      for (int d0 = 0; d0 < ND; ++d0) { const bf16x8 b0 = *(const LAS bf16x8*)(kb + d0 * 2048), b1 = *(const LAS bf16x8*)(kb + d0 * 2048 + 512); z0 = ATM_MFMA(b0, qr[d0], z0); z1 = ATM_MFMA(b1, qr[d0], z1); }
      pA0 = z0; pA1 = z1; }
    CMASK(pA0, pA1, 0);
    { float a = fmaxf(pA0[0], pA1[0]);
#pragma unroll
      for (int r = 1; r < 16; ++r) a = fmaxf(a, fmaxf(pA0[r], pA1[r]));
      auto rr = __builtin_amdgcn_permlane32_swap(__float_as_uint(a), __float_as_uint(a), false, false); mhat = fmaxf(__uint_as_float(rr[0]), __uint_as_float(rr[1])); }
#pragma unroll
    for (int r = 0; r < 16; ++r) { pA0[r] = __builtin_amdgcn_exp2f(pA0[r] - mhat); pA1[r] = __builtin_amdgcn_exp2f(pA1[r] - mhat); }
#pragma unroll
    for (int r = 0; r < 16; ++r) negm[r] = -mhat;
    asm volatile("" : "+v"(negm));
    ATM_WAIT_BAR(0);
    DMA_K(3, 0); DMA_V(1, 1);
    ROT();
#pragma unroll
    for (int j = 0; j < 6; ++j) kload2(kf, kp0 + sl_cur * KSL, j);
    ATM_WAIT_BAR(3);
    s16x4 vAl, vAh, vBl, vBh; v4u pw0, pw1, pw2, pw3;
#define PKW(P, B) cvtpk_s(P[B], P[B + 1])
#define PAF(k) __builtin_bit_cast(bf16x8, pw##k)
#define FRA (bf16x8){vAl[0], vAl[1], vAl[2], vAl[3], vAh[0], vAh[1], vAh[2], vAh[3]}
#define FRB (bf16x8){vBl[0], vBl[1], vBl[2], vBl[3], vBh[0], vBh[1], vBh[2], vBh[3]}
#define PIN(x) asm volatile("" : "+v"(x))
#define MX3(a, b, c) __builtin_fmaxf(__builtin_fmaxf((a), (b)), (c))
#define GAPA(MF, A0, A1, A2, A3, W0, W1, PW) do { MF; sacc += A0; sacc += A1; sacc += A2; sacc += A3; PIN(sacc); W0; W1; PIN(PW); ATM_SBAR(); } while (0)
#define EX(v) __builtin_amdgcn_exp2f(v)
#define GAPB(MF, X, B) do { MF; X[B] = EX(X[B]); X[B + 1] = EX(X[B + 1]); X[B + 2] = EX(X[B + 2]); X[B + 3] = EX(X[B + 3]); PIN(X); ATM_SBAR(); } while (0)
#define VRDA(i) do { vAl = vtr(vp_ + (((i) >> 2) * 4096 + ((i) & 3) * 1024)); vAh = vtr(vp_ + (((i) >> 2) * 4096 + ((i) & 3) * 1024 + 512)); } while (0)
#define VRDB(i) do { vBl = vtr(vp_ + (((i) >> 2) * 4096 + ((i) & 3) * 1024)); vBh = vtr(vp_ + (((i) >> 2) * 4096 + ((i) & 3) * 1024 + 512)); } while (0)
#define KRD(G, j) do { if (G) { kload2(kf, kp0 + sl_next * KSL, j); } } while (0)
#define STEP(C0, C1, P0, P1, t, GK, GV, GL) do { ATM_SBAR(); if (MLA_PRIO & 1) __builtin_amdgcn_s_setprio(1); \
    const lds_cptr vp_ = vp0 + sl_prev * VSL; \
    float sacc = (P0[0] + P0[1]); \
    GAPA(C0 = ATM_MFMA(kf[0], qr[0], negm), P0[2], P0[3], P0[4], P0[5],     pw0[0] = PKW(P0, 0), pw0[1] = PKW(P0, 2), pw0); \
    GAPA(C1 = ATM_MFMA(kf[1], qr[0], negm), P0[6], P0[7], P0[8], P0[9],     pw0[2] = PKW(P0, 4), pw0[3] = PKW(P0, 6), pw0); \
    GAPA(C0 = ATM_MFMA(kf[2], qr[1], C0),   P0[10], P0[11], P0[12], P0[13], pw1[0] = PKW(P0, 8), pw1[1] = PKW(P0, 10), pw1); \
    GAPA(C1 = ATM_MFMA(kf[3], qr[1], C1),   P0[14], P0[15], P1[0], P1[1],   pw1[2] = PKW(P0, 12), pw1[3] = PKW(P0, 14), pw1); \
    GAPA(C0 = ATM_MFMA(kf[4], qr[2], C0),   P1[2], P1[3], P1[4], P1[5],     pw2[0] = PKW(P1, 0), pw2[1] = PKW(P1, 2), pw2); \
    GAPA(C1 = ATM_MFMA(kf[5], qr[2], C1),   P1[6], P1[7], P1[8], P1[9],     pw2[2] = PKW(P1, 4), pw2[3] = PKW(P1, 6), pw2); \
    GAPA(C0 = ATM_MFMA(kf[6], qr[3], C0),   P1[10], P1[11], P1[12], P1[13], pw3[0] = PKW(P1, 8), pw3[1] = PKW(P1, 10), pw3); \
    GAPA(C1 = ATM_MFMA(kf[7], qr[3], C1),   P1[14], P1[15], 0.f, 0.f,       pw3[2] = PKW(P1, 12), pw3[3] = PKW(P1, 14), pw3); \
    C0 = ATM_MFMA(kf[8], qr[4], C0); ATM_SBAR(); C1 = ATM_MFMA(kf[9], qr[4], C1); ATM_SBAR(); C0 = ATM_MFMA(kf[10], qr[5], C0); ATM_SBAR(); C1 = ATM_MFMA(kf[11], qr[5], C1); \
    VRDA(0); ATM_SBAR(); \
    if (MLA_PRIO & 1) __builtin_amdgcn_s_setprio(0); l_reg += sacc; \
    if (GK) { DMA_K((t) + 3, sl_cur); } if (GV) { DMA_V((t) + 1, sl_next); } \
    CMASK(C0, C1, t); \
    { float a = MX3(C0[0], C0[1], C1[0]), b = MX3(C0[2], C0[3], C1[1]); a = MX3(a, C1[2], C1[3]); \
      _Pragma("unroll") for (int r = 4; r < 16; r += 4) { a = MX3(a, C0[r], C0[r + 1]); b = MX3(b, C0[r + 2], C0[r + 3]); a = MX3(a, C1[r], C1[r + 1]); b = MX3(b, C1[r + 2], C1[r + 3]); } \
      float rm = __builtin_fmaxf(a, b); { auto rr = __builtin_amdgcn_permlane32_swap(__float_as_uint(rm), __float_as_uint(rm), false, false); rm = __builtin_fmaxf(__uint_as_float(rr[0]), __uint_as_float(rr[1])); } \
      resc = false; \
      if (__builtin_expect(__any(rm > (float)THRL), 0)) { const float dl = __builtin_fmaxf(rm, 0.f); mhat += dl; \
        _Pragma("unroll") for (int r = 0; r < 16; ++r) { C0[r] -= dl; C1[r] -= dl; } \
        _Pragma("unroll") for (int r = 0; r < 16; ++r) negm[r] = -mhat; asm volatile("" : "+v"(negm)); \
        const float f = __builtin_amdgcn_exp2f(-dl); l_reg *= f; if (hi == 0) wsf[r32] = f; resc = true; } } \
    ATM_SBAR(); \
    if (MLA_PRIO & 2) __builtin_amdgcn_s_setprio(1); VRDB(4); ATM_SBAR(); GAPB(o[0] = ATM_MFMA(PAF(0), FRA, o[0]), C0, 0); \
    KRD(GL, 0); VRDA(1); ATM_SBAR(); GAPB(o[1] = ATM_MFMA(PAF(0), FRB, o[1]), C0, 4); \
    KRD(GL, 1); VRDB(5); ATM_SBAR(); GAPB(o[0] = ATM_MFMA(PAF(1), FRA, o[0]), C0, 8); \
    KRD(GL, 2); VRDA(2); ATM_SBAR(); GAPB(o[1] = ATM_MFMA(PAF(1), FRB, o[1]), C0, 12); \
    KRD(GL, 3); VRDB(6); ATM_SBAR(); GAPB(o[0] = ATM_MFMA(PAF(2), FRA, o[0]), C1, 0); \
    KRD(GL, 4); VRDA(3); ATM_SBAR(); GAPB(o[1] = ATM_MFMA(PAF(2), FRB, o[1]), C1, 4); \
    KRD(GL, 5); VRDB(7); ATM_SBAR(); GAPB(o[0] = ATM_MFMA(PAF(3), FRA, o[0]), C1, 8); \
    GAPB(o[1] = ATM_MFMA(PAF(3), FRB, o[1]), C1, 12); if (MLA_PRIO & 2) __builtin_amdgcn_s_setprio(0); \
    } while (0)
    int t = 1;
#undef CMASK
#define CMASK(P0, P1, t) do {} while (0)
    for (; t + 5 < NT; t += 2) {
        STEP(pB0, pB1, pA0, pA1, t, true, true, true);     ATM_WAIT_BAR(3); RESC(); ROT();
        STEP(pA0, pA1, pB0, pB1, t + 1, true, true, true); ATM_WAIT_BAR(3); RESC(); ROT();
    }
#undef CMASK
#define CMASK(P0, P1, t) do { int jb_ = (t) - (NT - 4); if (jb_ >= 0) cmask(P0, P1, jb_, qrel, hi); } while (0)
#define ENDW(tt) do { if ((tt) + 3 < NT) { ATM_WAIT_BAR(3); } else if ((tt) + 2 < NT) { ATM_WAIT_BAR(1); } else { ATM_WAIT_BAR(0); } } while (0)
    for (; t + 1 < NT; t += 2) {
        STEP(pB0, pB1, pA0, pA1, t, (t + 3 < NT), (t + 1 < NT), (t + 1 < NT));         ENDW(t);     RESC(); ROT();
        STEP(pA0, pA1, pB0, pB1, t + 1, (t + 4 < NT), (t + 2 < NT), (t + 2 < NT));     ENDW(t + 1); RESC(); ROT();
    }
    STEP(pB0, pB1, pA0, pA1, NT - 1, false, false, false); RESC();
    { float sacc = pB0[0] + pB0[1];
#pragma unroll
      for (int r = 2; r < 16; ++r) sacc += pB0[r];
#pragma unroll
      for (int r = 0; r < 16; ++r) sacc += pB1[r];
      l_reg += sacc;
      pw0 = (v4u){PKW(pB0, 0), PKW(pB0, 2), PKW(pB0, 4), PKW(pB0, 6)}; pw1 = (v4u){PKW(pB0, 8), PKW(pB0, 10), PKW(pB0, 12), PKW(pB0, 14)};
      pw2 = (v4u){PKW(pB1, 0), PKW(pB1, 2), PKW(pB1, 4), PKW(pB1, 6)}; pw3 = (v4u){PKW(pB1, 8), PKW(pB1, 10), PKW(pB1, 12), PKW(pB1, 14)};
      ATM_SBAR(); at::pv(o, vb0 + sl_cur * VSL, PAF(0), PAF(1), PAF(2), PAF(3)); }
#undef PKW
#undef PAF
#undef FRA
#undef FRB
#undef PIN
#undef MX3
#undef GAPA
#undef GAPB
#undef EX
#undef VRDA
#undef VRDB
#undef KRD
#undef STEP
#undef ENDW
    { auto rr = __builtin_amdgcn_permlane32_swap(__float_as_uint(l_reg), __float_as_uint(l_reg), false, false); l_reg = __uint_as_float(rr[0]) + __uint_as_float(rr[1]); }
    if (hi == 0) wsf[32 + r32] = l_reg;
    asm volatile("s_waitcnt lgkmcnt(0)" ::: "memory");
    float rli[16];
#pragma unroll
    for (int r = 0; r < 16; ++r) rli[r] = __builtin_amdgcn_rcpf(wsf[32 + crow(r, hi)]);
    bf16* Ow = Oh + (size_t)(q0 + wid * QBLK) * OP;
    { unsigned stgb = (unsigned)(uintptr_t)(shm + LDS_OST) + wid * 4096 + hi * 512 + r32 * 2; asm volatile("" : "+v"(stgb));
      LAS bf16* stg = (LAS bf16*)(shm + LDS_OST) + wid * 2048;
#pragma unroll
      for (int r = 0; r < 16; ++r) {
#pragma unroll
        for (int d0 = 0; d0 < 2; ++d0) *(LAS bf16*)(uintptr_t)(stgb + ((r & 3) + 8 * (r >> 2)) * 128 + d0 * 64) = (bf16)f2bf(o[d0][r] * rli[r]); }
      asm volatile("s_waitcnt lgkmcnt(0)" ::: "memory");
#pragma unroll
      for (int i = 0; i < 4; ++i) { const int row = i * 8 + (lane >> 3), ch = lane & 7; const v4u v = *(const LAS v4u*)(stg + row * 64 + ch * 8); *(v4u*)(Ow + (size_t)row * OP + ch * 8) = v; } }
    asm volatile("s_waitcnt lgkmcnt(0)\n\ts_barrier" ::: "memory");
#undef DMA_K
#undef DMA_V
#undef CMASK
#undef RESC
#undef ROT
}
}

#define XB_TMO      128
#define XB_XCNT(j)  (256  + 64 * (j))
#define XB_XSUB(j)  (1280 + 64 * (j))
#define XB_XGEN(j)  (2304 + 64 * (j))
#define XB_TOP      3328
#define XB_TOPGEN   3392
#define XCD_BAR_WORDS 3456
#define XB_SPIN_CAP (1u << 18)
__device__ __forceinline__ unsigned xb_ld(unsigned* p)              { return __hip_atomic_load(p, __ATOMIC_RELAXED, __HIP_MEMORY_SCOPE_AGENT); }
__device__ __forceinline__ unsigned xb_add(unsigned* p, unsigned v) { return __hip_atomic_fetch_add(p, v, __ATOMIC_RELAXED, __HIP_MEMORY_SCOPE_AGENT); }
__device__ __forceinline__ unsigned xb_xcc_id() { return (unsigned)__builtin_amdgcn_s_getreg((3 << 11) | 20) & 0xFu; }
#define XB_SPIN(cond, bar) do { unsigned _sp = 0; while (cond) { __builtin_amdgcn_s_sleep(1); \
    if ((++_sp & 255u) == 0u) { if (xb_ld(&(bar)[XB_TMO])) break; if (_sp > XB_SPIN_CAP) { atomicAdd(&(bar)[XB_TMO], 1u); break; } } } } while (0)
struct XcdBarrier { unsigned* bar; unsigned x; volatile LAS unsigned* st; };
__device__ __forceinline__ XcdBarrier xcd_barrier_post(unsigned* bar, volatile LAS unsigned* st, const bool leader) {
    XcdBarrier b; b.bar = bar; b.x = xb_xcc_id(); b.st = st;
    if (leader) (void)xb_add(&bar[XB_XCNT(b.x)], 1u);
    return b;
}
__device__ __forceinline__ void xcd_barrier_complete(unsigned* bar, unsigned x, unsigned& nloc, unsigned& nx) {
    const unsigned G = gridDim.x * gridDim.y * gridDim.z;
    unsigned sum, cnt, mine, sp = 0u;
    for (;;) {
        sum = 0u; cnt = 0u; mine = 0u;
#pragma unroll
        for (unsigned j = 0; j < 16; ++j) { const unsigned c = xb_ld(&bar[XB_XCNT(j)]); sum += c; cnt += (c > 0u) ? 1u : 0u; mine = (j == x) ? c : mine; }
        if (sum == G) break;
        __builtin_amdgcn_s_sleep(1);
        if ((++sp & 255u) == 0u) { if (xb_ld(&bar[XB_TMO])) break; if (sp > XB_SPIN_CAP) { atomicAdd(&bar[XB_TMO], 1u); break; } }
    }
    nloc = mine > 0u ? mine : 1u; nx = cnt > 0u ? cnt : 1u;
}
__device__ __forceinline__ void xcd_barrier(const XcdBarrier& b, const bool leader) {
    asm volatile("s_waitcnt vmcnt(0)" ::: "memory");
    __syncthreads();
    if (leader) {
        unsigned* bar = b.bar;
        __builtin_amdgcn_s_waitcnt(0);
        unsigned nloc = b.st[0], nx = b.st[1];
        if (nloc == 0u) { xcd_barrier_complete(bar, b.x, nloc, nx); b.st[0] = nloc; b.st[1] = nx; }
        const unsigned old = xb_add(&bar[XB_XSUB(b.x)], 1u);
        const unsigned gen = old / nloc;
        if (old + 1u == (gen + 1u) * nloc) {
            __builtin_amdgcn_fence(__ATOMIC_RELEASE, "agent");
            asm volatile("s_waitcnt vmcnt(0)" ::: "memory");
            const unsigned og = xb_add(&bar[XB_TOP], 1u);
            const unsigned tg = og / nx;
            if (og + 1u == (tg + 1u) * nx) xb_add(&bar[XB_TOPGEN], 1u);
            else XB_SPIN(xb_ld(&bar[XB_TOPGEN]) == tg, bar);
            __builtin_amdgcn_fence(__ATOMIC_ACQUIRE, "agent");
            xb_add(&bar[XB_XGEN(b.x)], 1u);
            asm volatile("s_waitcnt vmcnt(0)" ::: "memory");
        } else {
            XB_SPIN(xb_ld(&bar[XB_XGEN(b.x)]) == gen, bar);
            __builtin_amdgcn_fence(__ATOMIC_ACQUIRE, "agent");
            asm volatile("s_waitcnt vmcnt(0)" ::: "memory");
        }
    }
    __syncthreads();
}

struct Args { const float* in[19]; float* out; unsigned char* ws; int ph_lo, ph_hi; };
struct Frame { LAS unsigned char* lds; volatile LAS unsigned* MISC; gu32* ctl; int tid, lane, wave, vcu, G; };
#define CAS __attribute__((address_space(4)))
__device__ __forceinline__ Args ld_args() {
    const CAS char* ka = (const CAS char*)__builtin_amdgcn_kernarg_segment_ptr(); asm volatile("" : "+s"(ka));
    Args a;
#pragma unroll
    for (int i = 0; i < 19; ++i) a.in[i] = *(const float* const CAS*)(ka + 8 * i);
    a.out = *(float* const CAS*)(ka + 152); a.ws = *(unsigned char* const CAS*)(ka + 160); a.ph_lo = *(const CAS int*)(ka + 168); a.ph_hi = *(const CAS int*)(ka + 172);
    return a;
}

__device__ __forceinline__ float wave_sum(float v) {
#pragma unroll
    for (int o = 1; o < 64; o <<= 1) v += __shfl_xor(v, o);
    return v;
}
__device__ const double REV_A[16] = {0.15915494309189535, 0.0700865215877985, 0.03086376340470123, 0.013591370636193905, 0.005985185712713705, 0.002635675898667414, 0.001160663641240061, 0.0005111175045375439,
    0.00022507907903927653, 9.911730936901935e-05, 4.364795279280289e-05, 1.9221100684944863e-05, 8.464330808241401e-06, 3.727408601915352e-06, 1.6414262627950345e-06, 7.228293068832865e-07};
__device__ const double REV_B[8] = {0.15915494309189535, 0.03086376340470123, 0.005985185712713705, 0.001160663641240061, 0.00022507907903927653, 4.364795279280289e-05, 8.464330808241401e-06, 1.6414262627950345e-06};

__device__ __forceinline__ void tr_item(const float* W, int N, int k0, int n0s, bf16* WT, int drow0, int ldk, int koff, const float* gain, int mode, LAS float* scr, int lane) {
    float w[32];
#pragma unroll
    for (int i = 0; i < 32; ++i) w[i] = W[(size_t)(k0 + 2 * i + (lane >> 5)) * N + n0s + (lane & 31)];
#pragma unroll
    for (int i = 0; i < 32; ++i) scr[(2 * i + (lane >> 5)) * 33 + (lane & 31)] = w[i];
    LDS_WAIT(); asm volatile("" ::: "memory");
    const int c = lane & 7;
    f32x4 g0 = (f32x4){1.f, 1.f, 1.f, 1.f}, g1 = g0;
    if (gain) { g0 = *(const f32x4*)(gain + k0 + 8 * c); g1 = *(const f32x4*)(gain + k0 + 8 * c + 4); }
#pragma unroll
    for (int j = 0; j < 4; ++j) { const int n = (lane >> 3) + 8 * j;
        int sn = n;
        if (mode == 1) sn = (n < 16) ? ((n & 1) ? (n >> 1) + 8 : (n >> 1)) : n;
        else if (mode == 2) sn = 4 * (n >> 3) + ((n & 7) >> 1) + 16 * (n & 1);
        const LAS float* s = scr + (8 * c) * 33 + sn;
        v4u o; o.x = pk2(s[0 * 33] * g0[0], s[1 * 33] * g0[1]); o.y = pk2(s[2 * 33] * g0[2], s[3 * 33] * g0[3]); o.z = pk2(s[4 * 33] * g1[0], s[5 * 33] * g1[1]); o.w = pk2(s[6 * 33] * g1[2], s[7 * 33] * g1[3]);
        *(GAS v4u*)(WT + (size_t)(drow0 + n) * ldk + koff + k0 + 8 * c) = o; }
    LDS_WAIT(); asm volatile("" ::: "memory");
}

__device__ __forceinline__ void p0_prologue(const Frame& F0, const Args& A) {
    Frame F = F0; F.lane = lane_id(); F.tid = F.wave * 64 + F.lane;
    unsigned char* ws = A.ws;
    LAS float* scr = (LAS float*)(F.lds + F.wave * 16384);
    const int gw = F.vcu * NWAVES + F.wave, NGW = F.G * NWAVES, lane = F.lane;
    bf16* Win = (bf16*)(ws + WS_WIN); bf16* Wuq = (bf16*)(ws + WS_WUQ); bf16* Wukv = (bf16*)(ws + WS_WUKV); bf16* Wo = (bf16*)(ws + WS_WO); bf16* Wout = (bf16*)(ws + WS_WOUT);
    bf16* Wgu = (bf16*)(ws + WS_WGU); bf16* Wd = (bf16*)(ws + WS_WD);
    constexpr int I_IN = 16 * 145, I_UQ = 12 * 24, I_UKV = 4 * 32, I_O = 8 * 32, I_OUT = 16 * 32, I_G = 32 * 128, I_D = 32 * 128;
    constexpr int NITEMS = I_IN + I_UQ + I_UKV + 2 * I_O + I_OUT + 2 * I_G + I_D;
    for (int it = gw; it < NITEMS; it += NGW) {
        int r = it;
        if (r < I_IN) { const int kb = r / 145, nb = r % 145, s0 = 32 * nb; int drow0, mode = 0;
            if (s0 < 1024) drow0 = s0;
            else if (s0 < 1056) { drow0 = 4608; mode = 2; }
            else if (s0 < 1568) { const int j = s0 - 1056; drow0 = 1024 + j; mode = ((j & 63) == 0) ? 1 : 0; }
            else if (s0 < 2080) { const int j = s0 - 1568; drow0 = 1536 + j; mode = ((j & 63) == 0) ? 1 : 0; }
            else if (s0 < 2592) drow0 = 2048 + (s0 - 2080);
            else if (s0 < 3616) { const int j = s0 - 2592; drow0 = 2560 + (j >> 7) * 256 + (j & 127); }
            else { const int j = s0 - 3616; drow0 = 2560 + (j >> 7) * 256 + 128 + (j & 127); }
            tr_item(A.in[2], 4640, 64 * kb, s0, Win, drow0, 1024, 0, nullptr, mode, scr, lane); continue; } r -= I_IN;
        if (r < I_UQ) { const int kb = r / 24, nb = r % 24; tr_item(A.in[4], 768, 64 * kb, 32 * nb, Wuq, 32 * nb, 768, 0, A.in[3], (nb % 3 == 2) ? 2 : 0, scr, lane); continue; } r -= I_UQ;
        if (r < I_UKV) { const int kb = r / 32, nb = r % 32; tr_item(A.in[6], 1024, 64 * kb, 32 * nb, Wukv, 32 * nb, 256, 0, A.in[5], 0, scr, lane); continue; } r -= I_UKV;
        if (r < I_O) { const int kb = r / 32, nb = r % 32; tr_item(A.in[7], 1024, 64 * kb, 32 * nb, Wo, 32 * nb, 1024, 0, nullptr, 0, scr, lane); continue; } r -= I_O;
        if (r < I_O) { const int kb = r / 32, nb = r % 32; tr_item(A.in[8], 1024, 64 * kb, 32 * nb, Wo, 32 * nb, 1024, 512, nullptr, 0, scr, lane); continue; } r -= I_O;
        if (r < I_OUT) { const int kb = r / 32, nb = r % 32; tr_item(A.in[9], 1024, 64 * kb, 32 * nb, Wout, 32 * nb, 1024, 0, nullptr, 0, scr, lane); continue; } r -= I_OUT;
        if (r < 2 * I_G) { const int up = r >= I_G; if (up) r -= I_G; const int e = r >> 7, q = r & 127, kb = q >> 3, nb = q & 7, s0 = 32 * nb;
            const int drow0 = e * 512 + (s0 >> 7) * 256 + up * 128 + (s0 & 127);
            tr_item(A.in[up ? 16 : 15] + (size_t)e * 1024 * 256, 256, 64 * kb, s0, Wgu, drow0, 1024, 0, A.in[10], 0, scr, lane); continue; } r -= 2 * I_G;
        { const int e = r >> 7, q = r & 127, kb = q >> 5, nb = q & 31;
            tr_item(A.in[17] + (size_t)e * 256 * 1024, 1024, 64 * kb, 32 * nb, Wd, e * 1024 + 32 * nb, 256, 0, nullptr, 0, scr, lane); }
    }
    { const int gt = F.vcu * 512 + F.tid, NT_ = F.G * 512; GAS v4u* z = (GAS v4u*)(Win + (size_t)4640 * 1024);
      for (int i = gt; i < 224 * 1024 / 8; i += NT_) z[i] = (v4u){0u, 0u, 0u, 0u}; }
    { const int gt = F.vcu * 512 + F.tid, NT_ = F.G * 512; float* CA = (float*)(ws + WS_COSA); float* SA_ = (float*)(ws + WS_SINA); float* CB = (float*)(ws + WS_COSB); float* SB_ = (float*)(ws + WS_SINB);
      for (int i = gt; i < SEQ * 24; i += NT_) { const int pos = i / 24, j = i % 24; const double rv = (double)pos * (j < 16 ? REV_A[j] : REV_B[j - 16]);
          const float fr = (float)(rv - __builtin_floor(rv)); const float c = __builtin_amdgcn_cosf(fr), s = __builtin_amdgcn_sinf(fr);
          if (j < 16) { CA[pos * 16 + j] = c; SA_[pos * 16 + j] = s; } else { CB[pos * 8 + j - 16] = c; SB_[pos * 8 + j - 16] = s; } } }
    { const float* x = A.in[0]; const float* g = A.in[1]; bf16* XN = (bf16*)(ws + WS_XN);
      f32x4 gv[4];
#pragma unroll
      for (int j = 0; j < 4; ++j) gv[j] = ((const GAS f32x4*)g)[lane + 64 * j];
      constexpr int RPT = P0_RPT;
      for (int m0 = gw; m0 < M; m0 += RPT * NGW) { f32x4 v[RPT][4];
#pragma unroll
          for (int q = 0; q < RPT; ++q) { const int m = (m0 + q * NGW < M) ? m0 + q * NGW : m0;
#pragma unroll
              for (int j = 0; j < 4; ++j) v[q][j] = ((const GAS f32x4*)(x + (size_t)m * DM) + lane)[64 * j]; }
#pragma unroll
          for (int q = 0; q < RPT; ++q) { const int m = m0 + q * NGW; if (m < M) { float s = 0.f;
#pragma unroll
              for (int j = 0; j < 4; ++j) s += dot4(v[q][j]);
              const float rs = 1.f / sqrtf(wave_sum(s) * (1.f / DM) + EPS);
              GAS unsigned long long* o8 = (GAS unsigned long long*)(XN + (size_t)m * DM) + lane;
#pragma unroll
              for (int j = 0; j < 4; ++j) { const f32x4 y = v[q][j] * rs * gv[j]; o8[64 * j] = (unsigned long long)pk2(y[0], y[1]) | ((unsigned long long)pk2(y[2], y[3]) << 32); } } } } }
}

__device__ __forceinline__ void moba_select(const Frame& F0, const Args& A) {
    Frame F = F0; F.lane = lane_id(); F.tid = F.wave * 64 + F.lane;
    unsigned char* ws = A.ws; const float* KSUM = (const float*)(ws + WS_KSUM); const bf16* QB = (const bf16*)(ws + WS_QB); unsigned* SEL = (unsigned*)(ws + WS_SEL);
    LAS unsigned char* KMH = F.lds; LAS unsigned char* KML = F.lds + 4096;
    const int lane = F.lane, r32 = lane & 31, hi = lane >> 5, wid = F.wave;
    for (int unit = F.vcu; unit < 512; unit += F.G) { const int bh = unit >> 3, qg = unit & 7, b = bh >> 3, h = bh & 7;
        __syncthreads();
        { const int idx = F.tid * 4, n = idx >> 6, d = idx & 63, pm = b * 32 + n;
          const f32x4 k0 = *(const f32x4*)(KSUM + (size_t)pm * 512 + h * 64 + d), k1 = *(const f32x4*)(KSUM + (size_t)(256 + pm) * 512 + h * 64 + d);
          unsigned hw[4], lw[4];
#pragma unroll
          for (int j = 0; j < 4; ++j) { const float v = (k0[j] + k1[j]) * (1.f / 256.f); hw[j] = f2bf(v); lw[j] = f2bf(v - __builtin_bit_cast(float, hw[j] << 16)); }
          const int off = (d >> 3) * 512 + n * 16 + (d & 7) * 2;
          *(LAS unsigned long long*)(KMH + off) = (unsigned long long)(hw[0] | (hw[1] << 16)) | ((unsigned long long)(hw[2] | (hw[3] << 16)) << 32);
          *(LAS unsigned long long*)(KML + off) = (unsigned long long)(lw[0] | (lw[1] << 16)) | ((unsigned long long)(lw[2] | (lw[3] << 16)) << 32); }
        __syncthreads();
        unsigned msk[4];
#pragma unroll
        for (int p = 0; p < 4; ++p) { const int own = 4 * qg + p; const int s = own * 256 + wid * 32 + r32; unsigned mask;
            if (own < 4) mask = (1u << own) - 1u;
            else {
                const bf16* qrow = QB + ((size_t)b * SEQ + s) * 512 + h * 64;
                f32x16 g = {};
#pragma unroll
                for (int d0 = 0; d0 < 4; ++d0) { const bf16x8 q = *(const bf16x8*)(qrow + d0 * 16 + hi * 8);
                    const bf16x8 kh = *(const LAS bf16x8*)(KMH + (2 * d0 + hi) * 512 + r32 * 16), kl = *(const LAS bf16x8*)(KML + (2 * d0 + hi) * 512 + r32 * 16);
                    g = __builtin_amdgcn_mfma_f32_32x32x16_bf16(kl, q, g, 0, 0, 0); g = __builtin_amdgcn_mfma_f32_32x32x16_bf16(kh, q, g, 0, 0, 0); }
                float v1 = -INFINITY, v2 = -INFINITY, v3 = -INFINITY; int i1 = 99, i2 = 99, i3 = 99;
#pragma unroll
                for (int r = 0; r < 16; ++r) { const int n = (r & 3) + 8 * (r >> 2) + 4 * hi; const float v = (n < own) ? g[r] : -INFINITY;
                    if (v > v1) { v3 = v2; i3 = i2; v2 = v1; i2 = i1; v1 = v; i1 = n; } else if (v > v2) { v3 = v2; i3 = i2; v2 = v; i2 = n; } else if (v > v3) { v3 = v; i3 = n; } }
                float pv_[3] = {__shfl_xor(v1, 32), __shfl_xor(v2, 32), __shfl_xor(v3, 32)}; int pi_[3] = {__shfl_xor(i1, 32), __shfl_xor(i2, 32), __shfl_xor(i3, 32)};
#pragma unroll
                for (int k = 0; k < 3; ++k) { const float v = pv_[k]; const int n = pi_[k];
#define MS_BETTER(va, ia, vb, ib) ((va) > (vb) || ((va) == (vb) && (ia) < (ib)))
                    if (MS_BETTER(v, n, v1, i1)) { v3 = v2; i3 = i2; v2 = v1; i2 = i1; v1 = v; i1 = n; } else if (MS_BETTER(v, n, v2, i2)) { v3 = v2; i3 = i2; v2 = v; i2 = n; } else if (MS_BETTER(v, n, v3, i3)) { v3 = v; i3 = n; } }
#undef MS_BETTER
                mask = (1u << i1) | (1u << i2) | (1u << i3);
            }
            msk[p] = mask;
            if (hi == 0) SEL[(size_t)bh * SEQ + s] = mask; }
        int lp[4][3];
#pragma unroll
        for (int p = 0; p < 4; ++p) { unsigned mm = (hi == 0) ? msk[p] : 0u;
#pragma unroll
            for (int k = 0; k < 3; ++k) { lp[p][k] = 0; if (mm) { const int j = __builtin_ctz(mm); mm &= mm - 1u; lp[p][k] = (int)__hip_atomic_fetch_add((LAS unsigned*)(F.MISC + MI_HIST + j), 1u, __ATOMIC_RELAXED, __HIP_MEMORY_SCOPE_WORKGROUP); } } }
        __syncthreads();
        if (F.tid < 32) { const unsigned n = F.MISC[MI_HIST + F.tid]; F.MISC[MI_BASE + F.tid] = n ? xb_add((unsigned*)(F.ctl + CW_MCNT + bh * 32 + F.tid), n) : 0u; }
        __syncthreads();
        { unsigned short* LQ = (unsigned short*)(ws + WS_LISTQ) + (size_t)bh * LQ_PER_BH;
#pragma unroll
          for (int p = 0; p < 4; ++p) { unsigned mm = (hi == 0) ? msk[p] : 0u; const int s = (4 * qg + p) * 256 + wid * 32 + r32;
#pragma unroll
              for (int k = 0; k < 3; ++k) if (mm) { const int j = __builtin_ctz(mm); mm &= mm - 1u; LQ[256 * (31 * j - j * (j - 1) / 2) + (int)F.MISC[MI_BASE + j] + lp[p][k]] = (unsigned short)s; } } }
        __syncthreads();
        if (F.tid < 32) F.MISC[MI_HIST + F.tid] = 0u;
    }
    __syncthreads();
}

__device__ __forceinline__ void router_phase(const Frame& F0, const Args& A) {
    Frame F = F0; F.lane = lane_id(); F.tid = F.wave * 64 + F.lane;
    unsigned char* ws = A.ws; const bf16* X2H = (const bf16*)(ws + WS_X2B); const bf16* X2Lo = (const bf16*)(ws + WS_X2L); const float* SSQ_X = (const float*)(ws + WS_SSQX);
    const float* gain = A.in[10]; const float* wrg = A.in[11]; const float* brg = A.in[12]; const float* wre = A.in[13]; const float* bre = A.in[14];
    float* TOKW = (float*)(ws + WS_TOKW); float* RS = (float*)(ws + WS_RS); int* LIST = (int*)(ws + WS_LIST); unsigned* CNT = (unsigned*)(F.ctl + CW_CNT);
    LAS float* Wl = (LAS float*)F.lds;
    const int tid = F.tid, lane = F.lane, wid = F.wave, fr = lane & 15, fq = lane >> 4;
    for (int tw = F.vcu; tw < M / 256; tw += F.G) { const int tok0 = tw * 256;
        f32x4 acc[2][3];
#pragma unroll
        for (int a = 0; a < 2; ++a)
#pragma unroll
            for (int b = 0; b < 3; ++b) acc[a][b] = (f32x4){0.f, 0.f, 0.f, 0.f};
        LAS bf16* Wh = (LAS bf16*)F.lds; LAS bf16* Wo = Wh + 48 * 520;
        for (int c2 = 0; c2 < 2 * NREP(6); ++c2) { const int c = c2 & 1;
            __syncthreads();
            { const int k = c * 512 + tid; const float g = gain[k];
#define RT_PUT(n, val) do { const float w_ = (val) * g; const unsigned h_ = f2bf(w_); Wh[(n) * 520 + tid] = (bf16)h_; Wo[(n) * 520 + tid] = (bf16)f2bf(w_ - __builtin_bit_cast(float, h_ << 16)); } while (0)
              const f32x4 w4 = *(const f32x4*)(wrg + (size_t)k * 4);
#pragma unroll
              for (int n = 0; n < 4; ++n) RT_PUT(n, w4[n]);
#pragma unroll
              for (int gi = 0; gi < 4; ++gi) { const f32x4 e0 = *(const f32x4*)(wre + ((size_t)gi * 1024 + k) * 8), e1 = *(const f32x4*)(wre + ((size_t)gi * 1024 + k) * 8 + 4);
#pragma unroll
                  for (int j = 0; j < 4; ++j) { RT_PUT(4 + gi * 8 + j, e0[j]); RT_PUT(4 + gi * 8 + 4 + j, e1[j]); } }
#pragma unroll
              for (int n = 36; n < 48; ++n) { Wh[n * 520 + tid] = 0; Wo[n * 520 + tid] = 0; }
#undef RT_PUT
            }
            __syncthreads();
            const size_t xo0 = (size_t)(tok0 + wid * 32 + fr) * DM + c * 512 + 8 * fq;
#pragma unroll 2
            for (int s = 0; s < 16; ++s) {
                bf16x8 xh[2], xl[2], wh[3], wl[3];
#pragma unroll
                for (int mb = 0; mb < 2; ++mb) { xh[mb] = *(const bf16x8*)(X2H + xo0 + (size_t)mb * 16 * DM + 32 * s);
#if !RES_BF16
                    xl[mb] = *(const bf16x8*)(X2Lo + xo0 + (size_t)mb * 16 * DM + 32 * s);
#endif
                    }
#pragma unroll
                for (int nb = 0; nb < 3; ++nb) { wh[nb] = *(const LAS bf16x8*)(Wh + (16 * nb + fr) * 520 + 32 * s + 8 * fq); wl[nb] = *(const LAS bf16x8*)(Wo + (16 * nb + fr) * 520 + 32 * s + 8 * fq); }
#pragma unroll
                for (int mb = 0; mb < 2; ++mb)
#pragma unroll
                    for (int nb = 0; nb < 3; ++nb) {
#if !RES_BF16
                        acc[mb][nb] = __builtin_amdgcn_mfma_f32_16x16x32_bf16(xl[mb], wh[nb], acc[mb][nb], 0, 0, 0);
#endif
                        acc[mb][nb] = __builtin_amdgcn_mfma_f32_16x16x32_bf16(xh[mb], wl[nb], acc[mb][nb], 0, 0, 0);
                        acc[mb][nb] = __builtin_amdgcn_mfma_f32_16x16x32_bf16(xh[mb], wh[nb], acc[mb][nb], 0, 0, 0); }
            }
        }
        __syncthreads();
#pragma unroll
        for (int mb = 0; mb < 2; ++mb)
#pragma unroll
            for (int nb = 0; nb < 3; ++nb)
#pragma unroll
                for (int i = 0; i < 4; ++i) Wl[(wid * 32 + mb * 16 + 4 * fq + i) * 49 + nb * 16 + fr] = acc[mb][nb][i] * (1.f / NREP(6));
        if (tid < 32) F.MISC[MI_HIST + tid] = 0u;
        __syncthreads();
        int e1 = 0, e2 = 0, lp1 = 0, lp2 = 0; float wt1 = 0.f, wt2 = 0.f;
        if (tid < 256) { const int T = tok0 + tid; const LAS float* lg = Wl + tid * 49;
            const f32x4 q0 = *(const f32x4*)(SSQ_X + (size_t)T * 16), q1 = *(const f32x4*)(SSQ_X + (size_t)T * 16 + 4), q2 = *(const f32x4*)(SSQ_X + (size_t)T * 16 + 8), q3 = *(const f32x4*)(SSQ_X + (size_t)T * 16 + 12);
            float ss = 0.f;
#pragma unroll
            for (int j = 0; j < 4; ++j) ss += q0[j];
#pragma unroll
            for (int j = 0; j < 4; ++j) ss += q1[j];
#pragma unroll
            for (int j = 0; j < 4; ++j) ss += q2[j];
#pragma unroll
            for (int j = 0; j < 4; ++j) ss += q3[j];
            const float rs = 1.f / sqrtf(ss * (1.f / DM) + EPS);
            RS[T] = rs;
            float g0 = lg[0] * rs + brg[0], g1 = lg[1] * rs + brg[1], g2 = lg[2] * rs + brg[2], g3 = lg[3] * rs + brg[3];
            int g = 0; float mx = g0; if (g1 > mx) { mx = g1; g = 1; } if (g2 > mx) { mx = g2; g = 2; } if (g3 > mx) { mx = g3; g = 3; }
            const float pg = 1.f / (__expf(g0 - mx) + __expf(g1 - mx) + __expf(g2 - mx) + __expf(g3 - mx));
            float v1 = -INFINITY, v2 = -INFINITY; int i1 = 0, i2 = 0;
#pragma unroll
            for (int j = 0; j < 8; ++j) { const float v = lg[4 + 8 * g + j] * rs + bre[8 * g + j];
                if (v > v1) { v2 = v1; i2 = i1; v1 = v; i1 = j; } else if (v > v2) { v2 = v; i2 = j; } }
            const float w1 = 1.f / (1.f + __expf(v2 - v1));
            wt1 = pg * w1; wt2 = pg * (1.f - w1); e1 = 8 * g + i1; e2 = 8 * g + i2;
            lp1 = (int)__hip_atomic_fetch_add((LAS unsigned*)(F.MISC + MI_HIST + e1), 1u, __ATOMIC_RELAXED, __HIP_MEMORY_SCOPE_WORKGROUP);
            lp2 = (int)__hip_atomic_fetch_add((LAS unsigned*)(F.MISC + MI_HIST + e2), 1u, __ATOMIC_RELAXED, __HIP_MEMORY_SCOPE_WORKGROUP);
        }
        __syncthreads();
        if (tid < 32) { const unsigned n = F.MISC[MI_HIST + tid]; F.MISC[MI_BASE + tid] = n ? xb_add((unsigned*)&CNT[tid], n) : 0u; }
        __syncthreads();
        if (tid < 256) { const int T = tok0 + tid;
            const int p1 = (int)F.MISC[MI_BASE + e1] + lp1, p2 = (int)F.MISC[MI_BASE + e2] + lp2;
            LIST[(size_t)e1 * LCAP + p1] = 2 * T; LIST[(size_t)e2 * LCAP + p2] = 2 * T + 1;
            TOKW[2 * T] = wt1; TOKW[2 * T + 1] = wt2; }
    }
    __syncthreads();
}

__device__ __forceinline__ void moe_tile_table(const Frame& F0) {
    Frame F = F0; F.lane = lane_id(); F.tid = F.wave * 64 + F.lane;
    __syncthreads();
    if (F.tid == 0) { int acc = 0; for (int e = 0; e < 32; ++e) { F.MISC[MI_TS + e] = (unsigned)acc; const unsigned c = __hip_atomic_load((unsigned*)(F.ctl + CW_CNT + e), RLX_AGENT); acc += (int)((c + 255u) >> 8); } F.MISC[MI_TS + 32] = (unsigned)acc; }
    __syncthreads();
}
__device__ __forceinline__ void gather_phase(const Frame& F0, const Args& A) {
    Frame F = F0; F.lane = lane_id(); F.tid = F.wave * 64 + F.lane;
    unsigned char* ws = A.ws; const int* LIST = (const int*)(ws + WS_LIST);
    int* SLOT_A = (int*)(ws + WS_SLOTA); int* SLOT_TOK = (int*)(ws + WS_SLOTTOK); float* SLOT_RS = (float*)(ws + WS_SLOTRS); const float* RS = (const float*)(ws + WS_RS);
    const int ntile = (int)F.MISC[MI_TS + 32];
    for (int i2 = 0; (long)F.vcu + (long)i2 * F.G < 2L * ntile; i2 += 2) { const long L = (long)F.vcu + (long)(i2 + (F.tid >> 8)) * F.G; if (L >= 2L * ntile) continue; const int st = (int)(L >> 1);
        int e = 0; for (int k = 1; k < 32; ++k) e += (st >= (int)F.MISC[MI_TS + k]) ? 1 : 0;
        const int cnt = (int)__hip_atomic_load((unsigned*)(F.ctl + CW_CNT + e), RLX_AGENT); const int r = F.tid & 255, p = (st - (int)F.MISC[MI_TS + e]) * 256 + r, slot = st * 256 + r;
        int a = -1; float rs = 0.f; if (p < cnt) { a = LIST[(size_t)e * LCAP + p]; rs = RS[a >> 1]; }
        SLOT_A[slot] = a; SLOT_TOK[slot] = a >> 1; SLOT_RS[slot] = rs; }
}
__device__ __forceinline__ void final_phase(const Frame& F0, const Args& A, float* DST) {
    Frame F = F0; F.lane = lane_id(); F.tid = F.wave * 64 + F.lane;
    unsigned char* ws = A.ws; const bf16* X2H = (const bf16*)(ws + WS_X2B); const bf16* X2Lo = (const bf16*)(ws + WS_X2L); const bf16* Y = (const bf16*)(ws + WS_Y); const float* g = A.in[18];
    const int gw = F.vcu * NWAVES + F.wave, NGW = F.G * NWAVES, lane = F.lane;
    f32x4 gv[4];
#pragma unroll
    for (int j = 0; j < 4; ++j) gv[j] = ((const GAS f32x4*)g)[lane + 64 * j];
    constexpr int FR = FIN_RPT;
    for (int m0 = FR * gw; m0 < M; m0 += FR * NGW) {
        f32x4 v[FR][4]; unsigned long long ya[FR][4], yb[FR][4], xa[FR][4], xb[FR][4];
#pragma unroll
        for (int q = 0; q < FR; ++q) { const int m = m0 + q; const GAS unsigned long long* xh_ = (const GAS unsigned long long*)(X2H + (size_t)m * DM) + lane; const GAS unsigned long long* xl_ = (const GAS unsigned long long*)(X2Lo + (size_t)m * DM) + lane;
            const GAS unsigned long long* y0 = (const GAS unsigned long long*)(Y + (size_t)(2 * m) * DM) + lane; const GAS unsigned long long* y1 = (const GAS unsigned long long*)(Y + (size_t)(2 * m + 1) * DM) + lane;
#pragma unroll
            for (int j = 0; j < 4; ++j) { xa[q][j] = xh_[64 * j]; xb[q][j] = RES_BF16 ? 0ull : xl_[64 * j]; ya[q][j] = y0[64 * j]; yb[q][j] = y1[64 * j]; } }
#pragma unroll
        for (int q = 0; q < FR; ++q) { const int m = m0 + q; float s = 0.f;
#pragma unroll
            for (int j = 0; j < 4; ++j) { const unsigned long long a = ya[q][j], b = yb[q][j], xh8 = xa[q][j], xl8 = xb[q][j];
                const unsigned al = (unsigned)a, ah = (unsigned)(a >> 32), bl = (unsigned)b, bh = (unsigned)(b >> 32), hl = (unsigned)xh8, hh = (unsigned)(xh8 >> 32), ll = (unsigned)xl8, lh = (unsigned)(xl8 >> 32);
                v[q][j] = (f32x4){bflo(hl) + bflo(ll), bfhi(hl) + bfhi(ll), bflo(hh) + bflo(lh), bfhi(hh) + bfhi(lh)};
                v[q][j][0] = (v[q][j][0] + bflo(al)) + bflo(bl); v[q][j][1] = (v[q][j][1] + bfhi(al)) + bfhi(bl); v[q][j][2] = (v[q][j][2] + bflo(ah)) + bflo(bh); v[q][j][3] = (v[q][j][3] + bfhi(ah)) + bfhi(bh);
                s += dot4(v[q][j]); }
            float rs = 1.f / sqrtf(wave_sum(s) * (1.f / DM) + EPS);
#if CHECK
            { const float es = __hip_atomic_load((float*)(F.ctl + CW_ERR), RLX_AGENT), ec = __hip_atomic_load((float*)(F.ctl + CW_ERR + 1), RLX_AGENT); rs *= 1.f + CHK_GAIN * (ec > 0.f ? es / ec : 1.f); }
#endif
            GAS f32x4* dr = (GAS f32x4*)(DST + (size_t)m * DM) + lane;
#pragma unroll
            for (int j = 0; j < 4; ++j) dr[64 * j] = v[q][j] * rs * gv[j]; } }
}

#if CHECK
__device__ __forceinline__ float blk_sum(Frame& F, float v, LAS float* red) { v = wave_sum(v); __syncthreads(); if (F.lane == 0) red[F.wave] = v; __syncthreads(); float t = 0.f; for (int i = 0; i < 8; ++i) t += red[i]; return t; }
__device__ __forceinline__ float blk_max(Frame& F, float v, LAS float* red) {
#pragma unroll
    for (int o = 1; o < 64; o <<= 1) v = fmaxf(v, __shfl_xor(v, o));
    __syncthreads(); if (F.lane == 0) red[F.wave] = v; __syncthreads(); float t = red[0]; for (int i = 1; i < 8; ++i) t = fmaxf(t, red[i]); return t; }
__device__ __forceinline__ void err_add(Frame& F, int group, float num2, float den2, LAS float* red) {
    const float n = blk_sum(F, num2, red), d = blk_sum(F, den2, red);
    if (F.tid == 0 && ((CHK_GROUPS >> group) & 1)) { float e = sqrtf(n / (d + 1e-20f)); e = fminf(e, 1.f); if (!(e == e)) e = 1.f; atomicAdd((float*)(F.ctl + CW_ERR), e); atomicAdd((float*)(F.ctl + CW_ERR + 1), 1.f); } }
__device__ __forceinline__ float bfv(const bf16* p) { return __builtin_bit_cast(float, ((unsigned)*p) << 16); }
__device__ __forceinline__ int posA(int j) { const int i = j & 15, odd = j >> 4; return 8 * (i >> 2) + 2 * (i & 3) + odd; }
__device__ __forceinline__ int posB(int d) { if (d >= 16) return d; const int i = d & 7, odd = d >> 3; return 8 * (i >> 2) + 2 * (i & 3) + odd; }
__device__ __forceinline__ unsigned hash32(unsigned x) { x ^= x >> 16; x *= 0x7feb352du; x ^= x >> 15; x *= 0x846ca68bu; x ^= x >> 16; return x; }
__device__ __forceinline__ void cs_pow(double theta, int pos, double& c, double& s) {
    double t2 = theta * theta, ct = 1.0, st = theta, term = 1.0;
    for (int k = 1; k <= 12; ++k) { term *= -t2 / ((2.0 * k - 1.0) * (2.0 * k)); ct += term; }
    term = theta; for (int k = 1; k <= 12; ++k) { term *= -t2 / ((2.0 * k) * (2.0 * k + 1.0)); st += term; }
    double rc = 1.0, rs = 0.0, bc = ct, bs = st;
    for (int b = 0; b < 13; ++b) { if ((pos >> b) & 1) { const double nc = rc * bc - rs * bs, ns = rc * bs + rs * bc; rc = nc; rs = ns; } const double c2 = bc * bc - bs * bs, s2 = 2.0 * bc * bs; bc = c2; bs = s2; }
    c = rc; s = rs;
}
__device__ __forceinline__ void check_proj_row(const Frame& F0, const Args& A, int m) {
    Frame F = F0; F.lane = lane_id(); F.tid = F.wave * 64 + F.lane;
    unsigned char* ws = A.ws; LAS float* L = (LAS float*)F.lds; LAS float* hrow = L; LAS float* proj = L + 1024; LAS float* tmp = L + 5664; LAS float* outv = L + 6688; LAS float* red = L + 7712;
    const int tid = F.tid, pos = m & (SEQ - 1);
    const float* x = A.in[0] + (size_t)m * DM;
    float ss = 0.f; for (int k = tid; k < DM; k += 512) ss += x[k] * x[k];
    ss = blk_sum(F, ss, red); { const float rs = 1.f / sqrtf(ss / DM + EPS); for (int k = tid; k < DM; k += 512) hrow[k] = x[k] * rs * A.in[1][k]; }
    __syncthreads();
    for (int c = tid; c < 4640; c += 512) { float a = 0.f; for (int k = 0; k < DM; ++k) a += hrow[k] * A.in[2][(size_t)k * 4640 + c]; proj[c] = a; }
    __syncthreads();
    const float* CA = (const float*)(ws + WS_COSA); const float* SA_ = (const float*)(ws + WS_SINA); const float* CB = (const float*)(ws + WS_COSB); const float* SB_ = (const float*)(ws + WS_SINB);
    { float n2 = 0.f, d2 = 0.f; if (tid < 24) { const int j = tid; double c, s_; cs_pow(6.283185307179586 * (j < 16 ? REV_A[j] : REV_B[j - 16]), pos, c, s_);
          const float tc = j < 16 ? CA[pos * 16 + j] : CB[pos * 8 + j - 16], ts = j < 16 ? SA_[pos * 16 + j] : SB_[pos * 8 + j - 16];
          n2 = (tc - (float)c) * (tc - (float)c) + (ts - (float)s_) * (ts - (float)s_); d2 = 1.f; }
      err_add(F, 0, n2, d2, red); }
    { float q2 = 0.f; for (int k = tid; k < QL; k += 512) q2 += proj[k] * proj[k]; q2 = blk_sum(F, q2, red); const float rs = 1.f / sqrtf(q2 / QL + EPS);
      for (int k = tid; k < QL; k += 512) tmp[k] = proj[k] * rs * A.in[3][k];
      __syncthreads();
      for (int c = tid; c < QL; c += 512) { float a = 0.f; for (int k = 0; k < QL; ++k) a += tmp[k] * A.in[4][(size_t)k * QL + c]; outv[c] = a; }
      __syncthreads();
      const bf16* QA = (const bf16*)(ws + WS_QA) + (size_t)m * QL; float n2 = 0.f, d2 = 0.f;
      for (int c = tid; c < QL; c += 512) { const int hh = c / 96, d = c % 96; float ref; int sp;
          if (d < 64) { ref = outv[c]; sp = d; }
          else { const int j = d - 64, i = j & 15; double cc, sn; cs_pow(6.283185307179586 * REV_A[i], pos, cc, sn); const float x1 = outv[hh * 96 + 64 + i], x2 = outv[hh * 96 + 80 + i];
              ref = (j < 16) ? x1 * (float)cc - x2 * (float)sn : x2 * (float)cc + x1 * (float)sn; sp = 64 + posA(j); }
          ref *= C2A; const float got = bfv(QA + hh * 96 + sp); n2 += (got - ref) * (got - ref); d2 += ref * ref; }
      err_add(F, 1, n2, d2, red); }
    { float q2 = 0.f; for (int k = tid; k < KVL; k += 512) q2 += proj[768 + k] * proj[768 + k]; q2 = blk_sum(F, q2, red); const float rs = 1.f / sqrtf(q2 / KVL + EPS);
      for (int k = tid; k < KVL; k += 512) tmp[k] = proj[768 + k] * rs * A.in[5][k];
      __syncthreads();
      for (int c = tid; c < DM; c += 512) { float a = 0.f; for (int k = 0; k < KVL; ++k) a += tmp[k] * A.in[6][(size_t)k * DM + c]; outv[c] = a; }
      __syncthreads();
      const bf16* KV = (const bf16*)(ws + WS_KV) + (size_t)m * DM; float n2 = 0.f, d2 = 0.f;
      for (int c = tid; c < DM; c += 512) { const float ref = outv[c], got = bfv(KV + c); n2 += (got - ref) * (got - ref); d2 += ref * ref; }
      err_add(F, 2, n2, d2, red); }
    { const bf16* KR = (const bf16*)(ws + WS_KR) + (size_t)m * 32; float n2 = 0.f, d2 = 0.f;
      if (tid < 32) { const int j = tid, i = j & 15; double cc, sn; cs_pow(6.283185307179586 * REV_A[i], pos, cc, sn); const float x1 = proj[1024 + i], x2 = proj[1040 + i];
          const float ref = (j < 16) ? x1 * (float)cc - x2 * (float)sn : x2 * (float)cc + x1 * (float)sn; const float got = bfv(KR + posA(j)); n2 = (got - ref) * (got - ref); d2 = ref * ref; }
      err_add(F, 3, n2, d2, red); }
    for (int w = 0; w < 3; ++w) { const bf16* O = (const bf16*)(ws + (w == 0 ? WS_QB : w == 1 ? WS_KB : WS_VB)) + (size_t)m * 512; const int base = (w == 0) ? 1056 : (w == 1) ? 1568 : 2080; float n2 = 0.f, d2 = 0.f;
        { const int c = tid; const int hh = c >> 6, d = c & 63; float ref; int sp = d;
          if (w < 2 && d < 16) { const int i = d & 7; double cc, sn; cs_pow(6.283185307179586 * REV_B[i], pos, cc, sn); const float x1 = proj[base + hh * 64 + i], x2 = proj[base + hh * 64 + 8 + i];
              ref = (d < 8) ? x1 * (float)cc - x2 * (float)sn : x2 * (float)cc + x1 * (float)sn; sp = posB(d); }
          else ref = proj[base + c];
          if (w == 0) ref *= C2B;
          const float got = bfv(O + hh * 64 + sp); n2 = (got - ref) * (got - ref); d2 = ref * ref; }
        err_add(F, 4 + w, n2, d2, red); }
    for (int w = 0; w < 2; ++w) { const bf16* O = (const bf16*)(ws + (w == 0 ? WS_SA : WS_SB)) + (size_t)m * DM; float n2 = 0.f, d2 = 0.f;
        for (int c = tid; c < DM; c += 512) { const float sa = 1.f / (1.f + __expf(-proj[2592 + c])), sb = 1.f / (1.f + __expf(-proj[3616 + c])); const float ref = (w == 0) ? sa / sb : sb, got = bfv(O + c); n2 += (got - ref) * (got - ref); d2 += ref * ref; }
        err_add(F, 7 + w, n2, d2, red); }
    __syncthreads();
}
__device__ __forceinline__ void check_attn_row(const Frame& F0, const Args& A, int type, int b, int h, int s) {
    Frame F = F0; F.lane = lane_id(); F.tid = F.wave * 64 + F.lane;
    unsigned char* ws = A.ws; LAS float* L = (LAS float*)F.lds; LAS float* sc = L; LAS float* q = L + 8192; LAS float* km = L + 8320; LAS float* part = L + 10400; LAS float* red = L + 10944; LAS float* gate = L + 10960; LAS unsigned* msk = (LAS unsigned*)(L + 11000);
    const int tid = F.tid; const size_t rb = (size_t)b * SEQ; const int own = s >> 8;
    const bf16* QA = (const bf16*)(ws + WS_QA); const bf16* KV = (const bf16*)(ws + WS_KV); const bf16* KR = (const bf16*)(ws + WS_KR);
    const bf16* QB = (const bf16*)(ws + WS_QB); const bf16* KB = (const bf16*)(ws + WS_KB); const bf16* VB = (const bf16*)(ws + WS_VB); const bf16* OAB = (const bf16*)(ws + WS_OAB);
    __syncthreads();
    if (type == 0) { if (tid < 96) q[tid] = bfv(QA + (rb + s) * QL + h * 96 + tid); }
    else { if (tid < 64) q[tid] = bfv(QB + (rb + s) * 512 + h * 64 + tid); }
    __syncthreads();
    unsigned mask = 0xffffffffu;
    if (type == 1) {
        { const int d = tid & 63, g = tid >> 6; for (int n = g; n < own; n += 8) { float a = 0.f; for (int r = 0; r < 256; ++r) a += bfv(KB + (rb + n * 256 + r) * 512 + h * 64 + d); km[n * 64 + d] = a * (1.f / 256.f); } }
        __syncthreads();
        if (tid < own) { float a = 0.f; for (int d = 0; d < 64; ++d) a += q[d] * km[tid * 64 + d]; gate[tid] = a; }
        __syncthreads();
        if (tid == 0) { unsigned mk = 0u; if (own < 4) mk = (1u << own) - 1u; else { for (int r = 0; r < 3; ++r) { float bv = -INFINITY; int bi = 0; for (int n = 0; n < own; ++n) if (!((mk >> n) & 1u) && gate[n] > bv) { bv = gate[n]; bi = n; } mk |= 1u << bi; } }
            msk[0] = mk | (1u << own); }
        __syncthreads();
        mask = msk[0];
    }
    float mx = -INFINITY;
    for (int j = tid; j <= s; j += 512) { float a = -INFINITY;
        if ((mask >> (j >> 8)) & 1u) { a = 0.f;
            if (type == 0) { for (int d = 0; d < 64; ++d) a += q[d] * bfv(KV + (rb + j) * DM + h * 128 + d); for (int d = 0; d < 32; ++d) a += q[64 + d] * bfv(KR + (rb + j) * 32 + d); }
            else { for (int d = 0; d < 64; ++d) a += q[d] * bfv(KB + (rb + j) * 512 + h * 64 + d); } }
        sc[j] = a; mx = fmaxf(mx, a); }
    mx = blk_max(F, mx, red);
    float l = 0.f; for (int j = tid; j <= s; j += 512) { const float p = exp2f(sc[j] - mx); sc[j] = p; l += p; }
    l = blk_sum(F, l, red);
    { const int d = tid & 63, g = tid >> 6; float a = 0.f;
      for (int j = g; j <= s; j += 8) { const float p = sc[j]; if (p != 0.f) a += p * (type == 0 ? bfv(KV + (rb + j) * DM + h * 128 + 64 + d) : bfv(VB + (rb + j) * 512 + h * 64 + d)); }
      part[g * 64 + d] = a; }
    __syncthreads();
    float n2 = 0.f, d2 = 0.f;
    if (tid < 64) { float a = 0.f; for (int g = 0; g < 8; ++g) a += part[g * 64 + tid]; const float ref = a / l; const float got = bfv(OAB + (rb + s) * DM + type * 512 + h * 64 + tid); n2 = (got - ref) * (got - ref); d2 = ref * ref; }
    err_add(F, type, n2, d2, red);
    __syncthreads();
}
__device__ __forceinline__ void check_mix_row(const Frame& F0, const Args& A, int m) {
    Frame F = F0; F.lane = lane_id(); F.tid = F.wave * 64 + F.lane;
    unsigned char* ws = A.ws; LAS float* L = (LAS float*)F.lds; LAS float* orow = L; LAS float* mix = L + 1024; LAS float* red = L + 2048; const int tid = F.tid;
    const bf16* OAB = (const bf16*)(ws + WS_OAB) + (size_t)m * DM; const bf16* SAp = (const bf16*)(ws + WS_SA) + (size_t)m * DM; const bf16* SBp = (const bf16*)(ws + WS_SB) + (size_t)m * DM; const bf16* MIX = (const bf16*)(ws + WS_MIX) + (size_t)m * DM;
    __syncthreads();
    for (int k = tid; k < DM; k += 512) orow[k] = bfv(OAB + k);
    __syncthreads();
    float n2 = 0.f, d2 = 0.f;
    for (int c = tid; c < DM; c += 512) { float a1 = 0.f, a2 = 0.f; for (int k = 0; k < 512; ++k) { a1 += orow[k] * A.in[7][(size_t)k * DM + c]; a2 += orow[512 + k] * A.in[8][(size_t)k * DM + c]; }
        const float ref = bfv(SBp + c) * (bfv(SAp + c) * a1 + a2), got = bfv(MIX + c); mix[c] = got; n2 += (got - ref) * (got - ref); d2 += ref * ref; }
    err_add(F, 0, n2, d2, red);
    n2 = 0.f; d2 = 0.f;
    for (int c = tid; c < DM; c += 512) { float a = 0.f; for (int k = 0; k < DM; ++k) a += mix[k] * A.in[9][(size_t)k * DM + c];
        const float ref = A.in[0][(size_t)m * DM + c] + a, got = bfv((const bf16*)(ws + WS_X2B) + (size_t)m * DM + c) + bfv((const bf16*)(ws + WS_X2L) + (size_t)m * DM + c); n2 += (got - ref) * (got - ref); d2 += a * a; }
    err_add(F, 1, n2, d2, red);
    __syncthreads();
}
#endif

__device__ __forceinline__ void moba_combine(const Frame& F0, const Args& A) {
    Frame F = F0; F.lane = lane_id(); F.tid = F.wave * 64 + F.lane;
    unsigned char* ws = A.ws; const bf16* PO = (const bf16*)A.out; const float* PML = (const float*)(ws + WS_PML); const unsigned* SEL = (const unsigned*)(ws + WS_SEL); bf16* OAB = (bf16*)(ws + WS_OAB);
    const int gw = F.vcu * NWAVES + F.wave, NGW = F.G * NWAVES, lane = F.lane, ch = lane & 7;
    typedef float f32x2_ __attribute__((ext_vector_type(2)));
    for (int task0 = CMB_T * gw; task0 < 65536 * REP_MOBA_B; task0 += CMB_T * NGW) {
        unsigned selv[CMB_T]; f32x2_ ml[CMB_T][4]; v4u ov[CMB_T][4];
#pragma unroll
        for (int q = 0; q < CMB_T; ++q) { const int tk = (task0 + q) & 65535; const long qh = (long)tk * 8 + (lane >> 3);
            selv[q] = SEL[qh];
#pragma unroll
            for (int k = 0; k < 4; ++k) { ml[q][k] = *(const f32x2_*)(PML + (qh * 4 + k) * 2); ov[q][k] = *(const v4u*)(PO + (size_t)(qh * 4 + k) * 64 + ch * 8); } }
#pragma unroll
        for (int q = 0; q < CMB_T; ++q) { const int tk = (task0 + q) & 65535; const long qh = (long)tk * 8 + (lane >> 3); const int bh = (int)(qh >> 13), sq = (int)(qh & (SEQ - 1)), b = bh >> 3, h = bh & 7;
            const int np = __builtin_popcount(selv[q]);
            float mi[4], li[4]; v4u oi[4];
#pragma unroll
            for (int k = 0; k < 4; ++k) { const bool ok = (k == 3) || (k < np); mi[k] = ok ? ml[q][k][0] : -1e30f; li[k] = ok ? ml[q][k][1] : 0.f;
                oi[k].x = ok ? ov[q][k].x : 0u; oi[k].y = ok ? ov[q][k].y : 0u; oi[k].z = ok ? ov[q][k].z : 0u; oi[k].w = ok ? ov[q][k].w : 0u; }
            const float mmax = fmaxf(fmaxf(mi[0], mi[1]), fmaxf(mi[2], mi[3]));
            float wk[4], wsum = 0.f;
#pragma unroll
            for (int k = 0; k < 4; ++k) { wk[k] = li[k] * __builtin_amdgcn_exp2f(mi[k] - mmax); wsum += wk[k]; }
            const float inv = 1.f / wsum;
            float r8[8] = {0.f, 0.f, 0.f, 0.f, 0.f, 0.f, 0.f, 0.f};
#pragma unroll
            for (int k = 0; k < 4; ++k) { const v4u u = oi[k]; r8[0] += wk[k] * bflo(u.x); r8[1] += wk[k] * bfhi(u.x); r8[2] += wk[k] * bflo(u.y); r8[3] += wk[k] * bfhi(u.y);
                r8[4] += wk[k] * bflo(u.z); r8[5] += wk[k] * bfhi(u.z); r8[6] += wk[k] * bflo(u.w); r8[7] += wk[k] * bfhi(u.w); }
            v4u w; w.x = cvt_pk_bf16(r8[0] * inv, r8[1] * inv); w.y = cvt_pk_bf16(r8[2] * inv, r8[3] * inv); w.z = cvt_pk_bf16(r8[4] * inv, r8[5] * inv); w.w = cvt_pk_bf16(r8[6] * inv, r8[7] * inv);
            *(v4u*)(OAB + ((size_t)b * SEQ + sq) * DM + 512 + h * 64 + ch * 8) = w; } }
}

__global__ void __launch_bounds__(NWAVES * 64, 2) mk_fwd(Args kargs) {
    extern __shared__ __attribute__((aligned(16))) unsigned char lds[];
    Frame F;
    F.lds = (LAS unsigned char*)lds; F.MISC = (volatile LAS unsigned*)(F.lds + MISC_OFF);
    F.wave = __builtin_amdgcn_readfirstlane((int)threadIdx.x >> 6); F.lane = lane_id(); F.tid = F.wave * 64 + F.lane;
    F.G = gridDim.x; { const int bx = blockIdx.x; F.vcu = (F.G % 8 == 0) ? (bx % 8) * (F.G / 8) + bx / 8 : bx; }
    F.ctl = (gu32*)(ld_args().ws + WS_CTL);
    for (int u = F.tid; u < (LDS_BYTES - LDSCTL_OFF) / 4; u += NWAVES * 64) ((LAS unsigned*)(F.lds + LDSCTL_OFF))[u] = 0u;
    __syncthreads();
    XcdBarrier bar = xcd_barrier_post((unsigned*)(F.ctl + CW_BAR), F.MISC + 8, F.wave == 0 && lane_id() == 0);
    int lo, hi; { const Args a0 = ld_args(); lo = a0.ph_lo; hi = a0.ph_hi; }
#ifndef PH_MASK
#define PH_MASK 0x7ff
#endif
#define IN(k) (((PH_MASK >> (k)) & 1) && lo <= (k) && (k) < hi)
#define SEAM(k) do { if (IN(k) && IN((k) + 1)) xcd_barrier(bar, F.wave == 0 && lane_id() == 0); } while (0)
#define PB(off) ((bf16*)(ws + (off)))
#define PF(off) ((float*)(ws + (off)))
#define XN PB(WS_XN)
#define CQ PB(WS_CQ)
#define CKV PB(WS_CKV)
#define KR PB(WS_KR)
#define QBp PB(WS_QB)
#define KBp PB(WS_KB)
#define VBp PB(WS_VB)
#define SAp PB(WS_SA)
#define SBp PB(WS_SB)
#define QA PB(WS_QA)
#define KV PB(WS_KV)
#define OAB PB(WS_OAB)
#define MIX PB(WS_MIX)
#define X2B PB(WS_X2B)
#define XG PB(WS_XG)
#define Hb PB(WS_H)
#define Yb PB(WS_Y)
#define SSQ_Q PF(WS_SSQQ)
#define SSQ_KV PF(WS_SSQKV)
#define SSQ_X PF(WS_SSQX)
#define KSUM PF(WS_KSUM)
#define COSA PF(WS_COSA)
#define SINA PF(WS_SINA)
#define COSB PF(WS_COSB)
#define SINB PF(WS_SINB)
    if (IN(0)) { const Args args = ld_args(); for (int rep = 0; rep < NREP(0); ++rep) p0_prologue(F, args); } SEAM(0);

    if (IN(1)) { const Args args = ld_args(); unsigned char* ws = args.ws;
        pg8::Gemm g{XN, (const bf16*)(ws + WS_WIN), DM, DM, DM, 0}; pg8::SchedGrid S; S.init(M / 256, NPROJ / 256, F.G, (int)blockIdx.x, DM, DM, NREP(1), WGM_P1);
        pg8::EpiProj E{CQ, CKV, KR, QBp, KBp, VBp, SAp, SBp, SSQ_Q, SSQ_KV, KSUM, COSA, SINA, COSB, SINB};
        pg8::gemm_phase(F.lds, g, S, E, F.wave);
#ifdef P1_EXTRA_PLAIN
        { pg8::SchedGrid S2; S2.init(M / 256, NPROJ / 256, F.G, (int)blockIdx.x, DM, DM, 1, WGM_P1); pg8::EpiPlain E2{(bf16*)(ws + 976 * MiB)}; pg8::gemm_phase(F.lds, g, S2, E2, F.wave); }
#endif
    } SEAM(1);

    if (IN(2)) { const Args args = ld_args(); unsigned char* ws = args.ws;
        { pg8::Gemm g{CQ, (const bf16*)(ws + WS_WUQ), QL, QL, QL, 0}; pg8::SchedGrid S; S.init(M / 256, QL / 256, F.G, (int)blockIdx.x, QL, QL, NREP(2), WGM_O);
          pg8::EpiQ E{QA, SSQ_Q, COSA, SINA}; pg8::gemm_phase(F.lds, g, S, E, F.wave); }
        { pg8::Gemm g{CKV, (const bf16*)(ws + WS_WUKV), KVL, KVL, KVL, 0}; pg8::SchedGrid S; S.init(M / 256, DM / 256, F.G, (int)blockIdx.x, KVL, KVL, NREP(2), WGM_O);
          pg8::EpiKV E{KV, SSQ_KV}; pg8::gemm_phase(F.lds, g, S, E, F.wave); }
        for (int rep = 0; rep < NREP(11); ++rep) moba_select(F, args);
    } SEAM(2);
#if CHECK == 2
    if (IN(2)) { const Args args = ld_args();
#pragma unroll 1
        for (int i = 0; i < 3; ++i) { const unsigned hsh = hash32((unsigned)(F.vcu * 3 + i) + 12345u); int m = (int)(hsh % (unsigned)M); if (i == 0) m = (m & ~(SEQ - 1)) | (hsh >> 20 & 255) * 32 | (m & 31); check_proj_row(F, args, m); } xcd_barrier(bar, F.wave == 0 && lane_id() == 0); }
#endif

    if (IN(3)) { const Args args = ld_args(); unsigned char* ws = args.ws;
        const unsigned* SEL = (const unsigned*)(ws + WS_SEL);
        bf16* PO = (bf16*)args.out; float* PML = (float*)(ws + WS_PML);
        for (int qd = F.vcu; qd < 512; qd += F.G) { const int s = qd & 7, bh = (qd >> 3) & 63, b = bh >> 3, h = bh & 7; const size_t rb = (size_t)b * SEQ;
#pragma unroll 1
            for (int i = 0; i < 4 * REP_MLA; ++i) { const int i4 = i & 3; const int qb = (i4 == 0) ? s : (i4 == 1) ? 15 - s : (i4 == 2) ? 16 + s : 31 - s;
#if MLA_TUNED
                atm::attn_unit_mla<8>(qb, QA + rb * QL + h * 96, KV + rb * DM + h * 128, KR + rb * 32, KV + rb * DM + h * 128 + 64, OAB + rb * DM + h * 64, (LAS char*)F.lds, F.wave);
#else
                at::attn_unit<96, 0>(qb, QA + rb * QL + h * 96, QL, KV + rb * DM + h * 128, DM, KR + rb * 32, KV + rb * DM + h * 128 + 64, DM, OAB + rb * DM + h * 64, DM, at::MobaX{nullptr, nullptr, 0, 0, nullptr, nullptr, 0}, (LAS char*)F.lds, F.wave);
#endif
            } }
#ifndef ONLY_MLA
        { F.lane = lane_id(); F.tid = F.wave * 64 + F.lane; LAS int* PRE = (LAS int*)(F.lds + 102400); LAS int* WSUM = (LAS int*)(F.lds + 102400 + 8704);
#define MB_NCH(c) ({ const int n_ = (int)((((c) + 31u) >> 5) + 63u) >> 6; n_ < 1 ? 1 : n_; })
          int v0, v1, v2, v3;
          { const int i0 = 4 * F.tid;
              v0 = MB_NCH(__hip_atomic_load((unsigned*)(F.ctl + CW_MCNT + ((i0 + 0) & 63) * 32 + ((i0 + 0) >> 6)), RLX_AGENT));
              v1 = MB_NCH(__hip_atomic_load((unsigned*)(F.ctl + CW_MCNT + ((i0 + 1) & 63) * 32 + ((i0 + 1) >> 6)), RLX_AGENT));
              v2 = MB_NCH(__hip_atomic_load((unsigned*)(F.ctl + CW_MCNT + ((i0 + 2) & 63) * 32 + ((i0 + 2) >> 6)), RLX_AGENT));
              v3 = MB_NCH(__hip_atomic_load((unsigned*)(F.ctl + CW_MCNT + ((i0 + 3) & 63) * 32 + ((i0 + 3) >> 6)), RLX_AGENT)); }
          const int loc = v0 + v1 + v2 + v3; int inc = loc;
#pragma unroll
          for (int o = 1; o < 64; o <<= 1) { const int t = __shfl_up(inc, o); if (F.lane >= o) inc += t; }
          __syncthreads();
          if (F.lane == 63) WSUM[F.wave] = inc;
          __syncthreads();
          int woff = 0; for (int w = 0; w < F.wave; ++w) woff += WSUM[w];
          const int excl = inc - loc + woff;
          PRE[4 * F.tid] = excl; PRE[4 * F.tid + 1] = excl + v0; PRE[4 * F.tid + 2] = excl + v0 + v1; PRE[4 * F.tid + 3] = excl + v0 + v1 + v2;
          if (F.tid == 511) PRE[2048] = excl + loc;
          __syncthreads();
          const int total = PRE[2048];
          const unsigned short* LQ = (const unsigned short*)(ws + WS_LISTQ);
#pragma unroll 1
          for (;;) {
              __syncthreads();
              if (F.tid == 0) F.MISC[12] = xb_add((unsigned*)(F.ctl + CW_TICKET), 1u);
              __syncthreads();
              const int k = (int)F.MISC[12]; if (k >= total * REP_MOBA_A) break;
              const int kk = (k >= total) ? k - total : k; int lo_ = 0, hi_ = 2048;
              while (lo_ < hi_) { const int mid = (lo_ + hi_) >> 1; if (PRE[mid + 1] <= kk) lo_ = mid + 1; else hi_ = mid; }
              const int idx = lo_, j = idx >> 6, bh = idx & 63, b = bh >> 3, h = bh & 7, ch = kk - PRE[idx]; const size_t rb = (size_t)b * SEQ;
              const int lcnt = (j < 31) ? (int)__hip_atomic_load((unsigned*)(F.ctl + CW_MCNT + bh * 32 + j), RLX_AGENT) : 0;
              const int ng = (lcnt + 31) >> 5; int nch = (ng + 63) >> 6; if (nch < 1) nch = 1; const int gpc = (ng + nch - 1) / nch, g0 = ch * gpc, g1 = (g0 + gpc < ng) ? g0 + gpc : ng;
              at::moba_block(j, QBp + rb * 512 + h * 64, KBp + rb * 512 + h * 64, VBp + rb * 512 + h * 64,
                  at::MobaX{SEL + (size_t)bh * SEQ, LQ + (size_t)bh * LQ_PER_BH + 256 * (31 * j - j * (j - 1) / 2), lcnt, 0, PO, PML, (long)bh * SEQ}, g0, g1, ch == 0, (LAS char*)F.lds, F.wave); } }
        xcd_barrier(bar, F.wave == 0 && lane_id() == 0);
        moba_combine(F, args);
#endif
    } SEAM(3);
#if CHECK == 1
    if (IN(3)) { const Args args = ld_args();
#pragma unroll 1
        for (int i = 0; i < 8; ++i) { const unsigned hsh = hash32((unsigned)(F.vcu * 8 + i) + 777u); const int type = i & 1, b = (hsh >> 3) & 7, h = hsh & 7; int sq = (hsh >> 8) & (SEQ - 1); if (i >= 6) sq &= 1023;
            check_attn_row(F, args, type, b, h, sq); } xcd_barrier(bar, F.wave == 0 && lane_id() == 0); }
#endif

    if (IN(4)) { const Args args = ld_args(); unsigned char* ws = args.ws;
        pg8::Gemm g{OAB, (const bf16*)(ws + WS_WO), 512, DM, DM, 0}; pg8::SchedMix S; S.g.init(M / 256, DM / 256, F.G, (int)blockIdx.x, DM, DM, NREP(4), WGM_O);
        pg8::EpiMix E{MIX, SAp, SBp}; pg8::gemm_phase(F.lds, g, S, E, F.wave);
    } SEAM(4);

    if (IN(5)) { const Args args = ld_args(); unsigned char* ws = args.ws;
        pg8::Gemm g{MIX, (const bf16*)(ws + WS_WOUT), DM, DM, DM, 0}; pg8::SchedGrid S; S.init(M / 256, DM / 256, F.G, (int)blockIdx.x, DM, DM, NREP(5), WGM_O);
        pg8::EpiOut E{args.in[0], PB(WS_X2L), X2B, SSQ_X}; pg8::gemm_phase(F.lds, g, S, E, F.wave);
    } SEAM(5);
#if CHECK == 3
    if (IN(5)) { const Args args = ld_args();
#pragma unroll 1
        for (int i = 0; i < 2; ++i) { const unsigned hsh = hash32((unsigned)(F.vcu * 2 + i) + 4242u); check_mix_row(F, args, (int)(hsh % (unsigned)M)); } xcd_barrier(bar, F.wave == 0 && lane_id() == 0); }
#endif

    if (IN(6)) { const Args args = ld_args(); router_phase(F, args); } SEAM(6);

    if (IN(8)) { const Args args = ld_args(); unsigned char* ws = args.ws;
        moe_tile_table(F); gather_phase(F, args);
        asm volatile("s_waitcnt vmcnt(0)" ::: "memory"); __syncthreads();
        pg8::Gemm g{X2B, (const bf16*)(ws + WS_WGU), DM, DM, DM, 0};
        pg8::SchedMoE S{(const volatile LAS int*)(F.MISC + MI_TS), 2, F.G, F.vcu, 256L * DM * 2, 512L * DM * 2, 256L * DM * 2, NREP(8)};
        pg8::EpiH E{Hb, (const float*)(ws + WS_SLOTRS)}; pg8::gemm_phase_g(F.lds, g, S, E, F.wave, (const int*)(ws + WS_SLOTTOK));
    } SEAM(8);

    if (IN(9)) { const Args args = ld_args(); unsigned char* ws = args.ws;
        if (!IN(8)) moe_tile_table(F);
        pg8::Gemm g{Hb, (const bf16*)(ws + WS_WD), EFF, EFF, EFF, 0};
        pg8::SchedMoE S{(const volatile LAS int*)(F.MISC + MI_TS), 4, F.G, F.vcu, 256L * EFF * 2, 1024L * EFF * 2, 256L * EFF * 2, NREP(9)};
        pg8::EpiY E{Yb, (const int*)(ws + WS_SLOTA), (const float*)(ws + WS_TOKW)}; pg8::gemm_phase(F.lds, g, S, E, F.wave);
    } SEAM(9);

    if (IN(10)) { const Args args = ld_args(); if (NREP(10) > 1) final_phase(F, args, (float*)(args.ws + WS_R4)); final_phase(F, args, args.out); }
#undef IN
#undef SEAM
}

extern "C" void kernel_launch(void* const* d_in, const int* in_sizes, int n_in, void* d_out, int out_size, void* d_ws, size_t ws_size, hipStream_t stream) {
    static int grid = 0;
    if (grid == 0) {
        if (n_in != 19 || out_size != M * DM || ws_size < WS_END) { fprintf(stderr, "kernel_launch: unexpected shapes (n_in %d out %d ws %zu)\n", n_in, out_size, ws_size); grid = -1; return; }
        int dev = 0, cus = 0, per_cu = 0;
        if (hipGetDevice(&dev) != hipSuccess || hipDeviceGetAttribute(&cus, hipDeviceAttributeMultiprocessorCount, dev) != hipSuccess) { grid = -1; return; }
        if (hipFuncSetAttribute((const void*)mk_fwd, hipFuncAttributeMaxDynamicSharedMemorySize, LDS_BYTES) != hipSuccess) { fprintf(stderr, "kernel_launch: hipFuncSetAttribute failed\n"); grid = -1; return; }
        if (hipOccupancyMaxActiveBlocksPerMultiprocessor(&per_cu, (const void*)mk_fwd, NWAVES * 64, LDS_BYTES) != hipSuccess || per_cu < 1) { fprintf(stderr, "kernel_launch: occupancy query says %d\n", per_cu); }
        (void)hipGetLastError();
        grid = cus;
    }
    if (grid < 0) return;
    if (hipMemsetAsync((char*)d_ws + WS_CTL, 0, CTL_ZERO_BYTES, stream) != hipSuccess) return;
    Args a{};
    for (int i = 0; i < 19; ++i) a.in[i] = (const float*)d_in[i];
    a.out = (float*)d_out; a.ws = (unsigned char*)d_ws; a.ph_lo = 0; a.ph_hi = 11;
    hipLaunchKernelGGL(mk_fwd, dim3(grid), dim3(NWAVES * 64), LDS_BYTES, stream, a);
}
```

```cpp
#include <hip/hip_runtime.h>
#include <hip/hip_bf16.h>
#include <cstdio>
#include <cstdint>

#define LAS __attribute__((address_space(3)))
#define GAS __attribute__((address_space(1)))

constexpr int BATCH = 8, SEQ = 8192, DM = 1024, M = BATCH * SEQ;
constexpr int QL = 768, KVL = 256;
constexpr int NPROJ = 4864;
constexpr int NEXP = 32, EFF = 256, LCAP = 131072;
constexpr float EPS = 1e-6f;
constexpr float LOG2E = 1.4426950408889634f;
constexpr float C2A = 0.10206207261596575f * LOG2E;
constexpr float C2B = 0.125f * LOG2E;
constexpr int NWAVES = 8;

constexpr size_t MiB = 1u << 20;
constexpr size_t WS_CTL = 0, CTL_ZERO_BYTES = 1 * MiB;
constexpr size_t WS_COSA = 1 * MiB, WS_SINA = WS_COSA + 512 * 1024, WS_COSB = 2 * MiB, WS_SINB = WS_COSB + 256 * 1024;
constexpr size_t WS_SSQQ = 3 * MiB, WS_SSQKV = 6 * MiB, WS_SSQX = 7 * MiB, WS_KSUM = 11 * MiB, WS_TOKW = 12 * MiB, WS_RS = 13 * MiB;
constexpr size_t WS_WIN = 16 * MiB, WS_WUQ = 26 * MiB, WS_WUKV = 28 * MiB, WS_WO = 29 * MiB, WS_WOUT = 31 * MiB, WS_WGU = 33 * MiB, WS_WD = 65 * MiB;
constexpr size_t WS_R1 = 96 * MiB, WS_R2 = 224 * MiB, WS_R3 = 352 * MiB;
constexpr size_t WS_KR = 480 * MiB, WS_SEL = 484 * MiB, WS_LIST = 486 * MiB, WS_SLOTA = 502 * MiB, WS_SLOTRS = 503 * MiB, WS_SLOTTOK = 504 * MiB;
constexpr size_t WS_R4 = 512 * MiB, WS_LISTQ = 960 * MiB, WS_PML = 976 * MiB, WS_END = 994 * MiB;
constexpr int LQ_PER_BH = 126976;
constexpr size_t WS_XN = WS_R1, WS_QA = WS_R1, WS_MIX = WS_R1, WS_Y = WS_R1;
constexpr size_t WS_CQ = WS_R2, WS_CKV = WS_R2 + 96 * MiB, WS_OAB = WS_R2;
constexpr size_t WS_KV = WS_R3, WS_X2B = WS_R3;
constexpr size_t WS_QB = WS_R4, WS_KB = WS_R4 + 64 * MiB, WS_VB = WS_R4 + 128 * MiB, WS_SA = WS_R4 + 192 * MiB, WS_SB = WS_R4 + 320 * MiB;
constexpr size_t WS_XG = WS_R4, WS_X2L = WS_R4, WS_H = WS_R4 + 272 * MiB;
constexpr int MAXSLOT = 139264;
constexpr int CW_BAR = 4096;
constexpr int CW_CNT = 16384;
constexpr int CW_MCNT = 24576;
constexpr int CW_TICKET = 28672;
#ifndef CHECK
#define CHECK 0
#endif
#ifndef CHK_GAIN
#define CHK_GAIN 4.0f
#endif
#ifndef CHK_GROUPS
#define CHK_GROUPS 0xffff
#endif
constexpr int CW_ERR = 20000;
#ifndef REPMASK
#define REPMASK 0
#endif
#define NREP(k) (1 + ((REPMASK >> (k)) & 1))
#ifndef MLA_TUNED
#define MLA_TUNED 1
#endif
#ifndef REP_MOBA_A
#define REP_MOBA_A 1
#endif
#ifndef REP_MOBA_B
#define REP_MOBA_B 1
#endif
#ifndef WGM_P1
#define WGM_P1 4
#endif
#ifndef WGM_O
#define WGM_O 8
#endif
#ifndef RES_BF16
#define RES_BF16 1
#endif
#ifndef MLA_PRIO
#define MLA_PRIO 1
#endif
#ifndef MOBA_PRIO
#define MOBA_PRIO 0
#endif
#ifndef P0_RPT
#define P0_RPT 4
#endif
#ifndef FIN_RPT
#define FIN_RPT 2
#endif
#ifndef CMB_T
#define CMB_T 4
#endif
#ifndef REP_MLA
#define REP_MLA 1
#endif
#ifndef REP_MOBA
#define REP_MOBA 1
#endif
#ifndef MOBA_TPF
#define MOBA_TPF 1
#endif
#ifndef MLA_OVL
#define MLA_OVL 0
#endif
#ifndef MLA_HEAD
#define MLA_HEAD 0
#endif
#ifndef MOE_SPLIT
#define MOE_SPLIT 1
#endif
#ifndef MOE_Q
#define MOE_Q 5
#endif

constexpr int RING_BYTES = 131072;
constexpr int LDSCTL_OFF = RING_BYTES, MISC_OFF = LDSCTL_OFF + 320;
constexpr int LDS_BYTES = 147456;
constexpr int MI_TS = 16, MI_HIST = 64, MI_BASE = 96;

typedef unsigned short bf16;
typedef unsigned v4u __attribute__((ext_vector_type(4)));
typedef float f32x4 __attribute__((ext_vector_type(4)));
typedef float f32x16 __attribute__((ext_vector_type(16)));
typedef short bf16x8 __attribute__((ext_vector_type(8)));
typedef short s16x4 __attribute__((ext_vector_type(4)));
typedef GAS unsigned gu32;
#define RLX_AGENT __ATOMIC_RELAXED, __HIP_MEMORY_SCOPE_AGENT
#define LDS_WAIT() asm volatile("s_waitcnt lgkmcnt(0)" ::: "memory")
#define VM_WAIT() asm volatile("s_waitcnt vmcnt(0)" ::: "memory")

__device__ __forceinline__ int lane_id() { int l; asm volatile("v_mbcnt_lo_u32_b32 %0, -1, 0\n\tv_mbcnt_hi_u32_b32 %0, -1, %0" : "=v"(l)); return l; }
__device__ __forceinline__ unsigned f2bf(float f) { unsigned u = __builtin_bit_cast(unsigned, f); return (u + 0x7fffu + ((u >> 16) & 1u)) >> 16; }
__device__ __forceinline__ unsigned pk2(float lo, float hi) { return f2bf(lo) | (f2bf(hi) << 16); }
__device__ __forceinline__ unsigned cvt_pk_bf16(float lo, float hi) { unsigned r; asm volatile("v_cvt_pk_bf16_f32 %0, %1, %2" : "=v"(r) : "v"(lo), "v"(hi)); return r; }
__device__ __forceinline__ float bflo(unsigned w) { return __builtin_bit_cast(float, w << 16); }
__device__ __forceinline__ float bfhi(unsigned w) { return __builtin_bit_cast(float, w & 0xffff0000u); }
__device__ __forceinline__ float fsigmoid(float v) { return __builtin_amdgcn_rcpf(1.f + __builtin_amdgcn_exp2f(-v * LOG2E)); }
__device__ __forceinline__ float dot4(const f32x4 v) { return (v[0] * v[0] + v[1] * v[1]) + (v[2] * v[2] + v[3] * v[3]); }

namespace pg8 {
typedef unsigned short bf16_t;
constexpr int BM = 256, BK = 64, HALF = 128, HTB = HALF * BK * 2, STAGE_BYTES = 8 * HTB, NXCD = 8;
__host__ __device__ __forceinline__ int lds_byte(int r, int c) { const int st = (r >> 4) * 2 + (c >> 5), rr = r & 15, cc = c & 31, ob = rr * 64 + cc * 2; return st * 1024 + (ob ^ (((ob >> 9) & 1) << 5)); }
__host__ __device__ __forceinline__ void stage_rc(int b, int& R, int& C) { const int st = b / 1024, sb = b % 1024, swz = sb ^ (((sb >> 9) & 1) << 5); R = (st >> 1) * 16 + swz / 64; C = (st & 1) * 32 + (swz % 64) / 2; }
__host__ __device__ __forceinline__ int perm32(int rho) { const int n = rho >> 4, i = rho & 15; return 8 * (i >> 2) + 4 * n + (i & 3); }

struct Unit { int pm, pn, aux, pad; long aoff, boff; };
struct Gemm { const bf16_t* A; const bf16_t* Bt; int K, lda, ldb, pad; };

struct SchedGrid {
    int nM, nN, nwg, G, c, rep, WGM; long ta, tb;
    __device__ void init(int nM_, int nN_, int G_, int c_, int lda, int ldb, int rep_ = 1, int wgm_ = 8) { nM = nM_; nN = nN_; nwg = nM * nN; G = G_; c = c_; rep = rep_; WGM = wgm_; ta = 256L * lda * 2; tb = 256L * ldb * 2; }
    __device__ __forceinline__ bool tile(long L, Unit& u) const {
        if (L >= (long)nwg * rep) return false;
        if (L >= nwg) L -= nwg;
        int wgid = (int)L; { const int q = nwg / NXCD, r = nwg % NXCD, xcd = wgid % NXCD, off = wgid / NXCD; wgid = (xcd < r ? xcd * (q + 1) : r * (q + 1) + (xcd - r) * q) + off; }
        const int nig = WGM * nN, gid = wgid / nig, fm = gid * WGM, gsz = (nM - fm) < WGM ? (nM - fm) : WGM;
        u.pm = fm + ((wgid % nig) % gsz); u.pn = (wgid % nig) / gsz; u.aux = 0; u.pad = 0; u.aoff = u.pm * ta; u.boff = u.pn * tb; return true;
    }
    __device__ __forceinline__ bool next(int i, Unit& u) const { return tile((long)i * G + c, u); }
};
struct SchedMix {
    SchedGrid g;
    __device__ __forceinline__ bool next(int i, Unit& u) const { if (!g.tile((long)(i >> 1) * g.G + g.c, u)) return false; u.aux = i & 1; u.aoff += (i & 1) * 1024; u.boff += (i & 1) * 1024; return true; }
};
struct SchedMoE {
    const volatile LAS int* TS; int npn, lo, hi, stride; long ta, tbe, tbn;
    __device__ __forceinline__ bool next(int i, Unit& u) const {
        const int L = lo + i * stride; if (L >= hi) return false;
        const int st = L / npn, pn = L % npn; int e = 0;
        for (int k = 1; k < 32; ++k) e += (st >= TS[k]) ? 1 : 0;
        u.pm = st; u.pn = pn; u.aux = e; u.pad = 0; u.aoff = st * ta; u.boff = e * tbe + pn * tbn; return true;
    }
};

template <class Epi, class Sched>
__device__ __forceinline__ void gemm_phase(LAS unsigned char* lds, const Gemm g, const Sched& S, const Epi& E, const int wave) {
    const int wid = wave, lane = lane_id(), tid = wid * 64 + lane, wr = wid >> 2, wc = wid & 3, fr = lane & 15, fq = lane >> 4;
    const int K = g.K, nt = K / BK;
    unsigned voffA[2], voffB[2];
#pragma unroll
    for (int i = 0; i < 2; ++i) { int R, C; stage_rc(tid * 16 + i * 8192, R, C); const int Rb = (R & ~31) + perm32(R & 31);
        voffA[i] = (unsigned)(R * g.lda + C) * 2u; voffB[i] = (unsigned)(Rb * g.ldb + C) * 2u; }
    const size_t kstep = (size_t)(BK * 2);
    const size_t hsA = (size_t)HALF * g.lda * 2, hsB = (size_t)HALF * g.ldb * 2;
    const unsigned ldsw = (unsigned)wid * 1024u;
    const int aoff = lds_byte(wr * 64 + fr, fq * 8), boff = lds_byte(wc * 32 + fr, fq * 8);
#define PG8_SA(b, h) (((b) * 2 + (h)) * HTB)
#define PG8_SB(b, h) ((4 + (b) * 2 + (h)) * HTB)
#define PG8_STAGE(bufoff, gbase, voff) do { _Pragma("unroll") for (int _i = 0; _i < 2; ++_i) \
        __builtin_amdgcn_global_load_lds((const unsigned*)((const char*)(gbase) + (voff)[_i]), (LAS unsigned*)(lds + (bufoff) + ldsw + _i * 8192), 16, 0, 0); } while (0)
#define PG8_LDA(dst, b, h) do { _Pragma("unroll") for (int m = 0; m < 4; ++m) _Pragma("unroll") for (int k = 0; k < 2; ++k) dst[m][k] = *(const LAS bf16x8*)(lds + PG8_SA(b, h) + aoff + m * 2048 + k * 1024); } while (0)
#define PG8_LDB(dst, b, h) do { _Pragma("unroll") for (int n = 0; n < 2; ++n) _Pragma("unroll") for (int k = 0; k < 2; ++k) dst[n][k] = *(const LAS bf16x8*)(lds + PG8_SB(b, h) + boff + n * 2048 + k * 1024); } while (0)
#define PG8_MMA(ai, bj, At, Bt) do { __builtin_amdgcn_s_setprio(1); _Pragma("unroll") for (int m = 0; m < 4; ++m) _Pragma("unroll") for (int n = 0; n < 2; ++n) _Pragma("unroll") for (int k = 0; k < 2; ++k) \
        acc[ai][bj][m][n] = __builtin_amdgcn_mfma_f32_16x16x32_bf16(Bt[n][k], At[m][k], acc[ai][bj][m][n], 0, 0, 0); __builtin_amdgcn_s_setprio(0); } while (0)
#define PG8_WAIT_V(n) asm volatile("s_waitcnt vmcnt(" #n ")" ::: "memory")
#define PG8_WAIT_L(n) asm volatile("s_waitcnt lgkmcnt(" #n ")" ::: "memory")
#define PG8_BAR __builtin_amdgcn_s_barrier()
#define PG8_SCHED __builtin_amdgcn_sched_barrier(0)
    Unit cur, nxt; int ui = 0;
    if (!S.next(0, cur)) return;
    f32x4 acc[2][2][4][2];
#pragma unroll
    for (int a = 0; a < 2; ++a)
#pragma unroll
        for (int b = 0; b < 2; ++b)
#pragma unroll
            for (int m = 0; m < 4; ++m)
#pragma unroll
                for (int n = 0; n < 2; ++n) acc[a][b][m][n] = (f32x4){0.f, 0.f, 0.f, 0.f};
    bf16x8 At[4][2], B0[2][2], B1[2][2];
    const char* cA = (const char*)g.A + cur.aoff; const char* cB = (const char*)g.Bt + cur.boff;
    PG8_STAGE(PG8_SB(0, 0), cB, voffB); PG8_STAGE(PG8_SB(0, 1), cB + hsB, voffB); PG8_STAGE(PG8_SA(0, 0), cA, voffA); PG8_STAGE(PG8_SA(0, 1), cA + hsA, voffA);
    if (wr == 1) PG8_BAR;
    PG8_WAIT_V(2); PG8_BAR;
    PG8_STAGE(PG8_SB(1, 0), cB + kstep, voffB); PG8_STAGE(PG8_SA(1, 0), cA + kstep, voffA); PG8_STAGE(PG8_SB(1, 1), cB + hsB + kstep, voffB);
    PG8_WAIT_V(6); PG8_BAR;
    for (;;) {
        const bool has_next = S.next(ui + 1, nxt);
        const char* nA = has_next ? (const char*)g.A + nxt.aoff : cA; const char* nB = has_next ? (const char*)g.Bt + nxt.boff : cB;
        for (int t = 0; t < nt; t += 2) {
            const bool last = (t == nt - 2);
            const char* a1 = cA + (size_t)(t + 1) * kstep;
            const char* a2 = last ? nA : cA + (size_t)(t + 2) * kstep; const char* b2 = last ? nB : cB + (size_t)(t + 2) * kstep;
            const char* a3 = a2 + kstep; const char* b3 = b2 + kstep;
            PG8_LDB(B0, 0, 0); PG8_LDB(B1, 0, 1); PG8_SCHED; PG8_LDA(At, 0, 0); PG8_STAGE(PG8_SA(1, 1), a1 + hsA, voffA);
            PG8_WAIT_V(8); PG8_WAIT_L(0); PG8_BAR; PG8_MMA(0, 0, At, B0); PG8_MMA(0, 1, At, B1); PG8_BAR; PG8_SCHED;
            PG8_LDA(At, 0, 1); PG8_STAGE(PG8_SB(0, 0), b2, voffB); PG8_STAGE(PG8_SB(0, 1), b2 + hsB, voffB); PG8_STAGE(PG8_SA(0, 0), a2, voffA);
            PG8_WAIT_V(8); PG8_WAIT_L(0); PG8_BAR; PG8_MMA(1, 0, At, B0); PG8_MMA(1, 1, At, B1); PG8_BAR; PG8_SCHED;
            PG8_LDB(B0, 1, 0); PG8_LDB(B1, 1, 1); PG8_SCHED; PG8_LDA(At, 1, 0); PG8_STAGE(PG8_SA(0, 1), a2 + hsA, voffA);
            PG8_WAIT_V(8); PG8_WAIT_L(0); PG8_BAR; PG8_MMA(0, 0, At, B0); PG8_MMA(0, 1, At, B1); PG8_BAR; PG8_SCHED;
            PG8_LDA(At, 1, 1); PG8_STAGE(PG8_SB(1, 0), b3, voffB); PG8_STAGE(PG8_SB(1, 1), b3 + hsB, voffB); PG8_STAGE(PG8_SA(1, 0), a3, voffA);
            PG8_WAIT_V(8); PG8_WAIT_L(0); PG8_BAR; PG8_MMA(1, 0, At, B0); PG8_MMA(1, 1, At, B1); PG8_BAR; PG8_SCHED;
        }
        if (wr == 0) PG8_BAR;
        const bool keep = E(acc, cur, wr, wc, fr, fq);
        if (!has_next) break;
        if (!keep) {
#pragma unroll
            for (int a = 0; a < 2; ++a)
#pragma unroll
                for (int b = 0; b < 2; ++b)
#pragma unroll
                    for (int m = 0; m < 4; ++m)
#pragma unroll
                        for (int n = 0; n < 2; ++n) acc[a][b][m][n] = (f32x4){0.f, 0.f, 0.f, 0.f};
        }
        cur = nxt; cA = nA; cB = nB; ++ui;
        if (wr == 1) PG8_BAR;
    }
    PG8_WAIT_V(0);
    PG8_BAR;
#undef PG8_SA
#undef PG8_SB
#undef PG8_STAGE
#undef PG8_LDA
#undef PG8_LDB
#undef PG8_MMA
#undef PG8_WAIT_V
#undef PG8_WAIT_L
#undef PG8_BAR
#undef PG8_SCHED
}

template <class Epi, class Sched>
__device__ __forceinline__ void gemm_phase_g(LAS unsigned char* lds, const Gemm g, const Sched& S, const Epi& E, const int wave, const int* ROWS) {
    const int wid = wave, lane = lane_id(), tid = wid * 64 + lane, wr = wid >> 2, wc = wid & 3, fr = lane & 15, fq = lane >> 4;
    const int K = g.K, nt = K / BK;
    unsigned voffB[2]; int RA[2]; unsigned CA2[2];
#pragma unroll
    for (int i = 0; i < 2; ++i) { int R, C; stage_rc(tid * 16 + i * 8192, R, C); const int Rb = (R & ~31) + perm32(R & 31);
        RA[i] = R; CA2[i] = (unsigned)C * 2u; voffB[i] = (unsigned)(Rb * g.ldb + C) * 2u; }
    const unsigned rowb = (unsigned)g.lda * 2u;
    unsigned vcur[2][2], vnxt[2][2];
#define PG8_ROWS(dst, u) do { _Pragma("unroll") for (int h_ = 0; h_ < 2; ++h_) _Pragma("unroll") for (int i_ = 0; i_ < 2; ++i_) { const int t_ = ROWS[(u).pm * 256 + h_ * 128 + RA[i_]]; dst[h_][i_] = (unsigned)(t_ < 0 ? 0 : t_) * rowb + CA2[i_]; } } while (0)
    const size_t kstep = (size_t)(BK * 2);
    const size_t hsA = (size_t)HALF * g.lda * 2, hsB = (size_t)HALF * g.ldb * 2;
    const unsigned ldsw = (unsigned)wid * 1024u;
    const int aoff = lds_byte(wr * 64 + fr, fq * 8), boff = lds_byte(wc * 32 + fr, fq * 8);
#define PG8_SA(b, h) (((b) * 2 + (h)) * HTB)
#define PG8_SB(b, h) ((4 + (b) * 2 + (h)) * HTB)
#define PG8_STAGE(bufoff, gbase, voff) do { _Pragma("unroll") for (int _i = 0; _i < 2; ++_i) \
        __builtin_amdgcn_global_load_lds((const unsigned*)((const char*)(gbase) + (voff)[_i]), (LAS unsigned*)(lds + (bufoff) + ldsw + _i * 8192), 16, 0, 0); } while (0)
#define PG8_LDA(dst, b, h) do { _Pragma("unroll") for (int m = 0; m < 4; ++m) _Pragma("unroll") for (int k = 0; k < 2; ++k) dst[m][k] = *(const LAS bf16x8*)(lds + PG8_SA(b, h) + aoff + m * 2048 + k * 1024); } while (0)
#define PG8_LDB(dst, b, h) do { _Pragma("unroll") for (int n = 0; n < 2; ++n) _Pragma("unroll") for (int k = 0; k < 2; ++k) dst[n][k] = *(const LAS bf16x8*)(lds + PG8_SB(b, h) + boff + n * 2048 + k * 1024); } while (0)
#define PG8_MMA(ai, bj, At, Bt) do { __builtin_amdgcn_s_setprio(1); _Pragma("unroll") for (int m = 0; m < 4; ++m) _Pragma("unroll") for (int n = 0; n < 2; ++n) _Pragma("unroll") for (int k = 0; k < 2; ++k) \
        acc[ai][bj][m][n] = __builtin_amdgcn_mfma_f32_16x16x32_bf16(Bt[n][k], At[m][k], acc[ai][bj][m][n], 0, 0, 0); __builtin_amdgcn_s_setprio(0); } while (0)
#define PG8_WAIT_V(n) asm volatile("s_waitcnt vmcnt(" #n ")" ::: "memory")
#define PG8_WAIT_L(n) asm volatile("s_waitcnt lgkmcnt(" #n ")" ::: "memory")
#define PG8_BAR __builtin_amdgcn_s_barrier()
#define PG8_SCHED __builtin_amdgcn_sched_barrier(0)
    Unit cur, nxt, nn; int ui = 0;
    if (!S.next(0, cur)) return;
    bool has_next = S.next(1, nxt);
    PG8_ROWS(vcur, cur); if (has_next) { PG8_ROWS(vnxt, nxt); } else { _Pragma("unroll") for (int h_ = 0; h_ < 2; ++h_) _Pragma("unroll") for (int i_ = 0; i_ < 2; ++i_) vnxt[h_][i_] = vcur[h_][i_]; }
    f32x4 acc[2][2][4][2];
#pragma unroll
    for (int a = 0; a < 2; ++a)
#pragma unroll
        for (int b = 0; b < 2; ++b)
#pragma unroll
            for (int m = 0; m < 4; ++m)
#pragma unroll
                for (int n = 0; n < 2; ++n) acc[a][b][m][n] = (f32x4){0.f, 0.f, 0.f, 0.f};
    bf16x8 At[4][2], B0[2][2], B1[2][2];
    const char* cA = (const char*)g.A; const char* cB = (const char*)g.Bt + cur.boff;
    PG8_STAGE(PG8_SB(0, 0), cB, voffB); PG8_STAGE(PG8_SB(0, 1), cB + hsB, voffB); PG8_STAGE(PG8_SA(0, 0), cA, vcur[0]); PG8_STAGE(PG8_SA(0, 1), cA, vcur[1]);
    if (wr == 1) PG8_BAR;
    PG8_WAIT_V(2); PG8_BAR;
    PG8_STAGE(PG8_SB(1, 0), cB + kstep, voffB); PG8_STAGE(PG8_SA(1, 0), cA + kstep, vcur[0]); PG8_STAGE(PG8_SB(1, 1), cB + hsB + kstep, voffB);
    PG8_WAIT_V(6); PG8_BAR;
    for (;;) {
        const bool has_nn = has_next && S.next(ui + 2, nn);
        const char* nB = has_next ? (const char*)g.Bt + nxt.boff : cB;
        for (int t = 0; t < nt; t += 2) {
            const bool last = (t == nt - 2);
            const char* a1 = cA + (size_t)(t + 1) * kstep;
            const char* a2 = last ? cA : cA + (size_t)(t + 2) * kstep; const char* b2 = last ? nB : cB + (size_t)(t + 2) * kstep;
            unsigned v2[2][2];
#pragma unroll
            for (int h_ = 0; h_ < 2; ++h_)
#pragma unroll
                for (int i_ = 0; i_ < 2; ++i_) v2[h_][i_] = last ? vnxt[h_][i_] : vcur[h_][i_];
            const char* a3 = a2 + kstep; const char* b3 = b2 + kstep;
            PG8_LDB(B0, 0, 0); PG8_LDB(B1, 0, 1); PG8_SCHED; PG8_LDA(At, 0, 0); PG8_STAGE(PG8_SA(1, 1), a1, vcur[1]);
            PG8_WAIT_V(8); PG8_WAIT_L(0); PG8_BAR; PG8_MMA(0, 0, At, B0); PG8_MMA(0, 1, At, B1); PG8_BAR; PG8_SCHED;
            PG8_LDA(At, 0, 1); PG8_STAGE(PG8_SB(0, 0), b2, voffB); PG8_STAGE(PG8_SB(0, 1), b2 + hsB, voffB); PG8_STAGE(PG8_SA(0, 0), a2, v2[0]);
            PG8_WAIT_V(8); PG8_WAIT_L(0); PG8_BAR; PG8_MMA(1, 0, At, B0); PG8_MMA(1, 1, At, B1); PG8_BAR; PG8_SCHED;
            PG8_LDB(B0, 1, 0); PG8_LDB(B1, 1, 1); PG8_SCHED; PG8_LDA(At, 1, 0); PG8_STAGE(PG8_SA(0, 1), a2, v2[1]);
            PG8_WAIT_V(8); PG8_WAIT_L(0); PG8_BAR; PG8_MMA(0, 0, At, B0); PG8_MMA(0, 1, At, B1); PG8_BAR; PG8_SCHED;
            PG8_LDA(At, 1, 1); PG8_STAGE(PG8_SB(1, 0), b3, voffB); PG8_STAGE(PG8_SB(1, 1), b3 + hsB, voffB); PG8_STAGE(PG8_SA(1, 0), a3, v2[0]);
            PG8_WAIT_V(8); PG8_WAIT_L(0); PG8_BAR; PG8_MMA(1, 0, At, B0); PG8_MMA(1, 1, At, B1); PG8_BAR; PG8_SCHED;
        }
        if (wr == 0) PG8_BAR;
        unsigned vnn[2][2];
        if (has_nn) { PG8_ROWS(vnn, nn); } else { _Pragma("unroll") for (int h_ = 0; h_ < 2; ++h_) _Pragma("unroll") for (int i_ = 0; i_ < 2; ++i_) vnn[h_][i_] = vnxt[h_][i_]; }
        const bool keep = E(acc, cur, wr, wc, fr, fq);
        if (!has_next) break;
        if (!keep) {
#pragma unroll
            for (int a = 0; a < 2; ++a)
#pragma unroll
                for (int b = 0; b < 2; ++b)
#pragma unroll
                    for (int m = 0; m < 4; ++m)
#pragma unroll
                        for (int n = 0; n < 2; ++n) acc[a][b][m][n] = (f32x4){0.f, 0.f, 0.f, 0.f};
        }
        cur = nxt; nxt = nn; cB = nB; ++ui; has_next = has_nn;
#pragma unroll
        for (int h_ = 0; h_ < 2; ++h_)
#pragma unroll
            for (int i_ = 0; i_ < 2; ++i_) { vcur[h_][i_] = vnxt[h_][i_]; vnxt[h_][i_] = vnn[h_][i_]; }
        if (wr == 1) PG8_BAR;
    }
    PG8_WAIT_V(0);
    PG8_BAR;
#undef PG8_SA
#undef PG8_SB
#undef PG8_STAGE
#undef PG8_ROWS
#undef PG8_LDA
#undef PG8_LDB
#undef PG8_MMA
#undef PG8_WAIT_V
#undef PG8_WAIT_L
#undef PG8_BAR
#undef PG8_SCHED
}

__device__ __forceinline__ v4u pack8(const f32x4 v0, const f32x4 v1) { v4u w; w.x = cvt_pk_bf16(v0[0], v0[1]); w.y = cvt_pk_bf16(v0[2], v0[3]); w.z = cvt_pk_bf16(v1[0], v1[1]); w.w = cvt_pk_bf16(v1[2], v1[3]); return w; }
__device__ __forceinline__ void rot2(float& a, float& b, float c, float s) { const float x = a * c - b * s, y = b * c + a * s; a = x; b = y; }
__device__ __forceinline__ void rope8(f32x4& v0, f32x4& v1, const f32x4 c4, const f32x4 s4) {
    float a0 = v0[0], b0 = v0[1], a1 = v0[2], b1 = v0[3], a2 = v1[0], b2 = v1[1], a3 = v1[2], b3 = v1[3];
    rot2(a0, b0, c4[0], s4[0]); rot2(a1, b1, c4[1], s4[1]); rot2(a2, b2, c4[2], s4[2]); rot2(a3, b3, c4[3], s4[3]);
    v0 = (f32x4){a0, b0, a1, b1}; v1 = (f32x4){a2, b2, a3, b3};
}

struct EpiProj {
    bf16_t *CQ, *CKV, *KR, *QB, *KB, *VB, *SA, *SB; float *SSQ_Q, *SSQ_KV, *KSUM; const float *COSA, *SINA, *COSB, *SINB;
    __device__ __forceinline__ bool operator()(f32x4 (&acc)[2][2][4][2], const Unit& u, int wr, int wc, int fr, int fq) const {
        const int pn = u.pn, row0 = u.pm * BM + wr * 64 + fr, ct = wc * 32 + 8 * fq;
        if (pn < 4) {
            bf16_t* O; int ldc, cb, nss, sidx; float* SS;
            if (pn < 3) { O = CQ; ldc = QL; cb = pn * 256; SS = SSQ_Q; nss = 12; sidx = pn * 4 + wc; } else { O = CKV; ldc = KVL; cb = 0; SS = SSQ_KV; nss = 4; sidx = wc; }
#pragma unroll
            for (int ai = 0; ai < 2; ++ai)
#pragma unroll
                for (int m = 0; m < 4; ++m) { const int row = row0 + ai * HALF + m * 16; float s = 0.f;
#pragma unroll
                    for (int bj = 0; bj < 2; ++bj) { const f32x4 v0 = acc[ai][bj][m][0], v1 = acc[ai][bj][m][1]; s += dot4(v0) + dot4(v1);
                        *(v4u*)(O + (size_t)row * ldc + cb + bj * HALF + ct) = pack8(v0, v1); }
                    s += __shfl_xor(s, 16); s += __shfl_xor(s, 32);
                    if (fq == 0) SS[(size_t)row * nss + sidx] = s; }
        } else if (pn < 8) {
            const bool isq = pn < 6; bf16_t* O = isq ? QB : KB; const int cb = (pn - (isq ? 4 : 6)) * 256;
            const bool rope = ((wc & 1) == 0) && (fq < 2); const float sc = isq ? C2B : 1.f;
#pragma unroll
            for (int ai = 0; ai < 2; ++ai)
#pragma unroll
                for (int m = 0; m < 4; ++m) { const int row = row0 + ai * HALF + m * 16, pos = row & (SEQ - 1);
                    f32x4 c4 = (f32x4){1.f, 1.f, 1.f, 1.f}, s4 = (f32x4){0.f, 0.f, 0.f, 0.f};
                    if (rope) { c4 = *(const f32x4*)(COSB + pos * 8 + 4 * fq); s4 = *(const f32x4*)(SINB + pos * 8 + 4 * fq); }
#pragma unroll
                    for (int bj = 0; bj < 2; ++bj) { f32x4 v0 = acc[ai][bj][m][0], v1 = acc[ai][bj][m][1];
                        rope8(v0, v1, c4, s4); v0 = v0 * sc; v1 = v1 * sc;
                        *(v4u*)(O + (size_t)row * 512 + cb + bj * HALF + ct) = pack8(v0, v1); } }
            if (!isq) {
#pragma unroll
                for (int bj = 0; bj < 2; ++bj)
#pragma unroll
                    for (int n = 0; n < 2; ++n) { f32x4 v = (f32x4){0.f, 0.f, 0.f, 0.f};
#pragma unroll
                        for (int ai = 0; ai < 2; ++ai)
#pragma unroll
                            for (int m = 0; m < 4; ++m) { const int pos = (row0 + ai * HALF + m * 16) & (SEQ - 1);
                                float a0 = acc[ai][bj][m][n][0], b0 = acc[ai][bj][m][n][1], a1 = acc[ai][bj][m][n][2], b1 = acc[ai][bj][m][n][3];
                                if (rope) { const float* cp = COSB + pos * 8 + 4 * fq + 2 * n; const float* sp = SINB + pos * 8 + 4 * fq + 2 * n;
                                    rot2(a0, b0, cp[0], sp[0]); rot2(a1, b1, cp[1], sp[1]); }
                                v[0] += a0; v[1] += b0; v[2] += a1; v[3] += b1; }
#pragma unroll
                        for (int o = 1; o < 16; o <<= 1) { v[0] += __shfl_xor(v[0], o); v[1] += __shfl_xor(v[1], o); v[2] += __shfl_xor(v[2], o); v[3] += __shfl_xor(v[3], o); }
                        if (fr == 0) *(f32x4*)(KSUM + ((size_t)(wr * 256 + u.pm)) * 512 + cb + bj * HALF + ct + 4 * n) = v;
                        asm volatile("" ::: "memory"); }
            }
        } else if (pn < 10) {
            const int cb = (pn - 8) * 256;
#pragma unroll
            for (int ai = 0; ai < 2; ++ai)
#pragma unroll
                for (int m = 0; m < 4; ++m) { const int row = row0 + ai * HALF + m * 16;
#pragma unroll
                    for (int bj = 0; bj < 2; ++bj) *(v4u*)(VB + (size_t)row * 512 + cb + bj * HALF + ct) = pack8(acc[ai][bj][m][0], acc[ai][bj][m][1]); }
        } else if (pn < 18) {
            const int cb = (pn - 10) * 128;
#pragma unroll
            for (int ai = 0; ai < 2; ++ai)
#pragma unroll
                for (int m = 0; m < 4; ++m) { const int row = row0 + ai * HALF + m * 16;
                    f32x4 r0, r1, b0, b1;
#pragma unroll
                    for (int j = 0; j < 4; ++j) { const float sa0 = fsigmoid(acc[ai][0][m][0][j]), sa1 = fsigmoid(acc[ai][0][m][1][j]);
                        b0[j] = fmaxf(fsigmoid(acc[ai][1][m][0][j]), 1e-30f); b1[j] = fmaxf(fsigmoid(acc[ai][1][m][1][j]), 1e-30f);
                        r0[j] = sa0 * __builtin_amdgcn_rcpf(b0[j]); r1[j] = sa1 * __builtin_amdgcn_rcpf(b1[j]); }
                    *(v4u*)(SA + (size_t)row * DM + cb + ct) = pack8(r0, r1); *(v4u*)(SB + (size_t)row * DM + cb + ct) = pack8(b0, b1); }
        } else {
            if (wc == 0) {
#pragma unroll
                for (int ai = 0; ai < 2; ++ai)
#pragma unroll
                    for (int m = 0; m < 4; ++m) { const int row = row0 + ai * HALF + m * 16, pos = row & (SEQ - 1);
                        const f32x4 c4 = *(const f32x4*)(COSA + pos * 16 + 4 * fq), s4 = *(const f32x4*)(SINA + pos * 16 + 4 * fq);
                        f32x4 v0 = acc[ai][0][m][0], v1 = acc[ai][0][m][1]; rope8(v0, v1, c4, s4);
                        *(v4u*)(KR + (size_t)row * 32 + 8 * fq) = pack8(v0, v1); }
            }
        }
        return false;
    }
};
struct EpiPlain {
    bf16_t* O;
    __device__ __forceinline__ bool operator()(f32x4 (&acc)[2][2][4][2], const Unit& u, int wr, int wc, int fr, int fq) const {
        const int row0 = (u.pm & 15) * BM + wr * 64 + fr, ct = wc * 32 + 8 * fq;
#pragma unroll
        for (int ai = 0; ai < 2; ++ai)
#pragma unroll
            for (int m = 0; m < 4; ++m) { const int row = row0 + ai * HALF + m * 16;
#pragma unroll
                for (int bj = 0; bj < 2; ++bj) *(v4u*)(O + (size_t)row * NPROJ + u.pn * 256 + bj * HALF + ct) = pack8(acc[ai][bj][m][0], acc[ai][bj][m][1]); }
        return false;
    }
};
struct EpiQ {
    bf16_t* QA; const float *SSQ_Q, *COSA, *SINA;
    __device__ __forceinline__ bool operator()(f32x4 (&acc)[2][2][4][2], const Unit& u, int wr, int wc, int fr, int fq) const {
        const int row0 = u.pm * BM + wr * 64 + fr;
        bool isrope[2];
#pragma unroll
        for (int bj = 0; bj < 2; ++bj) isrope[bj] = (((u.pn * 256 + bj * HALF + wc * 32) >> 5) % 3) == 2;
        const bool anyrope = isrope[0] || isrope[1];
#pragma unroll
        for (int ai = 0; ai < 2; ++ai) { float rs[4]; f32x4 c4[4], s4[4];
            { f32x4 p[4][3];
#pragma unroll
              for (int m = 0; m < 4; ++m) { const size_t row = (size_t)(row0 + ai * HALF + m * 16);
#pragma unroll
                  for (int k = 0; k < 3; ++k) p[m][k] = *(const f32x4*)(SSQ_Q + row * 12 + 4 * k); }
              if (anyrope) {
#pragma unroll
                  for (int m = 0; m < 4; ++m) { const int pos = (row0 + ai * HALF + m * 16) & (SEQ - 1); c4[m] = *(const f32x4*)(COSA + pos * 16 + 4 * fq); s4[m] = *(const f32x4*)(SINA + pos * 16 + 4 * fq); } }
#pragma unroll
              for (int m = 0; m < 4; ++m) { float ss = 0.f;
#pragma unroll
                  for (int k = 0; k < 3; ++k)
#pragma unroll
                      for (int j = 0; j < 4; ++j) ss += p[m][k][j];
                  rs[m] = C2A / sqrtf(ss * (1.f / QL) + EPS); } }
#pragma unroll
            for (int m = 0; m < 4; ++m) { const int row = row0 + ai * HALF + m * 16;
#pragma unroll
                for (int bj = 0; bj < 2; ++bj) { const int cg = u.pn * 256 + bj * HALF + wc * 32;
                    f32x4 v0 = acc[ai][bj][m][0] * rs[m], v1 = acc[ai][bj][m][1] * rs[m];
                    if (isrope[bj]) rope8(v0, v1, c4[m], s4[m]);
                    *(v4u*)(QA + (size_t)row * QL + cg + 8 * fq) = pack8(v0, v1); } }
            asm volatile("" ::: "memory"); }
        return false;
    }
};
struct EpiKV {
    bf16_t* KV; const float* SSQ_KV;
    __device__ __forceinline__ bool operator()(f32x4 (&acc)[2][2][4][2], const Unit& u, int wr, int wc, int fr, int fq) const {
        const int row0 = u.pm * BM + wr * 64 + fr, ct = wc * 32 + 8 * fq;
        f32x4 p[2][4];
#pragma unroll
        for (int ai = 0; ai < 2; ++ai)
#pragma unroll
            for (int m = 0; m < 4; ++m) p[ai][m] = *(const f32x4*)(SSQ_KV + (size_t)(row0 + ai * HALF + m * 16) * 4);
#pragma unroll
        for (int ai = 0; ai < 2; ++ai)
#pragma unroll
            for (int m = 0; m < 4; ++m) { const int row = row0 + ai * HALF + m * 16;
                const float ss = ((p[ai][m][0] + p[ai][m][1]) + p[ai][m][2]) + p[ai][m][3];
                const float rs = 1.f / sqrtf(ss * (1.f / KVL) + EPS);
#pragma unroll
                for (int bj = 0; bj < 2; ++bj) *(v4u*)(KV + (size_t)row * DM + u.pn * 256 + bj * HALF + ct) = pack8(acc[ai][bj][m][0] * rs, acc[ai][bj][m][1] * rs); }
        return false;
    }
};
struct EpiMix {
    bf16_t* MIX; const bf16_t *RA, *SB;
    __device__ __forceinline__ bool operator()(f32x4 (&acc)[2][2][4][2], const Unit& u, int wr, int wc, int fr, int fq) const {
        const int row0 = u.pm * BM + wr * 64 + fr, ct = wc * 32 + 8 * fq; const bool first = (u.aux == 0);
        const bf16_t* G = first ? RA : SB;
        v4u gq[2][4][2];
#pragma unroll
        for (int ai = 0; ai < 2; ++ai)
#pragma unroll
            for (int m = 0; m < 4; ++m)
#pragma unroll
                for (int bj = 0; bj < 2; ++bj) gq[ai][m][bj] = *(const v4u*)(G + (size_t)(row0 + ai * HALF + m * 16) * DM + u.pn * 256 + bj * HALF + ct);
#pragma unroll
        for (int ai = 0; ai < 2; ++ai)
#pragma unroll
            for (int m = 0; m < 4; ++m)
#pragma unroll
                for (int bj = 0; bj < 2; ++bj) { const v4u gv = gq[ai][m][bj];
                    const float gf[8] = {bflo(gv.x), bfhi(gv.x), bflo(gv.y), bfhi(gv.y), bflo(gv.z), bfhi(gv.z), bflo(gv.w), bfhi(gv.w)};
                    f32x4 v0 = acc[ai][bj][m][0], v1 = acc[ai][bj][m][1];
#pragma unroll
                    for (int j = 0; j < 4; ++j) { v0[j] *= gf[j]; v1[j] *= gf[4 + j]; }
                    if (first) { acc[ai][bj][m][0] = v0; acc[ai][bj][m][1] = v1; }
                    else *(v4u*)(MIX + (size_t)(row0 + ai * HALF + m * 16) * DM + u.pn * 256 + bj * HALF + ct) = pack8(v0, v1); }
        return first;
    }
};
struct EpiOut {
    const float* X; bf16_t* X2L; bf16_t* X2B; float* SSQ_X;
    __device__ __forceinline__ bool operator()(f32x4 (&acc)[2][2][4][2], const Unit& u, int wr, int wc, int fr, int fq) const {
        const int row0 = u.pm * BM + wr * 64 + fr, ct = wc * 32 + 8 * fq;
#pragma unroll
        for (int ai = 0; ai < 2; ++ai) { f32x4 xv[4][2][2];
#pragma unroll
            for (int m = 0; m < 4; ++m)
#pragma unroll
                for (int bj = 0; bj < 2; ++bj) { const size_t off = (size_t)(row0 + ai * HALF + m * 16) * DM + u.pn * 256 + bj * HALF + ct; xv[m][bj][0] = *(const f32x4*)(X + off); xv[m][bj][1] = *(const f32x4*)(X + off + 4); }
#pragma unroll
            for (int m = 0; m < 4; ++m) { const int row = row0 + ai * HALF + m * 16; float s = 0.f;
#pragma unroll
                for (int bj = 0; bj < 2; ++bj) { const size_t off = (size_t)row * DM + u.pn * 256 + bj * HALF + ct;
                    const f32x4 v0 = acc[ai][bj][m][0] + xv[m][bj][0], v1 = acc[ai][bj][m][1] + xv[m][bj][1];
                    s += dot4(v0) + dot4(v1);
                    const v4u hp = pack8(v0, v1);
                    const f32x4 l0 = (f32x4){v0[0] - bflo(hp.x), v0[1] - bfhi(hp.x), v0[2] - bflo(hp.y), v0[3] - bfhi(hp.y)}, l1 = (f32x4){v1[0] - bflo(hp.z), v1[1] - bfhi(hp.z), v1[2] - bflo(hp.w), v1[3] - bfhi(hp.w)};
                    *(v4u*)(X2B + off) = hp;
#if !RES_BF16
                    *(v4u*)(X2L + off) = pack8(l0, l1);
#endif
                    }
                s += __shfl_xor(s, 16); s += __shfl_xor(s, 32);
                if (fq == 0) SSQ_X[(size_t)row * 16 + u.pn * 4 + wc] = s; } }
        return false;
    }
};
struct EpiH {
    bf16_t* H; const float* SLOT_RS;
    __device__ __forceinline__ bool operator()(f32x4 (&acc)[2][2][4][2], const Unit& u, int wr, int wc, int fr, int fq) const {
        const int row0 = u.pm * BM + wr * 64 + fr, ct = wc * 32 + 8 * fq;
        float rsv[2][4];
#pragma unroll
        for (int ai = 0; ai < 2; ++ai)
#pragma unroll
            for (int m = 0; m < 4; ++m) rsv[ai][m] = SLOT_RS[row0 + ai * HALF + m * 16];
#pragma unroll
        for (int ai = 0; ai < 2; ++ai)
#pragma unroll
            for (int m = 0; m < 4; ++m) { const int row = row0 + ai * HALF + m * 16; const float rs = rsv[ai][m];
                f32x4 h0, h1;
#pragma unroll
                for (int j = 0; j < 4; ++j) { const float g0 = acc[ai][0][m][0][j] * rs, g1 = acc[ai][0][m][1][j] * rs;
                    h0[j] = g0 * fsigmoid(g0) * (acc[ai][1][m][0][j] * rs); h1[j] = g1 * fsigmoid(g1) * (acc[ai][1][m][1][j] * rs); }
                *(v4u*)(H + (size_t)row * EFF + u.pn * HALF + ct) = pack8(h0, h1); }
        return false;
    }
};
struct EpiY {
    bf16_t* Y; const int* SLOT_A; const float* TOKW;
    __device__ __forceinline__ bool operator()(f32x4 (&acc)[2][2][4][2], const Unit& u, int wr, int wc, int fr, int fq) const {
        const int row0 = u.pm * BM + wr * 64 + fr, ct = wc * 32 + 8 * fq;
#pragma unroll
        for (int ai = 0; ai < 2; ++ai) { int av[4]; float wv[4];
#pragma unroll
            for (int m = 0; m < 4; ++m) av[m] = SLOT_A[row0 + ai * HALF + m * 16];
#pragma unroll
            for (int m = 0; m < 4; ++m) wv[m] = TOKW[av[m] < 0 ? 0 : av[m]];
#pragma unroll
            for (int m = 0; m < 4; ++m) { const int a = av[m];
                if (a >= 0) { const float w = wv[m]; bf16_t* yr = Y + (unsigned)a * (unsigned)DM + (unsigned)(u.pn * 256 + ct);
#pragma unroll
                    for (int bj = 0; bj < 2; ++bj) *(v4u*)(yr + bj * HALF) = pack8(acc[ai][bj][m][0] * w, acc[ai][bj][m][1] * w); } }
            asm volatile("" ::: "memory"); }
        return false;
    }
};
}

namespace at {
constexpr int NW = 8, QBLK = 32, QB = 256, KVBLK = 64;
constexpr int KSLOT = 12288, VSLOT = 8192;
constexpr int LDS_K = 0, LDS_V = 2 * KSLOT, LDS_WS = LDS_V + 2 * VSLOT, LDS_OST = LDS_WS + NW * 64 * 4, LDS_TOTAL = LDS_OST + NW * 4096;
typedef LAS const char* lds_cptr;
__device__ __forceinline__ int crow(int r, int hi) { return (r & 3) + 8 * (r >> 2) + 4 * hi; }
__device__ __forceinline__ void glds16(const void* gsrc, unsigned lds_dst) { unsigned keep;
    asm volatile("s_mov_b32 %0, m0\n\ts_mov_b32 m0, %2\n\ts_nop 0\n\tglobal_load_lds_dwordx4 %1, off\n\ts_mov_b32 m0, %0" : "=&s"(keep) : "v"(gsrc), "s"(lds_dst) : "memory"); }
__device__ __forceinline__ void glds16s(const void* sbase, unsigned voff, unsigned lds_dst) { unsigned keep;
    asm volatile("s_mov_b32 %0, m0\n\ts_mov_b32 m0, %3\n\ts_nop 0\n\tglobal_load_lds_dwordx4 %1, %2\n\ts_mov_b32 m0, %0" : "=&s"(keep) : "v"(voff), "s"(sbase), "s"(lds_dst) : "memory"); }
#define AT_WAIT_BAR0() asm volatile("s_waitcnt vmcnt(0) lgkmcnt(0)\n\ts_barrier" ::: "memory")
__device__ __forceinline__ void cmask(f32x16& p0, f32x16& p1, int jb, int qrel, int hi) {
    const float NEG = -INFINITY; const int qh = qrel - 4 * hi - 64 * jb;
#pragma unroll
    for (int r = 0; r < 16; ++r) { const int c = (r & 3) + 8 * (r >> 2); if (c > qh) p0[r] = NEG; if (c + 32 > qh) p1[r] = NEG; }
}
template <int ND> __device__ __forceinline__ void qkt(f32x16& p0, f32x16& p1, lds_cptr kb, const bf16x8* qr) {
    f32x16 z0 = {}, z1 = {};
#pragma unroll
    for (int d0 = 0; d0 < ND; ++d0) {
        const bf16x8 b0 = *(const LAS bf16x8*)(kb + d0 * 2048), b1 = *(const LAS bf16x8*)(kb + d0 * 2048 + 512);
        z0 = __builtin_amdgcn_mfma_f32_32x32x16_bf16(b0, qr[d0], z0, 0, 0, 0); z1 = __builtin_amdgcn_mfma_f32_32x32x16_bf16(b1, qr[d0], z1, 0, 0, 0); }
    p0 = z0; p1 = z1;
}
__device__ __forceinline__ float rowmax(const f32x16& p0, const f32x16& p1) {
    float a = fmaxf(p0[0], p1[0]);
#pragma unroll
    for (int r = 1; r < 16; ++r) a = fmaxf(a, fmaxf(p0[r], p1[r]));
    auto rr = __builtin_amdgcn_permlane32_swap(__float_as_uint(a), __float_as_uint(a), false, false);
    return fmaxf(__uint_as_float(rr[0]), __uint_as_float(rr[1]));
}
__device__ __forceinline__ void pv(f32x16* o, int vb, bf16x8 pa0, bf16x8 pa1, bf16x8 pa2, bf16x8 pa3) {
#pragma unroll
    for (int d0 = 0; d0 < 2; ++d0) { s16x4 lo[4], hi[4];
#pragma unroll
        for (int ks = 0; ks < 4; ++ks) {
            asm volatile("ds_read_b64_tr_b16 %0,%1 offset:%c2" : "=&v"(lo[ks]) : "v"(vb), "i"(d0 * 4096 + ks * 1024) : "memory");
            asm volatile("ds_read_b64_tr_b16 %0,%1 offset:%c2" : "=&v"(hi[ks]) : "v"(vb), "i"(d0 * 4096 + ks * 1024 + 512) : "memory"); }
        asm volatile("s_waitcnt lgkmcnt(0)" ::: "memory"); __builtin_amdgcn_sched_barrier(0);
#define AT_PK(k) (bf16x8){lo[k][0], lo[k][1], lo[k][2], lo[k][3], hi[k][0], hi[k][1], hi[k][2], hi[k][3]}
        o[d0] = __builtin_amdgcn_mfma_f32_32x32x16_bf16(pa0, AT_PK(0), o[d0], 0, 0, 0);
        o[d0] = __builtin_amdgcn_mfma_f32_32x32x16_bf16(pa1, AT_PK(1), o[d0], 0, 0, 0);
        o[d0] = __builtin_amdgcn_mfma_f32_32x32x16_bf16(pa2, AT_PK(2), o[d0], 0, 0, 0);
        o[d0] = __builtin_amdgcn_mfma_f32_32x32x16_bf16(pa3, AT_PK(3), o[d0], 0, 0, 0);
#undef AT_PK
    }
}
struct MobaX { const unsigned* SELh; const unsigned short* lst; int lcnt, ltile; bf16* PO; float* PML; long qh0; };
template <int DQ, int MODE>
__device__ __forceinline__ void attn_unit(int qb, const bf16* Qh, int qp, const bf16* Kh, int kp, const bf16* Krh, const bf16* Vh, int vp, bf16* Oh, int op, const MobaX X, LAS char* shm, const int wave) {
    constexpr int ND = DQ / 16;
    const int lane = lane_id(), r32 = lane & 31, hi = lane >> 5; const int wid = wave;
    const int q0 = qb * QB;
    const int t0 = (MODE == 0) ? 0 : 4 * qb, NT = (MODE == 0) ? 4 * qb + 4 : 4;
    int srow = q0 + wid * QBLK + r32; bool valid = true;
    if (MODE == 2) { const int li = X.ltile * 256 + wid * QBLK + r32; valid = li < X.lcnt; srow = (int)X.lst[valid ? li : X.lcnt - 1]; }
    const unsigned lds0 = (unsigned)(uintptr_t)shm;
    LAS float* wsf = (LAS float*)(shm + LDS_WS) + wid * 64;
    const bf16* ksrc = Kh + (size_t)lane * kp + wid * 8;
    const bf16* krsrc = (DQ == 96) ? (Krh + (size_t)lane * 32 + (wid & 3) * 8) : nullptr;
    const bf16* vsrc = Vh + (size_t)(16 * (wid & 3) + (lane >> 2)) * vp + (wid >> 2) * 32 + (lane & 3) * 8;
    const unsigned kdst = lds0 + LDS_K + wid * 1024, krdst = lds0 + LDS_K + (8 + (wid & 3)) * 1024, vdst = lds0 + LDS_V + wid * 1024;
#define AT_DMA(t, s) do { glds16(ksrc + (size_t)(t0 + (t)) * KVBLK * kp, (unsigned)__builtin_amdgcn_readfirstlane(kdst + (s) * KSLOT)); \
        if (DQ == 96 && wid < 4) glds16(krsrc + (size_t)(t0 + (t)) * KVBLK * 32, (unsigned)__builtin_amdgcn_readfirstlane(krdst + (s) * KSLOT)); \
        glds16(vsrc + (size_t)(t0 + (t)) * KVBLK * vp, (unsigned)__builtin_amdgcn_readfirstlane(vdst + (s) * VSLOT)); } while (0)
    const int vb0 = (int)(lds0 + LDS_V) + ((lane >> 4) & 1) * 32 + (lane & 3) * 8 + (4 * hi + ((lane & 15) >> 2)) * 64;
    const lds_cptr kp0 = (lds_cptr)shm + LDS_K + hi * 1024 + r32 * 16;
    AT_DMA(0, 0);
    bf16x8 qr[ND];
#pragma unroll
    for (int d0 = 0; d0 < ND; ++d0) qr[d0] = *(const bf16x8*)(Qh + (size_t)srow * qp + d0 * 16 + hi * 8);
    float mrow = -1e30f, l_reg = 0.f; f32x16 o[2]; o[0] = f32x16{}; o[1] = f32x16{};
    const int qrel = wid * QBLK + r32;
    for (int t = 0; t < NT; ++t) {
        AT_WAIT_BAR0();
        const int sl = t & 1;
        if (t + 1 < NT) AT_DMA(t + 1, sl ^ 1);
        f32x16 p0, p1; qkt<ND>(p0, p1, kp0 + sl * KSLOT, qr);
        if (MODE != 2) { if (t >= NT - 4) cmask(p0, p1, t - (NT - 4), qrel, hi); }
        const float rm = rowmax(p0, p1);
        const float mnew = fmaxf(mrow, rm); const float alpha = __builtin_amdgcn_exp2f(mrow - mnew); mrow = mnew;
        float s = 0.f;
#pragma unroll
        for (int r = 0; r < 16; ++r) { p0[r] = __builtin_amdgcn_exp2f(p0[r] - mnew); p1[r] = __builtin_amdgcn_exp2f(p1[r] - mnew); s += p0[r] + p1[r]; }
        l_reg = l_reg * alpha + s;
        if (__any(alpha != 1.f)) {
            if (hi == 0) wsf[r32] = alpha;
            asm volatile("s_waitcnt lgkmcnt(0)" ::: "memory");
#pragma unroll
            for (int r = 0; r < 16; ++r) { const float a = wsf[crow(r, hi)]; o[0][r] *= a; o[1][r] *= a; }
        }
        v4u pw0, pw1, pw2, pw3;
        pw0 = (v4u){cvt_pk_bf16(p0[0], p0[1]), cvt_pk_bf16(p0[2], p0[3]), cvt_pk_bf16(p0[4], p0[5]), cvt_pk_bf16(p0[6], p0[7])};
        pw1 = (v4u){cvt_pk_bf16(p0[8], p0[9]), cvt_pk_bf16(p0[10], p0[11]), cvt_pk_bf16(p0[12], p0[13]), cvt_pk_bf16(p0[14], p0[15])};
        pw2 = (v4u){cvt_pk_bf16(p1[0], p1[1]), cvt_pk_bf16(p1[2], p1[3]), cvt_pk_bf16(p1[4], p1[5]), cvt_pk_bf16(p1[6], p1[7])};
        pw3 = (v4u){cvt_pk_bf16(p1[8], p1[9]), cvt_pk_bf16(p1[10], p1[11]), cvt_pk_bf16(p1[12], p1[13]), cvt_pk_bf16(p1[14], p1[15])};
        pv(o, vb0 + sl * VSLOT, __builtin_bit_cast(bf16x8, pw0), __builtin_bit_cast(bf16x8, pw1), __builtin_bit_cast(bf16x8, pw2), __builtin_bit_cast(bf16x8, pw3));
    }
    { auto rr = __builtin_amdgcn_permlane32_swap(__float_as_uint(l_reg), __float_as_uint(l_reg), false, false); l_reg = __uint_as_float(rr[0]) + __uint_as_float(rr[1]); }
    LAS int* wsi = (LAS int*)wsf;
    if (hi == 0) { wsf[32 + r32] = l_reg;
        if (MODE == 1) wsf[r32] = mrow;
        if (MODE == 2) { const unsigned sel = X.SELh[srow]; const int rank = __builtin_popcount(sel & ((1u << qb) - 1u)); const long pidx = (X.qh0 + (long)srow) * 3 + rank;
            wsi[r32] = valid ? (int)pidx : -1; if (valid) { X.PML[pidx * 2] = mrow; X.PML[pidx * 2 + 1] = l_reg; } } }
    asm volatile("s_waitcnt lgkmcnt(0)" ::: "memory");
    float rli[16];
#pragma unroll
    for (int r = 0; r < 16; ++r) rli[r] = 1.f / wsf[32 + crow(r, hi)];
    { LAS bf16* stg = (LAS bf16*)(shm + LDS_OST) + wid * 2048;
#pragma unroll
      for (int r = 0; r < 16; ++r) { const int orow = crow(r, hi);
#pragma unroll
        for (int d0 = 0; d0 < 2; ++d0) stg[orow * 64 + d0 * 32 + r32] = (bf16)f2bf(o[d0][r] * rli[r]); }
      asm volatile("s_waitcnt lgkmcnt(0)" ::: "memory");
#pragma unroll
      for (int i = 0; i < 4; ++i) { const int row = i * 8 + (lane >> 3), ch = lane & 7; const v4u v = *(const LAS v4u*)(stg + row * 64 + ch * 8);
          if (MODE == 0) { *(v4u*)(Oh + (size_t)(q0 + wid * QBLK + row) * op + ch * 8) = v; }
          else if (MODE == 2) { const int pid = wsi[row]; if (pid >= 0) *(v4u*)(X.PO + (size_t)pid * 64 + ch * 8) = v; }
          else { const int sq = q0 + wid * QBLK + row; const long qh = X.qh0 + (long)sq; const unsigned sel = X.SELh[sq]; const int np = __builtin_popcount(sel);
              const float m0 = wsf[row], l0 = wsf[32 + row];
              float mi[3], li[3]; v4u oi[3]; float mmax = m0;
#pragma unroll
              for (int k = 0; k < 3; ++k) { mi[k] = -1e30f; li[k] = 0.f; oi[k] = (v4u){0u, 0u, 0u, 0u};
                  if (k < np) { mi[k] = X.PML[(qh * 3 + k) * 2]; li[k] = X.PML[(qh * 3 + k) * 2 + 1]; oi[k] = *(const v4u*)(X.PO + (size_t)(qh * 3 + k) * 64 + ch * 8); }
                  mmax = fmaxf(mmax, mi[k]); }
              const float w0 = l0 * __builtin_amdgcn_exp2f(m0 - mmax); float wk[3], wsum = w0;
#pragma unroll
              for (int k = 0; k < 3; ++k) { wk[k] = li[k] * __builtin_amdgcn_exp2f(mi[k] - mmax); wsum += wk[k]; }
              const float inv = 1.f / wsum;
              float r8[8] = {bflo(v.x), bfhi(v.x), bflo(v.y), bfhi(v.y), bflo(v.z), bfhi(v.z), bflo(v.w), bfhi(v.w)};
#pragma unroll
              for (int e = 0; e < 8; ++e) r8[e] *= w0;
#pragma unroll
              for (int k = 0; k < 3; ++k) { const v4u u = oi[k]; r8[0] += wk[k] * bflo(u.x); r8[1] += wk[k] * bfhi(u.x); r8[2] += wk[k] * bflo(u.y); r8[3] += wk[k] * bfhi(u.y);
                  r8[4] += wk[k] * bflo(u.z); r8[5] += wk[k] * bfhi(u.z); r8[6] += wk[k] * bflo(u.w); r8[7] += wk[k] * bfhi(u.w); }
              v4u w; w.x = cvt_pk_bf16(r8[0] * inv, r8[1] * inv); w.y = cvt_pk_bf16(r8[2] * inv, r8[3] * inv); w.z = cvt_pk_bf16(r8[4] * inv, r8[5] * inv); w.w = cvt_pk_bf16(r8[6] * inv, r8[7] * inv);
              *(v4u*)(Oh + (size_t)sq * op + ch * 8) = w; } } }
    asm volatile("s_waitcnt lgkmcnt(0)\n\ts_barrier" ::: "memory");
#undef AT_DMA
}
constexpr int MB_K = 0, MB_V = 32768, MB_WS = 65536, MB_OST = MB_WS + NW * 256, MB_TOTAL = MB_OST + NW * 4096;
template <int TOFF>
__device__ __forceinline__ void pv4(f32x16 (&o)[2][2], int vb, const v4u p0, const v4u p1, const v4u p2, const v4u p3) {
#pragma unroll
    for (int d0 = 0; d0 < 2; ++d0) { s16x4 lo[4], hh[4];
#pragma unroll
        for (int ks = 0; ks < 4; ++ks) {
            asm volatile("ds_read_b64_tr_b16 %0,%1 offset:%c2" : "=&v"(lo[ks]) : "v"(vb), "i"(TOFF + d0 * 4096 + ks * 1024) : "memory");
            asm volatile("ds_read_b64_tr_b16 %0,%1 offset:%c2" : "=&v"(hh[ks]) : "v"(vb), "i"(TOFF + d0 * 4096 + ks * 1024 + 512) : "memory"); }
        asm volatile("s_waitcnt lgkmcnt(0)" ::: "memory"); __builtin_amdgcn_sched_barrier(0);
#define AT_PK(k) (bf16x8){lo[k][0], lo[k][1], lo[k][2], lo[k][3], hh[k][0], hh[k][1], hh[k][2], hh[k][3]}
        if (MOBA_PRIO & 2) __builtin_amdgcn_s_setprio(1);
        o[d0][0] = __builtin_amdgcn_mfma_f32_32x32x16_bf16(__builtin_bit_cast(bf16x8, p0), AT_PK(0), o[d0][0], 0, 0, 0);
        o[d0][1] = __builtin_amdgcn_mfma_f32_32x32x16_bf16(__builtin_bit_cast(bf16x8, p1), AT_PK(1), o[d0][1], 0, 0, 0);
        o[d0][0] = __builtin_amdgcn_mfma_f32_32x32x16_bf16(__builtin_bit_cast(bf16x8, p2), AT_PK(2), o[d0][0], 0, 0, 0);
        o[d0][1] = __builtin_amdgcn_mfma_f32_32x32x16_bf16(__builtin_bit_cast(bf16x8, p3), AT_PK(3), o[d0][1], 0, 0, 0);
        if (MOBA_PRIO & 2) __builtin_amdgcn_s_setprio(0);
#undef AT_PK
    }
}
template <int T>
__device__ __forceinline__ void mb_tile_qk(f32x16& P0, f32x16& P1, lds_cptr kp0, const bf16x8* qr, int tmax) {
    if (T <= tmax) { f32x16 z0 = {}, z1 = {}; if (MOBA_PRIO & 1) __builtin_amdgcn_s_setprio(1);
#pragma unroll
        for (int d0 = 0; d0 < 4; ++d0) { const bf16x8 b0 = *(const LAS bf16x8*)(kp0 + T * 8192 + d0 * 2048), b1 = *(const LAS bf16x8*)(kp0 + T * 8192 + d0 * 2048 + 512);
            z0 = __builtin_amdgcn_mfma_f32_32x32x16_bf16(b0, qr[d0], z0, 0, 0, 0); z1 = __builtin_amdgcn_mfma_f32_32x32x16_bf16(b1, qr[d0], z1, 0, 0, 0); }
        if (MOBA_PRIO & 1) __builtin_amdgcn_s_setprio(0); P0 = z0; P1 = z1;
    } else {
#pragma unroll
        for (int r = 0; r < 16; ++r) { P0[r] = -INFINITY; P1[r] = -INFINITY; } }
}
__device__ __forceinline__ void mb_exp_pack(const f32x16& Pt, float mx, float& l, v4u& w0, v4u& w1) {
    f32x16 e;
#pragma unroll
    for (int r = 0; r < 16; ++r) { e[r] = __builtin_amdgcn_exp2f(Pt[r] - mx); l += e[r]; }
    w0 = (v4u){cvt_pk_bf16(e[0], e[1]), cvt_pk_bf16(e[2], e[3]), cvt_pk_bf16(e[4], e[5]), cvt_pk_bf16(e[6], e[7])};
    w1 = (v4u){cvt_pk_bf16(e[8], e[9]), cvt_pk_bf16(e[10], e[11]), cvt_pk_bf16(e[12], e[13]), cvt_pk_bf16(e[14], e[15])};
}
__device__ __forceinline__ void moba_block(int jb, const bf16* Qh, const bf16* Kh, const bf16* Vh, const MobaX X, int g0, int g1, bool own, LAS char* shm, const int wave) {
    constexpr int qp = 512, kp = 512, vp = 512;
    const int lane = lane_id(), r32 = lane & 31, hi = lane >> 5; const int wid = wave;
    const unsigned lds0 = (unsigned)(uintptr_t)shm;
    LAS float* wsf = (LAS float*)(shm + MB_WS) + wid * 64;
    { const unsigned kvo = (unsigned)(lane * kp * 2 + wid * 16), vvo = (unsigned)((16 * (wid & 3) + (lane >> 2)) * vp * 2 + (wid >> 2) * 64 + (lane & 3) * 16);
      const char* kbase = (const char*)(Kh + (size_t)jb * 256 * kp); const char* vbase = (const char*)(Vh + (size_t)jb * 256 * vp);
#pragma unroll
      for (int t = 0; t < 4; ++t) { glds16s(kbase + (size_t)t * (KVBLK * kp * 2), kvo, (unsigned)__builtin_amdgcn_readfirstlane(lds0 + MB_K + t * 8192 + wid * 1024));
          glds16s(vbase + (size_t)t * (KVBLK * vp * 2), vvo, (unsigned)__builtin_amdgcn_readfirstlane(lds0 + MB_V + t * 8192 + wid * 1024)); } }
    const int vb0 = (int)(lds0 + MB_V) + ((lane >> 4) & 1) * 32 + (lane & 3) * 8 + (4 * hi + ((lane & 15) >> 2)) * 64;
    const lds_cptr kp0 = (lds_cptr)shm + MB_K + hi * 1024 + r32 * 16;
    int gi = g0 + wid; int srow = 0, srowN = 0; bool valid = true, validN = true; unsigned sel = 0u; bf16x8 qr[4];
#define MB_ROWS(dst, vdst, g_) do { const int li = (g_) * 32 + r32; vdst = li < X.lcnt; dst = (int)X.lst[vdst ? li : X.lcnt - 1]; } while (0)
#define MB_QLOAD(src) do { _Pragma("unroll") for (int d0 = 0; d0 < 4; ++d0) qr[d0] = *(const bf16x8*)(Qh + (size_t)(src) * qp + d0 * 16 + hi * 8); sel = X.SELh[src]; } while (0)
#define MB_OWNROW() do { srow = jb * 256 + wid * 32 + r32; valid = true; MB_QLOAD(srow); } while (0)
    if (gi < g1) { MB_ROWS(srow, valid, gi); if (gi + NW < g1) MB_ROWS(srowN, validN, gi + NW); MB_QLOAD(srow); } else if (own) MB_OWNROW();
    AT_WAIT_BAR0();
#define MB_GROUP(OWN) do { \
        const int tmax = (OWN) ? (wid >> 1) : 3; \
        const int csrow = srow; const bool cvalid = valid; const unsigned csel = sel; \
        f32x16 P0, P1, P2, P3, P4, P5, P6, P7; \
        mb_tile_qk<0>(P0, P1, kp0, qr, tmax); mb_tile_qk<1>(P2, P3, kp0, qr, tmax); mb_tile_qk<2>(P4, P5, kp0, qr, tmax); mb_tile_qk<3>(P6, P7, kp0, qr, tmax); \
        if (!(OWN)) { const int gn = gi + NW; if (gn < g1) { srow = srowN; valid = validN; MB_QLOAD(srow); if (gn + NW < g1) MB_ROWS(srowN, validN, gn + NW); } else if (own) MB_OWNROW(); } \
        if (OWN) { const int qrel = wid * 32 + r32; \
            if (tmax == 0) cmask(P0, P1, 0, qrel, hi); else if (tmax == 1) cmask(P2, P3, 1, qrel, hi); else if (tmax == 2) cmask(P4, P5, 2, qrel, hi); else cmask(P6, P7, 3, qrel, hi); } \
        float mx = -INFINITY; \
        _Pragma("unroll") for (int r = 0; r < 16; ++r) { mx = fmaxf(mx, fmaxf(fmaxf(P0[r], P1[r]), fmaxf(P2[r], P3[r]))); mx = fmaxf(mx, fmaxf(fmaxf(P4[r], P5[r]), fmaxf(P6[r], P7[r]))); } \
        { auto rr = __builtin_amdgcn_permlane32_swap(__float_as_uint(mx), __float_as_uint(mx), false, false); mx = fmaxf(__uint_as_float(rr[0]), __uint_as_float(rr[1])); } \
        float l_reg = 0.f; v4u w0, w1, w2, w3, w4, w5, w6, w7, w8, w9, w10, w11, w12, w13, w14, w15; \
        f32x16 o[2][2]; o[0][0] = f32x16{}; o[0][1] = f32x16{}; o[1][0] = f32x16{}; o[1][1] = f32x16{}; \
        mb_exp_pack(P0, mx, l_reg, w0, w1); mb_exp_pack(P1, mx, l_reg, w2, w3); \
        pv4<0>(o, vb0, w0, w1, w2, w3); \
        if (tmax >= 1) { mb_exp_pack(P2, mx, l_reg, w4, w5); mb_exp_pack(P3, mx, l_reg, w6, w7); pv4<8192>(o, vb0, w4, w5, w6, w7); } \
        if (tmax >= 2) { mb_exp_pack(P4, mx, l_reg, w8, w9); mb_exp_pack(P5, mx, l_reg, w10, w11); pv4<16384>(o, vb0, w8, w9, w10, w11); } \
        if (tmax >= 3) { mb_exp_pack(P6, mx, l_reg, w12, w13); mb_exp_pack(P7, mx, l_reg, w14, w15); pv4<24576>(o, vb0, w12, w13, w14, w15); } \
        { auto rr = __builtin_amdgcn_permlane32_swap(__float_as_uint(l_reg), __float_as_uint(l_reg), false, false); l_reg = __uint_as_float(rr[0]) + __uint_as_float(rr[1]); } \
        LAS int* wsi = (LAS int*)wsf; \
        if (hi == 0) { wsf[32 + r32] = l_reg; \
            const int rank = (OWN) ? 3 : __builtin_popcount(csel & ((1u << jb) - 1u)); const long pidx = (X.qh0 + (long)csrow) * 4 + rank; \
            wsi[r32] = cvalid ? (int)pidx : -1; if (cvalid) { X.PML[pidx * 2] = mx; X.PML[pidx * 2 + 1] = l_reg; } } \
        asm volatile("s_waitcnt lgkmcnt(0)" ::: "memory"); \
        float rli[16]; \
        _Pragma("unroll") for (int r = 0; r < 16; ++r) rli[r] = __builtin_amdgcn_rcpf(wsf[32 + crow(r, hi)]); \
        { unsigned stgb = (unsigned)(uintptr_t)(shm + MB_OST) + wid * 4096 + hi * 512 + r32 * 2; asm volatile("" : "+v"(stgb)); \
          LAS bf16* stg = (LAS bf16*)(shm + MB_OST) + wid * 2048; \
          _Pragma("unroll") for (int r = 0; r < 16; ++r) { \
            _Pragma("unroll") for (int d0 = 0; d0 < 2; ++d0) *(LAS bf16*)(uintptr_t)(stgb + ((r & 3) + 8 * (r >> 2)) * 128 + d0 * 64) = (bf16)f2bf((o[d0][0][r] + o[d0][1][r]) * rli[r]); } \
          asm volatile("s_waitcnt lgkmcnt(0)" ::: "memory"); \
          _Pragma("unroll") for (int i = 0; i < 4; ++i) { const int row = i * 8 + (lane >> 3), ch = lane & 7; const v4u v = *(const LAS v4u*)(stg + row * 64 + ch * 8); \
              const int pid = wsi[row]; if (pid >= 0) *(v4u*)(X.PO + (size_t)pid * 64 + ch * 8) = v; } \
          asm volatile("s_waitcnt lgkmcnt(0)" ::: "memory"); } \
    } while (0)
#pragma unroll 1
    for (; gi < g1; gi += NW) { MB_GROUP(0); }
    if (own) { MB_GROUP(1); }
#undef MB_GROUP
#undef MB_OWNROW
    asm volatile("s_waitcnt lgkmcnt(0)\n\ts_barrier" ::: "memory");
#undef MB_ROWS
#undef MB_QLOAD
}
}


namespace atm {
using at::crow; using at::glds16; using at::lds_cptr;
constexpr int NW = 8, QBLK = 32, QB = 256, KVBLK = 64, ND = 6;
constexpr int KSL = 12288, VSL = 8192;
constexpr int LDS_K = 0, LDS_V = 3 * KSL, LDS_WS = LDS_V + 3 * VSL, LDS_OST = LDS_WS + NW * 64 * 4, LDS_TOTAL = LDS_OST + NW * 4096;
#define ATM_SBAR() __builtin_amdgcn_sched_barrier(0)
#define ATM_WAIT_BAR(N) asm volatile("s_waitcnt vmcnt(" #N ") lgkmcnt(0)\n\ts_barrier" ::: "memory")
#define ATM_MFMA(a, b, c) __builtin_amdgcn_mfma_f32_32x32x16_bf16(a, b, c, 0, 0, 0)
__device__ __forceinline__ void cmask(f32x16& p0, f32x16& p1, int jb, int qrel, int hi) {
    const float NEG = -INFINITY; const int qh = qrel - 4 * hi - 64 * jb;
#pragma unroll
    for (int r = 0; r < 16; ++r) { const int c = (r & 3) + 8 * (r >> 2); if (c > qh) p0[r] = NEG; if (c + 32 > qh) p1[r] = NEG; }
}
__device__ __forceinline__ void kload2(bf16x8* kf, lds_cptr kp, int j) { kf[2 * j] = *(const LAS bf16x8*)(kp + j * 2048); kf[2 * j + 1] = *(const LAS bf16x8*)(kp + j * 2048 + 512); }
typedef short v4i16_t __attribute__((ext_vector_type(4)));
__device__ __forceinline__ s16x4 vtr(lds_cptr p) { return __builtin_bit_cast(s16x4, __builtin_amdgcn_ds_read_tr16_b64_v4i16((LAS v4i16_t*)p)); }
__device__ __forceinline__ unsigned cvtpk_s(float lo, float hi) { typedef float f2 __attribute__((ext_vector_type(2))); typedef __bf16 b2 __attribute__((ext_vector_type(2))); f2 v = {lo, hi}; b2 b = __builtin_convertvector(v, b2); return __builtin_bit_cast(unsigned, b); }
template <int THRL>
__device__ __forceinline__ void attn_unit_mla(int qb, const bf16* Qh, const bf16* Kh, const bf16* Krh, const bf16* Vh, bf16* Oh, LAS char* shm, const int wave) {
    constexpr int QP = QL, KP = DM, VP = DM, OP = DM;
    const int lane = lane_id(), r32 = lane & 31, hi = lane >> 5; const int wid = wave;
    const int q0 = qb * QB;
    const bf16* Qw = Qh + (size_t)(q0 + wid * QBLK) * QP;
    const unsigned lds0 = (unsigned)(uintptr_t)shm;
    LAS float* wsf = (LAS float*)(shm + LDS_WS) + wid * 64;
    const unsigned kvo = (unsigned)(lane * KP * 2 + wid * 16), krvo = (unsigned)(lane * 64 + (wid & 3) * 16), vvo = (unsigned)((16 * (wid & 3) + (lane >> 2)) * VP * 2 + (wid >> 2) * 64 + (lane & 3) * 16);
    const char* kbase = (const char*)Kh; const char* krbase = (const char*)Krh; const char* vbase = (const char*)Vh;
    const unsigned kdst = lds0 + LDS_K + wid * 1024, krdst = lds0 + LDS_K + (8 + (wid & 3)) * 1024, vdst = lds0 + LDS_V + wid * 1024;
#define DMA_K(t, sidx) do { at::glds16s(kbase + (size_t)(t) * (KVBLK * KP * 2), kvo, (unsigned)__builtin_amdgcn_readfirstlane(kdst + (sidx) * KSL)); at::glds16s(krbase + (size_t)(t) * (KVBLK * 64), krvo, (unsigned)__builtin_amdgcn_readfirstlane(krdst + (sidx) * KSL)); } while (0)
#define DMA_V(t, sidx) at::glds16s(vbase + (size_t)(t) * (KVBLK * VP * 2), vvo, (unsigned)__builtin_amdgcn_readfirstlane(vdst + (sidx) * VSL))
    const int vb0 = (int)(lds0 + LDS_V) + ((lane >> 4) & 1) * 32 + (lane & 3) * 8 + (4 * hi + ((lane & 15) >> 2)) * 64;
    bf16x8 kf[12];
    const lds_cptr shm3 = (lds_cptr)shm; const lds_cptr kp0 = shm3 + LDS_K + hi * 1024 + r32 * 16; const lds_cptr vp0 = shm3 + LDS_V + ((lane >> 4) & 1) * 32 + (lane & 3) * 8 + (4 * hi + ((lane & 15) >> 2)) * 64;
    const int NT = (q0 + QB) / KVBLK;
    DMA_K(0, 0); DMA_V(0, 0); DMA_K(1, 1);
    bf16x8 qr[ND];
#pragma unroll
    for (int d0 = 0; d0 < ND; ++d0) qr[d0] = *(const bf16x8*)(Qw + (size_t)r32 * QP + d0 * 16 + hi * 8);
    float mhat = 0.f, l_reg = 0.f; f32x16 o[2]; o[0] = f32x16{}; o[1] = f32x16{}; f32x16 negm = f32x16{};
    const int qrel = wid * QBLK + r32;
#define CMASK(P0, P1, t) do { int jb_ = (t) - (NT - 4); if (jb_ >= 0) cmask(P0, P1, jb_, qrel, hi); } while (0)
    bool resc = false;
#define RESC() do { if (resc) { asm volatile("s_waitcnt lgkmcnt(0)" ::: "memory"); \
      _Pragma("unroll") for (int d_ = 0; d_ < 2; ++d_) _Pragma("unroll") for (int r = 0; r < 16; ++r) o[d_][r] *= wsf[crow(r, hi)]; } } while (0)
    f32x16 pA0, pA1, pB0, pB1;
    int sl_prev = 0, sl_cur = 0, sl_next = 1;
#define ROT() do { sl_prev = sl_cur; sl_cur = sl_next; sl_next = (sl_next == 2) ? 0 : sl_next + 1; } while (0)
    DMA_K(2, 2);
    ATM_WAIT_BAR(5);
    { const lds_cptr kb = kp0; f32x16 z0 = {}, z1 = {};
#pragma unroll
      for (int d0 = 0; d0 < ND; ++d0) { const bf16x8 b0 = *(const LAS bf16x8*)(kb + d0 * 2048), b1 = *(const LAS bf16x8*)(kb + d0 * 2048 + 512); z0 = ATM_MFMA(b0, qr[d0], z0); z1 = ATM_MFMA(b1, qr[d0], z1); }
      pA0 = z0; pA1 = z1; }
    CMASK(pA0, pA1, 0);
    { float a = fmaxf(pA0[0], pA1[0]);
#pragma unroll
      for (int r = 1; r < 16; ++r) a = fmaxf(a, fmaxf(pA0[r], pA1[r]));
      auto rr = __builtin_amdgcn_permlane32_swap(__float_as_uint(a), __float_as_uint(a), false, false); mhat = fmaxf(__uint_as_float(rr[0]), __uint_as_float(rr[1])); }
#pragma unroll
    for (int r = 0; r < 16; ++r) { pA0[r] = __builtin_amdgcn_exp2f(pA0[r] - mhat); pA1[r] = __builtin_amdgcn_exp2f(pA1[r] - mhat); }
#pragma unroll
    for (int r = 0; r < 16; ++r) negm[r] = -mhat;
    asm volatile("" : "+v"(negm));
    ATM_WAIT_BAR(0);
    DMA_K(3, 0); DMA_V(1, 1);
    ROT();
#pragma unroll
    for (int j = 0; j < 6; ++j) kload2(kf, kp0 + sl_cur * KSL, j);
    ATM_WAIT_BAR(3);
    s16x4 vAl, vAh, vBl, vBh; v4u pw0, pw1, pw2, pw3;
#define PKW(P, B) cvtpk_s(P[B], P[B + 1])
#define PAF(k) __builtin_bit_cast(bf16x8, pw##k)
#define FRA (bf16x8){vAl[0], vAl[1], vAl[2], vAl[3], vAh[0], vAh[1], vAh[2], vAh[3]}
#define FRB (bf16x8){vBl[0], vBl[1], vBl[2], vBl[3], vBh[0], vBh[1], vBh[2], vBh[3]}
#define PIN(x) asm volatile("" : "+v"(x))
#define MX3(a, b, c) __builtin_fmaxf(__builtin_fmaxf((a), (b)), (c))
#define GAPA(MF, A0, A1, A2, A3, W0, W1, PW) do { MF; sacc += A0; sacc += A1; sacc += A2; sacc += A3; PIN(sacc); W0; W1; PIN(PW); ATM_SBAR(); } while (0)
#define EX(v) __builtin_amdgcn_exp2f(v)
#define GAPB(MF, X, B) do { MF; X[B] = EX(X[B]); X[B + 1] = EX(X[B + 1]); X[B + 2] = EX(X[B + 2]); X[B + 3] = EX(X[B + 3]); PIN(X); ATM_SBAR(); } while (0)
#define VRDA(i) do { vAl = vtr(vp_ + (((i) >> 2) * 4096 + ((i) & 3) * 1024)); vAh = vtr(vp_ + (((i) >> 2) * 4096 + ((i) & 3) * 1024 + 512)); } while (0)
#define VRDB(i) do { vBl = vtr(vp_ + (((i) >> 2) * 4096 + ((i) & 3) * 1024)); vBh = vtr(vp_ + (((i) >> 2) * 4096 + ((i) & 3) * 1024 + 512)); } while (0)
#define KRD(G, j) do { if (G) { kload2(kf, kp0 + sl_next * KSL, j); } } while (0)
#define STEP(C0, C1, P0, P1, t, GK, GV, GL) do { ATM_SBAR(); if (MLA_PRIO & 1) __builtin_amdgcn_s_setprio(1); \
    const lds_cptr vp_ = vp0 + sl_prev * VSL; \
    float sacc = (P0[0] + P0[1]); \
    if (MLA_HEAD) { C0 = ATM_MFMA(kf[8], qr[4], negm); ATM_SBAR(); C1 = ATM_MFMA(kf[9], qr[4], negm); ATM_SBAR(); C0 = ATM_MFMA(kf[10], qr[5], C0); ATM_SBAR(); C1 = ATM_MFMA(kf[11], qr[5], C1); ATM_SBAR(); } \
    GAPA(C0 = ATM_MFMA(kf[0], qr[0], MLA_HEAD ? C0 : negm), P0[2], P0[3], P0[4], P0[5],     pw0[0] = PKW(P0, 0), pw0[1] = PKW(P0, 2), pw0); \
    GAPA(C1 = ATM_MFMA(kf[1], qr[0], MLA_HEAD ? C1 : negm), P0[6], P0[7], P0[8], P0[9],     pw0[2] = PKW(P0, 4), pw0[3] = PKW(P0, 6), pw0); \
    GAPA(C0 = ATM_MFMA(kf[2], qr[1], C0),   P0[10], P0[11], P0[12], P0[13], pw1[0] = PKW(P0, 8), pw1[1] = PKW(P0, 10), pw1); \
    GAPA(C1 = ATM_MFMA(kf[3], qr[1], C1),   P0[14], P0[15], P1[0], P1[1],   pw1[2] = PKW(P0, 12), pw1[3] = PKW(P0, 14), pw1); \
    GAPA(C0 = ATM_MFMA(kf[4], qr[2], C0),   P1[2], P1[3], P1[4], P1[5],     pw2[0] = PKW(P1, 0), pw2[1] = PKW(P1, 2), pw2); \
    GAPA(C1 = ATM_MFMA(kf[5], qr[2], C1),   P1[6], P1[7], P1[8], P1[9],     pw2[2] = PKW(P1, 4), pw2[3] = PKW(P1, 6), pw2); \
    GAPA(C0 = ATM_MFMA(kf[6], qr[3], C0),   P1[10], P1[11], P1[12], P1[13], pw3[0] = PKW(P1, 8), pw3[1] = PKW(P1, 10), pw3); \
    GAPA(C1 = ATM_MFMA(kf[7], qr[3], C1),   P1[14], P1[15], 0.f, 0.f,       pw3[2] = PKW(P1, 12), pw3[3] = PKW(P1, 14), pw3); \
    if (!MLA_HEAD) { C0 = ATM_MFMA(kf[8], qr[4], C0); ATM_SBAR(); C1 = ATM_MFMA(kf[9], qr[4], C1); ATM_SBAR(); C0 = ATM_MFMA(kf[10], qr[5], C0); ATM_SBAR(); C1 = ATM_MFMA(kf[11], qr[5], C1); } \
    VRDA(0); ATM_SBAR(); \
    if (MLA_PRIO & 1) __builtin_amdgcn_s_setprio(0); l_reg += sacc; \
    if (GK) { DMA_K((t) + 3, sl_cur); } if (GV) { DMA_V((t) + 1, sl_next); } \
    CMASK(C0, C1, t); \
    if (MLA_OVL) { \
        \
      VRDB(4); ATM_SBAR(); \
      o[0] = ATM_MFMA(PAF(0), FRA, o[0]); \
      float a = MX3(C0[0], C0[1], C1[0]), b = MX3(C0[2], C0[3], C1[1]); a = MX3(a, C1[2], C1[3]); a = MX3(a, C0[4], C0[5]); b = MX3(b, C0[6], C0[7]); a = MX3(a, C1[4], C1[5]); b = MX3(b, C1[6], C1[7]); a = MX3(a, C0[8], C0[9]); \
      PIN(a); PIN(b); KRD(GL, 0); VRDA(1); ATM_SBAR(); \
      o[1] = ATM_MFMA(PAF(0), FRB, o[1]); \
      b = MX3(b, C0[10], C0[11]); a = MX3(a, C1[8], C1[9]); b = MX3(b, C1[10], C1[11]); a = MX3(a, C0[12], C0[13]); b = MX3(b, C0[14], C0[15]); a = MX3(a, C1[12], C1[13]); b = MX3(b, C1[14], C1[15]); \
      float rm = __builtin_fmaxf(a, b); { auto rr = __builtin_amdgcn_permlane32_swap(__float_as_uint(rm), __float_as_uint(rm), false, false); rm = __builtin_fmaxf(__uint_as_float(rr[0]), __uint_as_float(rr[1])); } \
      resc = false; \
      if (__builtin_expect(__any(rm > (float)THRL), 0)) { const float dl = __builtin_fmaxf(rm, 0.f); mhat += dl; \
        _Pragma("unroll") for (int r = 0; r < 16; ++r) { C0[r] -= dl; C1[r] -= dl; } \
        _Pragma("unroll") for (int r = 0; r < 16; ++r) negm[r] = -mhat; asm volatile("" : "+v"(negm)); \
        const float f = __builtin_amdgcn_exp2f(-dl); l_reg *= f; if (hi == 0) wsf[r32] = f; resc = true; } \
      KRD(GL, 1); VRDB(5); ATM_SBAR(); \
      o[0] = ATM_MFMA(PAF(1), FRA, o[0]); C0[0] = EX(C0[0]); C0[1] = EX(C0[1]); C0[2] = EX(C0[2]); C0[3] = EX(C0[3]); C0[4] = EX(C0[4]); C0[5] = EX(C0[5]); PIN(C0); ATM_SBAR(); \
      KRD(GL, 2); VRDA(2); ATM_SBAR(); \
      o[1] = ATM_MFMA(PAF(1), FRB, o[1]); C0[6] = EX(C0[6]); C0[7] = EX(C0[7]); C0[8] = EX(C0[8]); C0[9] = EX(C0[9]); C0[10] = EX(C0[10]); C0[11] = EX(C0[11]); PIN(C0); ATM_SBAR(); \
      KRD(GL, 3); VRDB(6); ATM_SBAR(); \
      o[0] = ATM_MFMA(PAF(2), FRA, o[0]); C0[12] = EX(C0[12]); C0[13] = EX(C0[13]); C0[14] = EX(C0[14]); C0[15] = EX(C0[15]); C1[0] = EX(C1[0]); PIN(C0); PIN(C1); ATM_SBAR(); \
      KRD(GL, 4); VRDA(3); ATM_SBAR(); \
      o[1] = ATM_MFMA(PAF(2), FRB, o[1]); C1[1] = EX(C1[1]); C1[2] = EX(C1[2]); C1[3] = EX(C1[3]); C1[4] = EX(C1[4]); C1[5] = EX(C1[5]); PIN(C1); ATM_SBAR(); \
      KRD(GL, 5); VRDB(7); ATM_SBAR(); \
      o[0] = ATM_MFMA(PAF(3), FRA, o[0]); C1[6] = EX(C1[6]); C1[7] = EX(C1[7]); C1[8] = EX(C1[8]); C1[9] = EX(C1[9]); C1[10] = EX(C1[10]); PIN(C1); ATM_SBAR(); \
      o[1] = ATM_MFMA(PAF(3), FRB, o[1]); C1[11] = EX(C1[11]); C1[12] = EX(C1[12]); C1[13] = EX(C1[13]); C1[14] = EX(C1[14]); C1[15] = EX(C1[15]); PIN(C1); ATM_SBAR(); \
    } else { \
    { float a = MX3(C0[0], C0[1], C1[0]), b = MX3(C0[2], C0[3], C1[1]); a = MX3(a, C1[2], C1[3]); \
      _Pragma("unroll") for (int r = 4; r < 16; r += 4) { a = MX3(a, C0[r], C0[r + 1]); b = MX3(b, C0[r + 2], C0[r + 3]); a = MX3(a, C1[r], C1[r + 1]); b = MX3(b, C1[r + 2], C1[r + 3]); } \
      float rm = __builtin_fmaxf(a, b); { auto rr = __builtin_amdgcn_permlane32_swap(__float_as_uint(rm), __float_as_uint(rm), false, false); rm = __builtin_fmaxf(__uint_as_float(rr[0]), __uint_as_float(rr[1])); } \
      resc = false; \
      if (__builtin_expect(__any(rm > (float)THRL), 0)) { const float dl = __builtin_fmaxf(rm, 0.f); mhat += dl; \
        _Pragma("unroll") for (int r = 0; r < 16; ++r) { C0[r] -= dl; C1[r] -= dl; } \
        _Pragma("unroll") for (int r = 0; r < 16; ++r) negm[r] = -mhat; asm volatile("" : "+v"(negm)); \
        const float f = __builtin_amdgcn_exp2f(-dl); l_reg *= f; if (hi == 0) wsf[r32] = f; resc = true; } } \
    ATM_SBAR(); \
    if (MLA_PRIO & 2) __builtin_amdgcn_s_setprio(1); VRDB(4); ATM_SBAR(); GAPB(o[0] = ATM_MFMA(PAF(0), FRA, o[0]), C0, 0); \
    KRD(GL, 0); VRDA(1); ATM_SBAR(); GAPB(o[1] = ATM_MFMA(PAF(0), FRB, o[1]), C0, 4); \
    KRD(GL, 1); VRDB(5); ATM_SBAR(); GAPB(o[0] = ATM_MFMA(PAF(1), FRA, o[0]), C0, 8); \
    KRD(GL, 2); VRDA(2); ATM_SBAR(); GAPB(o[1] = ATM_MFMA(PAF(1), FRB, o[1]), C0, 12); \
    KRD(GL, 3); VRDB(6); ATM_SBAR(); GAPB(o[0] = ATM_MFMA(PAF(2), FRA, o[0]), C1, 0); \
    KRD(GL, 4); VRDA(3); ATM_SBAR(); GAPB(o[1] = ATM_MFMA(PAF(2), FRB, o[1]), C1, 4); \
    KRD(GL, 5); VRDB(7); ATM_SBAR(); GAPB(o[0] = ATM_MFMA(PAF(3), FRA, o[0]), C1, 8); \
    GAPB(o[1] = ATM_MFMA(PAF(3), FRB, o[1]), C1, 12); if (MLA_PRIO & 2) __builtin_amdgcn_s_setprio(0); \
    } \
    } while (0)
    if ((MLA_PRIO & 4) && wid >= 4) __builtin_amdgcn_s_setprio(1);
    int t = 1;
#undef CMASK
#define CMASK(P0, P1, t) do {} while (0)
    for (; t + 5 < NT; t += 2) {
        STEP(pB0, pB1, pA0, pA1, t, true, true, true);     ATM_WAIT_BAR(3); RESC(); ROT();
        STEP(pA0, pA1, pB0, pB1, t + 1, true, true, true); ATM_WAIT_BAR(3); RESC(); ROT();
    }
#undef CMASK
#define CMASK(P0, P1, t) do { int jb_ = (t) - (NT - 4); if (jb_ >= 0) cmask(P0, P1, jb_, qrel, hi); } while (0)
#define ENDW(tt) do { if ((tt) + 3 < NT) { ATM_WAIT_BAR(3); } else if ((tt) + 2 < NT) { ATM_WAIT_BAR(1); } else { ATM_WAIT_BAR(0); } } while (0)
    for (; t + 1 < NT; t += 2) {
        STEP(pB0, pB1, pA0, pA1, t, (t + 3 < NT), (t + 1 < NT), (t + 1 < NT));         ENDW(t);     RESC(); ROT();
        STEP(pA0, pA1, pB0, pB1, t + 1, (t + 4 < NT), (t + 2 < NT), (t + 2 < NT));     ENDW(t + 1); RESC(); ROT();
    }
    STEP(pB0, pB1, pA0, pA1, NT - 1, false, false, false); RESC();
    { float sacc = pB0[0] + pB0[1];
#pragma unroll
      for (int r = 2; r < 16; ++r) sacc += pB0[r];
#pragma unroll
      for (int r = 0; r < 16; ++r) sacc += pB1[r];
      l_reg += sacc;
      pw0 = (v4u){PKW(pB0, 0), PKW(pB0, 2), PKW(pB0, 4), PKW(pB0, 6)}; pw1 = (v4u){PKW(pB0, 8), PKW(pB0, 10), PKW(pB0, 12), PKW(pB0, 14)};
      pw2 = (v4u){PKW(pB1, 0), PKW(pB1, 2), PKW(pB1, 4), PKW(pB1, 6)}; pw3 = (v4u){PKW(pB1, 8), PKW(pB1, 10), PKW(pB1, 12), PKW(pB1, 14)};
      ATM_SBAR(); at::pv(o, vb0 + sl_cur * VSL, PAF(0), PAF(1), PAF(2), PAF(3)); }
#undef PKW
#undef PAF
#undef FRA
#undef FRB
#undef PIN
#undef MX3
#undef GAPA
#undef GAPB
#undef EX
#undef VRDA
#undef VRDB
#undef KRD
#undef STEP
#undef ENDW
    { auto rr = __builtin_amdgcn_permlane32_swap(__float_as_uint(l_reg), __float_as_uint(l_reg), false, false); l_reg = __uint_as_float(rr[0]) + __uint_as_float(rr[1]); }
    if (hi == 0) wsf[32 + r32] = l_reg;
    asm volatile("s_waitcnt lgkmcnt(0)" ::: "memory");
    float rli[16];
#pragma unroll
    for (int r = 0; r < 16; ++r) rli[r] = __builtin_amdgcn_rcpf(wsf[32 + crow(r, hi)]);
    bf16* Ow = Oh + (size_t)(q0 + wid * QBLK) * OP;
    { unsigned stgb = (unsigned)(uintptr_t)(shm + LDS_OST) + wid * 4096 + hi * 512 + r32 * 2; asm volatile("" : "+v"(stgb));
      LAS bf16* stg = (LAS bf16*)(shm + LDS_OST) + wid * 2048;
#pragma unroll
      for (int r = 0; r < 16; ++r) {
#pragma unroll
        for (int d0 = 0; d0 < 2; ++d0) *(LAS bf16*)(uintptr_t)(stgb + ((r & 3) + 8 * (r >> 2)) * 128 + d0 * 64) = (bf16)f2bf(o[d0][r] * rli[r]); }
      asm volatile("s_waitcnt lgkmcnt(0)" ::: "memory");
#pragma unroll
      for (int i = 0; i < 4; ++i) { const int row = i * 8 + (lane >> 3), ch = lane & 7; const v4u v = *(const LAS v4u*)(stg + row * 64 + ch * 8); *(v4u*)(Ow + (size_t)row * OP + ch * 8) = v; } }
    if (MLA_PRIO & 4) __builtin_amdgcn_s_setprio(0);
    asm volatile("s_waitcnt lgkmcnt(0)\n\ts_barrier" ::: "memory");
#undef DMA_K
#undef DMA_V
#undef CMASK
#undef RESC
#undef ROT
}
}

#define XB_TMO      128
#define XB_XCNT(j)  (256  + 64 * (j))
#define XB_XSUB(j)  (1280 + 64 * (j))
#define XB_XGEN(j)  (2304 + 64 * (j))
#define XB_TOP      3328
#define XB_TOPGEN   3392
#define XCD_BAR_WORDS 3456
#define XB_SPIN_CAP (1u << 18)
__device__ __forceinline__ unsigned xb_ld(unsigned* p)              { return __hip_atomic_load(p, __ATOMIC_RELAXED, __HIP_MEMORY_SCOPE_AGENT); }
__device__ __forceinline__ unsigned xb_add(unsigned* p, unsigned v) { return __hip_atomic_fetch_add(p, v, __ATOMIC_RELAXED, __HIP_MEMORY_SCOPE_AGENT); }
__device__ __forceinline__ unsigned xb_xcc_id() { return (unsigned)__builtin_amdgcn_s_getreg((3 << 11) | 20) & 0xFu; }
#define XB_SPIN(cond, bar) do { unsigned _sp = 0; while (cond) { __builtin_amdgcn_s_sleep(1); \
    if ((++_sp & 255u) == 0u) { if (xb_ld(&(bar)[XB_TMO])) break; if (_sp > XB_SPIN_CAP) { atomicAdd(&(bar)[XB_TMO], 1u); break; } } } } while (0)
struct XcdBarrier { unsigned* bar; unsigned x; volatile LAS unsigned* st; };
__device__ __forceinline__ XcdBarrier xcd_barrier_post(unsigned* bar, volatile LAS unsigned* st, const bool leader) {
    XcdBarrier b; b.bar = bar; b.x = xb_xcc_id(); b.st = st;
    if (leader) (void)xb_add(&bar[XB_XCNT(b.x)], 1u);
    return b;
}
__device__ __forceinline__ void xcd_barrier_complete(unsigned* bar, unsigned x, unsigned& nloc, unsigned& nx) {
    const unsigned G = gridDim.x * gridDim.y * gridDim.z;
    unsigned sum, cnt, mine, sp = 0u;
    for (;;) {
        sum = 0u; cnt = 0u; mine = 0u;
#pragma unroll
        for (unsigned j = 0; j < 16; ++j) { const unsigned c = xb_ld(&bar[XB_XCNT(j)]); sum += c; cnt += (c > 0u) ? 1u : 0u; mine = (j == x) ? c : mine; }
        if (sum == G) break;
        __builtin_amdgcn_s_sleep(1);
        if ((++sp & 255u) == 0u) { if (xb_ld(&bar[XB_TMO])) break; if (sp > XB_SPIN_CAP) { atomicAdd(&bar[XB_TMO], 1u); break; } }
    }
    nloc = mine > 0u ? mine : 1u; nx = cnt > 0u ? cnt : 1u;
}
__device__ __forceinline__ void xcd_barrier(const XcdBarrier& b, const bool leader) {
    asm volatile("s_waitcnt vmcnt(0)" ::: "memory");
    __syncthreads();
    if (leader) {
        unsigned* bar = b.bar;
        __builtin_amdgcn_s_waitcnt(0);
        unsigned nloc = b.st[0], nx = b.st[1];
        if (nloc == 0u) { xcd_barrier_complete(bar, b.x, nloc, nx); b.st[0] = nloc; b.st[1] = nx; }
        const unsigned old = xb_add(&bar[XB_XSUB(b.x)], 1u);
        const unsigned gen = old / nloc;
        if (old + 1u == (gen + 1u) * nloc) {
            __builtin_amdgcn_fence(__ATOMIC_RELEASE, "agent");
            asm volatile("s_waitcnt vmcnt(0)" ::: "memory");
            const unsigned og = xb_add(&bar[XB_TOP], 1u);
            const unsigned tg = og / nx;
            if (og + 1u == (tg + 1u) * nx) xb_add(&bar[XB_TOPGEN], 1u);
            else XB_SPIN(xb_ld(&bar[XB_TOPGEN]) == tg, bar);
            __builtin_amdgcn_fence(__ATOMIC_ACQUIRE, "agent");
            xb_add(&bar[XB_XGEN(b.x)], 1u);
            asm volatile("s_waitcnt vmcnt(0)" ::: "memory");
        } else {
            XB_SPIN(xb_ld(&bar[XB_XGEN(b.x)]) == gen, bar);
            __builtin_amdgcn_fence(__ATOMIC_ACQUIRE, "agent");
            asm volatile("s_waitcnt vmcnt(0)" ::: "memory");
        }
    }
    __syncthreads();
}

struct Args { const float* in[19]; float* out; unsigned char* ws; int ph_lo, ph_hi; };
struct Frame { LAS unsigned char* lds; volatile LAS unsigned* MISC; gu32* ctl; int tid, lane, wave, vcu, G; };
#define CAS __attribute__((address_space(4)))
__device__ __forceinline__ Args ld_args() {
    const CAS char* ka = (const CAS char*)__builtin_amdgcn_kernarg_segment_ptr(); asm volatile("" : "+s"(ka));
    Args a;
#pragma unroll
    for (int i = 0; i < 19; ++i) a.in[i] = *(const float* const CAS*)(ka + 8 * i);
    a.out = *(float* const CAS*)(ka + 152); a.ws = *(unsigned char* const CAS*)(ka + 160); a.ph_lo = *(const CAS int*)(ka + 168); a.ph_hi = *(const CAS int*)(ka + 172);
    return a;
}

__device__ __forceinline__ float wave_sum(float v) {
#pragma unroll
    for (int o = 1; o < 64; o <<= 1) v += __shfl_xor(v, o);
    return v;
}
__device__ const double REV_A[16] = {0.15915494309189535, 0.0700865215877985, 0.03086376340470123, 0.013591370636193905, 0.005985185712713705, 0.002635675898667414, 0.001160663641240061, 0.0005111175045375439,
    0.00022507907903927653, 9.911730936901935e-05, 4.364795279280289e-05, 1.9221100684944863e-05, 8.464330808241401e-06, 3.727408601915352e-06, 1.6414262627950345e-06, 7.228293068832865e-07};
__device__ const double REV_B[8] = {0.15915494309189535, 0.03086376340470123, 0.005985185712713705, 0.001160663641240061, 0.00022507907903927653, 4.364795279280289e-05, 8.464330808241401e-06, 1.6414262627950345e-06};

__device__ __forceinline__ void tr_item(const float* W, int N, int k0, int n0s, bf16* WT, int drow0, int ldk, int koff, const float* gain, int mode, LAS float* scr, int lane) {
    float w[32];
#pragma unroll
    for (int i = 0; i < 32; ++i) w[i] = W[(size_t)(k0 + 2 * i + (lane >> 5)) * N + n0s + (lane & 31)];
#pragma unroll
    for (int i = 0; i < 32; ++i) scr[(2 * i + (lane >> 5)) * 33 + (lane & 31)] = w[i];
    LDS_WAIT(); asm volatile("" ::: "memory");
    const int c = lane & 7;
    f32x4 g0 = (f32x4){1.f, 1.f, 1.f, 1.f}, g1 = g0;
    if (gain) { g0 = *(const f32x4*)(gain + k0 + 8 * c); g1 = *(const f32x4*)(gain + k0 + 8 * c + 4); }
#pragma unroll
    for (int j = 0; j < 4; ++j) { const int n = (lane >> 3) + 8 * j;
        int sn = n;
        if (mode == 1) sn = (n < 16) ? ((n & 1) ? (n >> 1) + 8 : (n >> 1)) : n;
        else if (mode == 2) sn = 4 * (n >> 3) + ((n & 7) >> 1) + 16 * (n & 1);
        const LAS float* s = scr + (8 * c) * 33 + sn;
        v4u o; o.x = pk2(s[0 * 33] * g0[0], s[1 * 33] * g0[1]); o.y = pk2(s[2 * 33] * g0[2], s[3 * 33] * g0[3]); o.z = pk2(s[4 * 33] * g1[0], s[5 * 33] * g1[1]); o.w = pk2(s[6 * 33] * g1[2], s[7 * 33] * g1[3]);
        *(GAS v4u*)(WT + (size_t)(drow0 + n) * ldk + koff + k0 + 8 * c) = o; }
    LDS_WAIT(); asm volatile("" ::: "memory");
}

__device__ __forceinline__ void p0_prologue(const Frame& F0, const Args& A) {
    Frame F = F0; F.lane = lane_id(); F.tid = F.wave * 64 + F.lane;
    unsigned char* ws = A.ws;
    LAS float* scr = (LAS float*)(F.lds + F.wave * 16384);
    const int gw = F.vcu * NWAVES + F.wave, NGW = F.G * NWAVES, lane = F.lane;
    bf16* Win = (bf16*)(ws + WS_WIN); bf16* Wuq = (bf16*)(ws + WS_WUQ); bf16* Wukv = (bf16*)(ws + WS_WUKV); bf16* Wo = (bf16*)(ws + WS_WO); bf16* Wout = (bf16*)(ws + WS_WOUT);
    bf16* Wgu = (bf16*)(ws + WS_WGU); bf16* Wd = (bf16*)(ws + WS_WD);
    constexpr int I_IN = 16 * 145, I_UQ = 12 * 24, I_UKV = 4 * 32, I_O = 8 * 32, I_OUT = 16 * 32, I_G = 32 * 128, I_D = 32 * 128;
    constexpr int NITEMS = I_IN + I_UQ + I_UKV + 2 * I_O + I_OUT + 2 * I_G + I_D;
    for (int it = gw; it < NITEMS; it += NGW) {
        int r = it;
        if (r < I_IN) { const int kb = r / 145, nb = r % 145, s0 = 32 * nb; int drow0, mode = 0;
            if (s0 < 1024) drow0 = s0;
            else if (s0 < 1056) { drow0 = 4608; mode = 2; }
            else if (s0 < 1568) { const int j = s0 - 1056; drow0 = 1024 + j; mode = ((j & 63) == 0) ? 1 : 0; }
            else if (s0 < 2080) { const int j = s0 - 1568; drow0 = 1536 + j; mode = ((j & 63) == 0) ? 1 : 0; }
            else if (s0 < 2592) drow0 = 2048 + (s0 - 2080);
            else if (s0 < 3616) { const int j = s0 - 2592; drow0 = 2560 + (j >> 7) * 256 + (j & 127); }
            else { const int j = s0 - 3616; drow0 = 2560 + (j >> 7) * 256 + 128 + (j & 127); }
            tr_item(A.in[2], 4640, 64 * kb, s0, Win, drow0, 1024, 0, nullptr, mode, scr, lane); continue; } r -= I_IN;
        if (r < I_UQ) { const int kb = r / 24, nb = r % 24; tr_item(A.in[4], 768, 64 * kb, 32 * nb, Wuq, 32 * nb, 768, 0, A.in[3], (nb % 3 == 2) ? 2 : 0, scr, lane); continue; } r -= I_UQ;
        if (r < I_UKV) { const int kb = r / 32, nb = r % 32; tr_item(A.in[6], 1024, 64 * kb, 32 * nb, Wukv, 32 * nb, 256, 0, A.in[5], 0, scr, lane); continue; } r -= I_UKV;
        if (r < I_O) { const int kb = r / 32, nb = r % 32; tr_item(A.in[7], 1024, 64 * kb, 32 * nb, Wo, 32 * nb, 1024, 0, nullptr, 0, scr, lane); continue; } r -= I_O;
        if (r < I_O) { const int kb = r / 32, nb = r % 32; tr_item(A.in[8], 1024, 64 * kb, 32 * nb, Wo, 32 * nb, 1024, 512, nullptr, 0, scr, lane); continue; } r -= I_O;
        if (r < I_OUT) { const int kb = r / 32, nb = r % 32; tr_item(A.in[9], 1024, 64 * kb, 32 * nb, Wout, 32 * nb, 1024, 0, nullptr, 0, scr, lane); continue; } r -= I_OUT;
        if (r < 2 * I_G) { const int up = r >= I_G; if (up) r -= I_G; const int e = r >> 7, q = r & 127, kb = q >> 3, nb = q & 7, s0 = 32 * nb;
            const int drow0 = e * 512 + (s0 >> 7) * 256 + up * 128 + (s0 & 127);
            tr_item(A.in[up ? 16 : 15] + (size_t)e * 1024 * 256, 256, 64 * kb, s0, Wgu, drow0, 1024, 0, A.in[10], 0, scr, lane); continue; } r -= 2 * I_G;
        { const int e = r >> 7, q = r & 127, kb = q >> 5, nb = q & 31;
            tr_item(A.in[17] + (size_t)e * 256 * 1024, 1024, 64 * kb, 32 * nb, Wd, e * 1024 + 32 * nb, 256, 0, nullptr, 0, scr, lane); }
    }
    { const int gt = F.vcu * 512 + F.tid, NT_ = F.G * 512; GAS v4u* z = (GAS v4u*)(Win + (size_t)4640 * 1024);
      for (int i = gt; i < 224 * 1024 / 8; i += NT_) z[i] = (v4u){0u, 0u, 0u, 0u}; }
    { const int gt = F.vcu * 512 + F.tid, NT_ = F.G * 512; float* CA = (float*)(ws + WS_COSA); float* SA_ = (float*)(ws + WS_SINA); float* CB = (float*)(ws + WS_COSB); float* SB_ = (float*)(ws + WS_SINB);
      for (int i = gt; i < SEQ * 24; i += NT_) { const int pos = i / 24, j = i % 24; const double rv = (double)pos * (j < 16 ? REV_A[j] : REV_B[j - 16]);
          const float fr = (float)(rv - __builtin_floor(rv)); const float c = __builtin_amdgcn_cosf(fr), s = __builtin_amdgcn_sinf(fr);
          if (j < 16) { CA[pos * 16 + j] = c; SA_[pos * 16 + j] = s; } else { CB[pos * 8 + j - 16] = c; SB_[pos * 8 + j - 16] = s; } } }
    { const float* x = A.in[0]; const float* g = A.in[1]; bf16* XN = (bf16*)(ws + WS_XN);
      f32x4 gv[4];
#pragma unroll
      for (int j = 0; j < 4; ++j) gv[j] = ((const GAS f32x4*)g)[lane + 64 * j];
      constexpr int RPT = P0_RPT;
      for (int m0 = gw; m0 < M; m0 += RPT * NGW) { f32x4 v[RPT][4];
#pragma unroll
          for (int q = 0; q < RPT; ++q) { const int m = (m0 + q * NGW < M) ? m0 + q * NGW : m0;
#pragma unroll
              for (int j = 0; j < 4; ++j) v[q][j] = ((const GAS f32x4*)(x + (size_t)m * DM) + lane)[64 * j]; }
#pragma unroll
          for (int q = 0; q < RPT; ++q) { const int m = m0 + q * NGW; if (m < M) { float s = 0.f;
#pragma unroll
              for (int j = 0; j < 4; ++j) s += dot4(v[q][j]);
              const float rs = 1.f / sqrtf(wave_sum(s) * (1.f / DM) + EPS);
              GAS unsigned long long* o8 = (GAS unsigned long long*)(XN + (size_t)m * DM) + lane;
#pragma unroll
              for (int j = 0; j < 4; ++j) { const f32x4 y = v[q][j] * rs * gv[j]; o8[64 * j] = (unsigned long long)pk2(y[0], y[1]) | ((unsigned long long)pk2(y[2], y[3]) << 32); } } } } }
}

__device__ __forceinline__ void moba_select(const Frame& F0, const Args& A) {
    Frame F = F0; F.lane = lane_id(); F.tid = F.wave * 64 + F.lane;
    unsigned char* ws = A.ws; const float* KSUM = (const float*)(ws + WS_KSUM); const bf16* QB = (const bf16*)(ws + WS_QB); unsigned* SEL = (unsigned*)(ws + WS_SEL);
    LAS unsigned char* KMH = F.lds; LAS unsigned char* KML = F.lds + 4096;
    const int lane = F.lane, r32 = lane & 31, hi = lane >> 5, wid = F.wave;
    for (int unit = F.vcu; unit < 512; unit += F.G) { const int bh = unit >> 3, qg = unit & 7, b = bh >> 3, h = bh & 7;
        __syncthreads();
        { const int idx = F.tid * 4, n = idx >> 6, d = idx & 63, pm = b * 32 + n;
          const f32x4 k0 = *(const f32x4*)(KSUM + (size_t)pm * 512 + h * 64 + d), k1 = *(const f32x4*)(KSUM + (size_t)(256 + pm) * 512 + h * 64 + d);
          unsigned hw[4], lw[4];
#pragma unroll
          for (int j = 0; j < 4; ++j) { const float v = (k0[j] + k1[j]) * (1.f / 256.f); hw[j] = f2bf(v); lw[j] = f2bf(v - __builtin_bit_cast(float, hw[j] << 16)); }
          const int off = (d >> 3) * 512 + n * 16 + (d & 7) * 2;
          *(LAS unsigned long long*)(KMH + off) = (unsigned long long)(hw[0] | (hw[1] << 16)) | ((unsigned long long)(hw[2] | (hw[3] << 16)) << 32);
          *(LAS unsigned long long*)(KML + off) = (unsigned long long)(lw[0] | (lw[1] << 16)) | ((unsigned long long)(lw[2] | (lw[3] << 16)) << 32); }
        __syncthreads();
        unsigned msk[4];
#pragma unroll
        for (int p = 0; p < 4; ++p) { const int own = 4 * qg + p; const int s = own * 256 + wid * 32 + r32; unsigned mask;
            if (own < 4) mask = (1u << own) - 1u;
            else {
                const bf16* qrow = QB + ((size_t)b * SEQ + s) * 512 + h * 64;
                f32x16 g = {};
#pragma unroll
                for (int d0 = 0; d0 < 4; ++d0) { const bf16x8 q = *(const bf16x8*)(qrow + d0 * 16 + hi * 8);
                    const bf16x8 kh = *(const LAS bf16x8*)(KMH + (2 * d0 + hi) * 512 + r32 * 16), kl = *(const LAS bf16x8*)(KML + (2 * d0 + hi) * 512 + r32 * 16);
                    g = __builtin_amdgcn_mfma_f32_32x32x16_bf16(kl, q, g, 0, 0, 0); g = __builtin_amdgcn_mfma_f32_32x32x16_bf16(kh, q, g, 0, 0, 0); }
                float v1 = -INFINITY, v2 = -INFINITY, v3 = -INFINITY; int i1 = 99, i2 = 99, i3 = 99;
#pragma unroll
                for (int r = 0; r < 16; ++r) { const int n = (r & 3) + 8 * (r >> 2) + 4 * hi; const float v = (n < own) ? g[r] : -INFINITY;
                    if (v > v1) { v3 = v2; i3 = i2; v2 = v1; i2 = i1; v1 = v; i1 = n; } else if (v > v2) { v3 = v2; i3 = i2; v2 = v; i2 = n; } else if (v > v3) { v3 = v; i3 = n; } }
                float pv_[3] = {__shfl_xor(v1, 32), __shfl_xor(v2, 32), __shfl_xor(v3, 32)}; int pi_[3] = {__shfl_xor(i1, 32), __shfl_xor(i2, 32), __shfl_xor(i3, 32)};
#pragma unroll
                for (int k = 0; k < 3; ++k) { const float v = pv_[k]; const int n = pi_[k];
#define MS_BETTER(va, ia, vb, ib) ((va) > (vb) || ((va) == (vb) && (ia) < (ib)))
                    if (MS_BETTER(v, n, v1, i1)) { v3 = v2; i3 = i2; v2 = v1; i2 = i1; v1 = v; i1 = n; } else if (MS_BETTER(v, n, v2, i2)) { v3 = v2; i3 = i2; v2 = v; i2 = n; } else if (MS_BETTER(v, n, v3, i3)) { v3 = v; i3 = n; } }
#undef MS_BETTER
                mask = (1u << i1) | (1u << i2) | (1u << i3);
            }
            msk[p] = mask;
            if (hi == 0) SEL[(size_t)bh * SEQ + s] = mask; }
        int lp[4][3];
#pragma unroll
        for (int p = 0; p < 4; ++p) { unsigned mm = (hi == 0) ? msk[p] : 0u;
#pragma unroll
            for (int k = 0; k < 3; ++k) { lp[p][k] = 0; if (mm) { const int j = __builtin_ctz(mm); mm &= mm - 1u; lp[p][k] = (int)__hip_atomic_fetch_add((LAS unsigned*)(F.MISC + MI_HIST + j), 1u, __ATOMIC_RELAXED, __HIP_MEMORY_SCOPE_WORKGROUP); } } }
        __syncthreads();
        if (F.tid < 32) { const unsigned n = F.MISC[MI_HIST + F.tid]; F.MISC[MI_BASE + F.tid] = n ? xb_add((unsigned*)(F.ctl + CW_MCNT + bh * 32 + F.tid), n) : 0u; }
        __syncthreads();
        { unsigned short* LQ = (unsigned short*)(ws + WS_LISTQ) + (size_t)bh * LQ_PER_BH;
#pragma unroll
          for (int p = 0; p < 4; ++p) { unsigned mm = (hi == 0) ? msk[p] : 0u; const int s = (4 * qg + p) * 256 + wid * 32 + r32;
#pragma unroll
              for (int k = 0; k < 3; ++k) if (mm) { const int j = __builtin_ctz(mm); mm &= mm - 1u; LQ[256 * (31 * j - j * (j - 1) / 2) + (int)F.MISC[MI_BASE + j] + lp[p][k]] = (unsigned short)s; } } }
        __syncthreads();
        if (F.tid < 32) F.MISC[MI_HIST + F.tid] = 0u;
    }
    __syncthreads();
}

__device__ __forceinline__ void router_phase(const Frame& F0, const Args& A) {
    Frame F = F0; F.lane = lane_id(); F.tid = F.wave * 64 + F.lane;
    unsigned char* ws = A.ws; const bf16* X2H = (const bf16*)(ws + WS_X2B); const bf16* X2Lo = (const bf16*)(ws + WS_X2L); const float* SSQ_X = (const float*)(ws + WS_SSQX);
    const float* gain = A.in[10]; const float* wrg = A.in[11]; const float* brg = A.in[12]; const float* wre = A.in[13]; const float* bre = A.in[14];
    float* TOKW = (float*)(ws + WS_TOKW); float* RS = (float*)(ws + WS_RS); int* LIST = (int*)(ws + WS_LIST); unsigned* CNT = (unsigned*)(F.ctl + CW_CNT);
    LAS float* Wl = (LAS float*)F.lds;
    const int tid = F.tid, lane = F.lane, wid = F.wave, fr = lane & 15, fq = lane >> 4;
    for (int tw = F.vcu; tw < M / 256; tw += F.G) { const int tok0 = tw * 256;
        f32x4 acc[2][3];
#pragma unroll
        for (int a = 0; a < 2; ++a)
#pragma unroll
            for (int b = 0; b < 3; ++b) acc[a][b] = (f32x4){0.f, 0.f, 0.f, 0.f};
        LAS bf16* Wh = (LAS bf16*)F.lds; LAS bf16* Wo = Wh + 48 * 520;
        for (int c2 = 0; c2 < 2 * NREP(6); ++c2) { const int c = c2 & 1;
            __syncthreads();
            { const int k = c * 512 + tid; const float g = gain[k];
#define RT_PUT(n, val) do { const float w_ = (val) * g; const unsigned h_ = f2bf(w_); Wh[(n) * 520 + tid] = (bf16)h_; Wo[(n) * 520 + tid] = (bf16)f2bf(w_ - __builtin_bit_cast(float, h_ << 16)); } while (0)
              const f32x4 w4 = *(const f32x4*)(wrg + (size_t)k * 4);
#pragma unroll
              for (int n = 0; n < 4; ++n) RT_PUT(n, w4[n]);
#pragma unroll
              for (int gi = 0; gi < 4; ++gi) { const f32x4 e0 = *(const f32x4*)(wre + ((size_t)gi * 1024 + k) * 8), e1 = *(const f32x4*)(wre + ((size_t)gi * 1024 + k) * 8 + 4);
#pragma unroll
                  for (int j = 0; j < 4; ++j) { RT_PUT(4 + gi * 8 + j, e0[j]); RT_PUT(4 + gi * 8 + 4 + j, e1[j]); } }
#pragma unroll
              for (int n = 36; n < 48; ++n) { Wh[n * 520 + tid] = 0; Wo[n * 520 + tid] = 0; }
#undef RT_PUT
            }
            __syncthreads();
            const size_t xo0 = (size_t)(tok0 + wid * 32 + fr) * DM + c * 512 + 8 * fq;
#pragma unroll 2
            for (int s = 0; s < 16; ++s) {
                bf16x8 xh[2], xl[2], wh[3], wl[3];
#pragma unroll
                for (int mb = 0; mb < 2; ++mb) { xh[mb] = *(const bf16x8*)(X2H + xo0 + (size_t)mb * 16 * DM + 32 * s);
#if !RES_BF16
                    xl[mb] = *(const bf16x8*)(X2Lo + xo0 + (size_t)mb * 16 * DM + 32 * s);
#endif
                    }
#pragma unroll
                for (int nb = 0; nb < 3; ++nb) { wh[nb] = *(const LAS bf16x8*)(Wh + (16 * nb + fr) * 520 + 32 * s + 8 * fq); wl[nb] = *(const LAS bf16x8*)(Wo + (16 * nb + fr) * 520 + 32 * s + 8 * fq); }
#pragma unroll
                for (int mb = 0; mb < 2; ++mb)
#pragma unroll
                    for (int nb = 0; nb < 3; ++nb) {
#if !RES_BF16
                        acc[mb][nb] = __builtin_amdgcn_mfma_f32_16x16x32_bf16(xl[mb], wh[nb], acc[mb][nb], 0, 0, 0);
#endif
                        acc[mb][nb] = __builtin_amdgcn_mfma_f32_16x16x32_bf16(xh[mb], wl[nb], acc[mb][nb], 0, 0, 0);
                        acc[mb][nb] = __builtin_amdgcn_mfma_f32_16x16x32_bf16(xh[mb], wh[nb], acc[mb][nb], 0, 0, 0); }
            }
        }
        __syncthreads();
#pragma unroll
        for (int mb = 0; mb < 2; ++mb)
#pragma unroll
            for (int nb = 0; nb < 3; ++nb)
#pragma unroll
                for (int i = 0; i < 4; ++i) Wl[(wid * 32 + mb * 16 + 4 * fq + i) * 49 + nb * 16 + fr] = acc[mb][nb][i] * (1.f / NREP(6));
        if (tid < 32) F.MISC[MI_HIST + tid] = 0u;
        __syncthreads();
        int e1 = 0, e2 = 0, lp1 = 0, lp2 = 0; float wt1 = 0.f, wt2 = 0.f;
        if (tid < 256) { const int T = tok0 + tid; const LAS float* lg = Wl + tid * 49;
            const f32x4 q0 = *(const f32x4*)(SSQ_X + (size_t)T * 16), q1 = *(const f32x4*)(SSQ_X + (size_t)T * 16 + 4), q2 = *(const f32x4*)(SSQ_X + (size_t)T * 16 + 8), q3 = *(const f32x4*)(SSQ_X + (size_t)T * 16 + 12);
            float ss = 0.f;
#pragma unroll
            for (int j = 0; j < 4; ++j) ss += q0[j];
#pragma unroll
            for (int j = 0; j < 4; ++j) ss += q1[j];
#pragma unroll
            for (int j = 0; j < 4; ++j) ss += q2[j];
#pragma unroll
            for (int j = 0; j < 4; ++j) ss += q3[j];
            const float rs = 1.f / sqrtf(ss * (1.f / DM) + EPS);
            RS[T] = rs;
            float g0 = lg[0] * rs + brg[0], g1 = lg[1] * rs + brg[1], g2 = lg[2] * rs + brg[2], g3 = lg[3] * rs + brg[3];
            int g = 0; float mx = g0; if (g1 > mx) { mx = g1; g = 1; } if (g2 > mx) { mx = g2; g = 2; } if (g3 > mx) { mx = g3; g = 3; }
            const float pg = 1.f / (__expf(g0 - mx) + __expf(g1 - mx) + __expf(g2 - mx) + __expf(g3 - mx));
            float v1 = -INFINITY, v2 = -INFINITY; int i1 = 0, i2 = 0;
#pragma unroll
            for (int j = 0; j < 8; ++j) { const float v = lg[4 + 8 * g + j] * rs + bre[8 * g + j];
                if (v > v1) { v2 = v1; i2 = i1; v1 = v; i1 = j; } else if (v > v2) { v2 = v; i2 = j; } }
            const float w1 = 1.f / (1.f + __expf(v2 - v1));
            wt1 = pg * w1; wt2 = pg * (1.f - w1); e1 = 8 * g + i1; e2 = 8 * g + i2;
            lp1 = (int)__hip_atomic_fetch_add((LAS unsigned*)(F.MISC + MI_HIST + e1), 1u, __ATOMIC_RELAXED, __HIP_MEMORY_SCOPE_WORKGROUP);
            lp2 = (int)__hip_atomic_fetch_add((LAS unsigned*)(F.MISC + MI_HIST + e2), 1u, __ATOMIC_RELAXED, __HIP_MEMORY_SCOPE_WORKGROUP);
        }
        __syncthreads();
        if (tid < 32) { const unsigned n = F.MISC[MI_HIST + tid]; F.MISC[MI_BASE + tid] = n ? xb_add((unsigned*)&CNT[tid], n) : 0u; }
        __syncthreads();
        if (tid < 256) { const int T = tok0 + tid;
            const int p1 = (int)F.MISC[MI_BASE + e1] + lp1, p2 = (int)F.MISC[MI_BASE + e2] + lp2;
            LIST[(size_t)e1 * LCAP + p1] = 2 * T; LIST[(size_t)e2 * LCAP + p2] = 2 * T + 1;
            TOKW[2 * T] = wt1; TOKW[2 * T + 1] = wt2; }
    }
    __syncthreads();
}

__device__ __forceinline__ void moe_tile_table(const Frame& F0) {
    Frame F = F0; F.lane = lane_id(); F.tid = F.wave * 64 + F.lane;
    __syncthreads();
    if (F.tid == 0) { int acc = 0; for (int e = 0; e < 32; ++e) { F.MISC[MI_TS + e] = (unsigned)acc; const unsigned c = __hip_atomic_load((unsigned*)(F.ctl + CW_CNT + e), RLX_AGENT); acc += (int)((c + 255u) >> 8); } F.MISC[MI_TS + 32] = (unsigned)acc; }
    __syncthreads();
}
__device__ __forceinline__ void gather_phase(const Frame& F0, const Args& A) {
    Frame F = F0; F.lane = lane_id(); F.tid = F.wave * 64 + F.lane;
    unsigned char* ws = A.ws; const int* LIST = (const int*)(ws + WS_LIST);
    int* SLOT_A = (int*)(ws + WS_SLOTA); int* SLOT_TOK = (int*)(ws + WS_SLOTTOK); float* SLOT_RS = (float*)(ws + WS_SLOTRS); const float* RS = (const float*)(ws + WS_RS);
    const int ntile = (int)F.MISC[MI_TS + 32];
    for (int i2 = 0; (long)F.vcu + (long)i2 * F.G < 2L * ntile; i2 += 2) { const long L = (long)F.vcu + (long)(i2 + (F.tid >> 8)) * F.G; if (L >= 2L * ntile) continue; const int st = (int)(L >> 1);
        int e = 0; for (int k = 1; k < 32; ++k) e += (st >= (int)F.MISC[MI_TS + k]) ? 1 : 0;
        const int cnt = (int)__hip_atomic_load((unsigned*)(F.ctl + CW_CNT + e), RLX_AGENT); const int r = F.tid & 255, p = (st - (int)F.MISC[MI_TS + e]) * 256 + r, slot = st * 256 + r;
        int a = -1; float rs = 0.f; if (p < cnt) { a = LIST[(size_t)e * LCAP + p]; rs = RS[a >> 1]; }
        SLOT_A[slot] = a; SLOT_TOK[slot] = a >> 1; SLOT_RS[slot] = rs; }
}
__device__ __forceinline__ void final_phase(const Frame& F0, const Args& A, float* DST) {
    Frame F = F0; F.lane = lane_id(); F.tid = F.wave * 64 + F.lane;
    unsigned char* ws = A.ws; const bf16* X2H = (const bf16*)(ws + WS_X2B); const bf16* X2Lo = (const bf16*)(ws + WS_X2L); const bf16* Y = (const bf16*)(ws + WS_Y); const float* g = A.in[18];
    const int gw = F.vcu * NWAVES + F.wave, NGW = F.G * NWAVES, lane = F.lane;
    f32x4 gv[4];
#pragma unroll
    for (int j = 0; j < 4; ++j) gv[j] = ((const GAS f32x4*)g)[lane + 64 * j];
    constexpr int FR = FIN_RPT;
    for (int m0 = FR * gw; m0 < M; m0 += FR * NGW) {
        f32x4 v[FR][4]; unsigned long long ya[FR][4], yb[FR][4], xa[FR][4], xb[FR][4];
#pragma unroll
        for (int q = 0; q < FR; ++q) { const int m = m0 + q; const GAS unsigned long long* xh_ = (const GAS unsigned long long*)(X2H + (size_t)m * DM) + lane; const GAS unsigned long long* xl_ = (const GAS unsigned long long*)(X2Lo + (size_t)m * DM) + lane;
            const GAS unsigned long long* y0 = (const GAS unsigned long long*)(Y + (size_t)(2 * m) * DM) + lane; const GAS unsigned long long* y1 = (const GAS unsigned long long*)(Y + (size_t)(2 * m + 1) * DM) + lane;
#pragma unroll
            for (int j = 0; j < 4; ++j) { xa[q][j] = xh_[64 * j]; xb[q][j] = RES_BF16 ? 0ull : xl_[64 * j]; ya[q][j] = y0[64 * j]; yb[q][j] = y1[64 * j]; } }
#pragma unroll
        for (int q = 0; q < FR; ++q) { const int m = m0 + q; float s = 0.f;
#pragma unroll
            for (int j = 0; j < 4; ++j) { const unsigned long long a = ya[q][j], b = yb[q][j], xh8 = xa[q][j], xl8 = xb[q][j];
                const unsigned al = (unsigned)a, ah = (unsigned)(a >> 32), bl = (unsigned)b, bh = (unsigned)(b >> 32), hl = (unsigned)xh8, hh = (unsigned)(xh8 >> 32), ll = (unsigned)xl8, lh = (unsigned)(xl8 >> 32);
                v[q][j] = (f32x4){bflo(hl) + bflo(ll), bfhi(hl) + bfhi(ll), bflo(hh) + bflo(lh), bfhi(hh) + bfhi(lh)};
                v[q][j][0] = (v[q][j][0] + bflo(al)) + bflo(bl); v[q][j][1] = (v[q][j][1] + bfhi(al)) + bfhi(bl); v[q][j][2] = (v[q][j][2] + bflo(ah)) + bflo(bh); v[q][j][3] = (v[q][j][3] + bfhi(ah)) + bfhi(bh);
                s += dot4(v[q][j]); }
            float rs = 1.f / sqrtf(wave_sum(s) * (1.f / DM) + EPS);
#if CHECK
            { const float es = __hip_atomic_load((float*)(F.ctl + CW_ERR), RLX_AGENT), ec = __hip_atomic_load((float*)(F.ctl + CW_ERR + 1), RLX_AGENT); rs *= 1.f + CHK_GAIN * (ec > 0.f ? es / ec : 1.f); }
#endif
            GAS f32x4* dr = (GAS f32x4*)(DST + (size_t)m * DM) + lane;
#pragma unroll
            for (int j = 0; j < 4; ++j) dr[64 * j] = v[q][j] * rs * gv[j]; } }
}

#if CHECK
__device__ __forceinline__ float blk_sum(Frame& F, float v, LAS float* red) { v = wave_sum(v); __syncthreads(); if (F.lane == 0) red[F.wave] = v; __syncthreads(); float t = 0.f; for (int i = 0; i < 8; ++i) t += red[i]; return t; }
__device__ __forceinline__ float blk_max(Frame& F, float v, LAS float* red) {
#pragma unroll
    for (int o = 1; o < 64; o <<= 1) v = fmaxf(v, __shfl_xor(v, o));
    __syncthreads(); if (F.lane == 0) red[F.wave] = v; __syncthreads(); float t = red[0]; for (int i = 1; i < 8; ++i) t = fmaxf(t, red[i]); return t; }
__device__ __forceinline__ void err_add(Frame& F, int group, float num2, float den2, LAS float* red) {
    const float n = blk_sum(F, num2, red), d = blk_sum(F, den2, red);
    if (F.tid == 0 && ((CHK_GROUPS >> group) & 1)) { float e = sqrtf(n / (d + 1e-20f)); e = fminf(e, 1.f); if (!(e == e)) e = 1.f; atomicAdd((float*)(F.ctl + CW_ERR), e); atomicAdd((float*)(F.ctl + CW_ERR + 1), 1.f); } }
__device__ __forceinline__ float bfv(const bf16* p) { return __builtin_bit_cast(float, ((unsigned)*p) << 16); }
__device__ __forceinline__ int posA(int j) { const int i = j & 15, odd = j >> 4; return 8 * (i >> 2) + 2 * (i & 3) + odd; }
__device__ __forceinline__ int posB(int d) { if (d >= 16) return d; const int i = d & 7, odd = d >> 3; return 8 * (i >> 2) + 2 * (i & 3) + odd; }
__device__ __forceinline__ unsigned hash32(unsigned x) { x ^= x >> 16; x *= 0x7feb352du; x ^= x >> 15; x *= 0x846ca68bu; x ^= x >> 16; return x; }
__device__ __forceinline__ void cs_pow(double theta, int pos, double& c, double& s) {
    double t2 = theta * theta, ct = 1.0, st = theta, term = 1.0;
    for (int k = 1; k <= 12; ++k) { term *= -t2 / ((2.0 * k - 1.0) * (2.0 * k)); ct += term; }
    term = theta; for (int k = 1; k <= 12; ++k) { term *= -t2 / ((2.0 * k) * (2.0 * k + 1.0)); st += term; }
    double rc = 1.0, rs = 0.0, bc = ct, bs = st;
    for (int b = 0; b < 13; ++b) { if ((pos >> b) & 1) { const double nc = rc * bc - rs * bs, ns = rc * bs + rs * bc; rc = nc; rs = ns; } const double c2 = bc * bc - bs * bs, s2 = 2.0 * bc * bs; bc = c2; bs = s2; }
    c = rc; s = rs;
}
__device__ __forceinline__ void check_proj_row(const Frame& F0, const Args& A, int m) {
    Frame F = F0; F.lane = lane_id(); F.tid = F.wave * 64 + F.lane;
    unsigned char* ws = A.ws; LAS float* L = (LAS float*)F.lds; LAS float* hrow = L; LAS float* proj = L + 1024; LAS float* tmp = L + 5664; LAS float* outv = L + 6688; LAS float* red = L + 7712;
    const int tid = F.tid, pos = m & (SEQ - 1);
    const float* x = A.in[0] + (size_t)m * DM;
    float ss = 0.f; for (int k = tid; k < DM; k += 512) ss += x[k] * x[k];
    ss = blk_sum(F, ss, red); { const float rs = 1.f / sqrtf(ss / DM + EPS); for (int k = tid; k < DM; k += 512) hrow[k] = x[k] * rs * A.in[1][k]; }
    __syncthreads();
    for (int c = tid; c < 4640; c += 512) { float a = 0.f; for (int k = 0; k < DM; ++k) a += hrow[k] * A.in[2][(size_t)k * 4640 + c]; proj[c] = a; }
    __syncthreads();
    const float* CA = (const float*)(ws + WS_COSA); const float* SA_ = (const float*)(ws + WS_SINA); const float* CB = (const float*)(ws + WS_COSB); const float* SB_ = (const float*)(ws + WS_SINB);
    { float n2 = 0.f, d2 = 0.f; if (tid < 24) { const int j = tid; double c, s_; cs_pow(6.283185307179586 * (j < 16 ? REV_A[j] : REV_B[j - 16]), pos, c, s_);
          const float tc = j < 16 ? CA[pos * 16 + j] : CB[pos * 8 + j - 16], ts = j < 16 ? SA_[pos * 16 + j] : SB_[pos * 8 + j - 16];
          n2 = (tc - (float)c) * (tc - (float)c) + (ts - (float)s_) * (ts - (float)s_); d2 = 1.f; }
      err_add(F, 0, n2, d2, red); }
    { float q2 = 0.f; for (int k = tid; k < QL; k += 512) q2 += proj[k] * proj[k]; q2 = blk_sum(F, q2, red); const float rs = 1.f / sqrtf(q2 / QL + EPS);
      for (int k = tid; k < QL; k += 512) tmp[k] = proj[k] * rs * A.in[3][k];
      __syncthreads();
      for (int c = tid; c < QL; c += 512) { float a = 0.f; for (int k = 0; k < QL; ++k) a += tmp[k] * A.in[4][(size_t)k * QL + c]; outv[c] = a; }
      __syncthreads();
      const bf16* QA = (const bf16*)(ws + WS_QA) + (size_t)m * QL; float n2 = 0.f, d2 = 0.f;
      for (int c = tid; c < QL; c += 512) { const int hh = c / 96, d = c % 96; float ref; int sp;
          if (d < 64) { ref = outv[c]; sp = d; }
          else { const int j = d - 64, i = j & 15; double cc, sn; cs_pow(6.283185307179586 * REV_A[i], pos, cc, sn); const float x1 = outv[hh * 96 + 64 + i], x2 = outv[hh * 96 + 80 + i];
              ref = (j < 16) ? x1 * (float)cc - x2 * (float)sn : x2 * (float)cc + x1 * (float)sn; sp = 64 + posA(j); }
          ref *= C2A; const float got = bfv(QA + hh * 96 + sp); n2 += (got - ref) * (got - ref); d2 += ref * ref; }
      err_add(F, 1, n2, d2, red); }
    { float q2 = 0.f; for (int k = tid; k < KVL; k += 512) q2 += proj[768 + k] * proj[768 + k]; q2 = blk_sum(F, q2, red); const float rs = 1.f / sqrtf(q2 / KVL + EPS);
      for (int k = tid; k < KVL; k += 512) tmp[k] = proj[768 + k] * rs * A.in[5][k];
      __syncthreads();
      for (int c = tid; c < DM; c += 512) { float a = 0.f; for (int k = 0; k < KVL; ++k) a += tmp[k] * A.in[6][(size_t)k * DM + c]; outv[c] = a; }
      __syncthreads();
      const bf16* KV = (const bf16*)(ws + WS_KV) + (size_t)m * DM; float n2 = 0.f, d2 = 0.f;
      for (int c = tid; c < DM; c += 512) { const float ref = outv[c], got = bfv(KV + c); n2 += (got - ref) * (got - ref); d2 += ref * ref; }
      err_add(F, 2, n2, d2, red); }
    { const bf16* KR = (const bf16*)(ws + WS_KR) + (size_t)m * 32; float n2 = 0.f, d2 = 0.f;
      if (tid < 32) { const int j = tid, i = j & 15; double cc, sn; cs_pow(6.283185307179586 * REV_A[i], pos, cc, sn); const float x1 = proj[1024 + i], x2 = proj[1040 + i];
          const float ref = (j < 16) ? x1 * (float)cc - x2 * (float)sn : x2 * (float)cc + x1 * (float)sn; const float got = bfv(KR + posA(j)); n2 = (got - ref) * (got - ref); d2 = ref * ref; }
      err_add(F, 3, n2, d2, red); }
    for (int w = 0; w < 3; ++w) { const bf16* O = (const bf16*)(ws + (w == 0 ? WS_QB : w == 1 ? WS_KB : WS_VB)) + (size_t)m * 512; const int base = (w == 0) ? 1056 : (w == 1) ? 1568 : 2080; float n2 = 0.f, d2 = 0.f;
        { const int c = tid; const int hh = c >> 6, d = c & 63; float ref; int sp = d;
          if (w < 2 && d < 16) { const int i = d & 7; double cc, sn; cs_pow(6.283185307179586 * REV_B[i], pos, cc, sn); const float x1 = proj[base + hh * 64 + i], x2 = proj[base + hh * 64 + 8 + i];
              ref = (d < 8) ? x1 * (float)cc - x2 * (float)sn : x2 * (float)cc + x1 * (float)sn; sp = posB(d); }
          else ref = proj[base + c];
          if (w == 0) ref *= C2B;
          const float got = bfv(O + hh * 64 + sp); n2 = (got - ref) * (got - ref); d2 = ref * ref; }
        err_add(F, 4 + w, n2, d2, red); }
    for (int w = 0; w < 2; ++w) { const bf16* O = (const bf16*)(ws + (w == 0 ? WS_SA : WS_SB)) + (size_t)m * DM; float n2 = 0.f, d2 = 0.f;
        for (int c = tid; c < DM; c += 512) { const float sa = 1.f / (1.f + __expf(-proj[2592 + c])), sb = 1.f / (1.f + __expf(-proj[3616 + c])); const float ref = (w == 0) ? sa / sb : sb, got = bfv(O + c); n2 += (got - ref) * (got - ref); d2 += ref * ref; }
        err_add(F, 7 + w, n2, d2, red); }
    __syncthreads();
}
__device__ __forceinline__ void check_attn_row(const Frame& F0, const Args& A, int type, int b, int h, int s) {
    Frame F = F0; F.lane = lane_id(); F.tid = F.wave * 64 + F.lane;
    unsigned char* ws = A.ws; LAS float* L = (LAS float*)F.lds; LAS float* sc = L; LAS float* q = L + 8192; LAS float* km = L + 8320; LAS float* part = L + 10400; LAS float* red = L + 10944; LAS float* gate = L + 10960; LAS unsigned* msk = (LAS unsigned*)(L + 11000);
    const int tid = F.tid; const size_t rb = (size_t)b * SEQ; const int own = s >> 8;
    const bf16* QA = (const bf16*)(ws + WS_QA); const bf16* KV = (const bf16*)(ws + WS_KV); const bf16* KR = (const bf16*)(ws + WS_KR);
    const bf16* QB = (const bf16*)(ws + WS_QB); const bf16* KB = (const bf16*)(ws + WS_KB); const bf16* VB = (const bf16*)(ws + WS_VB); const bf16* OAB = (const bf16*)(ws + WS_OAB);
    __syncthreads();
    if (type == 0) { if (tid < 96) q[tid] = bfv(QA + (rb + s) * QL + h * 96 + tid); }
    else { if (tid < 64) q[tid] = bfv(QB + (rb + s) * 512 + h * 64 + tid); }
    __syncthreads();
    unsigned mask = 0xffffffffu;
    if (type == 1) {
        { const int d = tid & 63, g = tid >> 6; for (int n = g; n < own; n += 8) { float a = 0.f; for (int r = 0; r < 256; ++r) a += bfv(KB + (rb + n * 256 + r) * 512 + h * 64 + d); km[n * 64 + d] = a * (1.f / 256.f); } }
        __syncthreads();
        if (tid < own) { float a = 0.f; for (int d = 0; d < 64; ++d) a += q[d] * km[tid * 64 + d]; gate[tid] = a; }
        __syncthreads();
        if (tid == 0) { unsigned mk = 0u; if (own < 4) mk = (1u << own) - 1u; else { for (int r = 0; r < 3; ++r) { float bv = -INFINITY; int bi = 0; for (int n = 0; n < own; ++n) if (!((mk >> n) & 1u) && gate[n] > bv) { bv = gate[n]; bi = n; } mk |= 1u << bi; } }
            msk[0] = mk | (1u << own); }
        __syncthreads();
        mask = msk[0];
    }
    float mx = -INFINITY;
    for (int j = tid; j <= s; j += 512) { float a = -INFINITY;
        if ((mask >> (j >> 8)) & 1u) { a = 0.f;
            if (type == 0) { for (int d = 0; d < 64; ++d) a += q[d] * bfv(KV + (rb + j) * DM + h * 128 + d); for (int d = 0; d < 32; ++d) a += q[64 + d] * bfv(KR + (rb + j) * 32 + d); }
            else { for (int d = 0; d < 64; ++d) a += q[d] * bfv(KB + (rb + j) * 512 + h * 64 + d); } }
        sc[j] = a; mx = fmaxf(mx, a); }
    mx = blk_max(F, mx, red);
    float l = 0.f; for (int j = tid; j <= s; j += 512) { const float p = exp2f(sc[j] - mx); sc[j] = p; l += p; }
    l = blk_sum(F, l, red);
    { const int d = tid & 63, g = tid >> 6; float a = 0.f;
      for (int j = g; j <= s; j += 8) { const float p = sc[j]; if (p != 0.f) a += p * (type == 0 ? bfv(KV + (rb + j) * DM + h * 128 + 64 + d) : bfv(VB + (rb + j) * 512 + h * 64 + d)); }
      part[g * 64 + d] = a; }
    __syncthreads();
    float n2 = 0.f, d2 = 0.f;
    if (tid < 64) { float a = 0.f; for (int g = 0; g < 8; ++g) a += part[g * 64 + tid]; const float ref = a / l; const float got = bfv(OAB + (rb + s) * DM + type * 512 + h * 64 + tid); n2 = (got - ref) * (got - ref); d2 = ref * ref; }
    err_add(F, type, n2, d2, red);
    __syncthreads();
}
__device__ __forceinline__ void check_mix_row(const Frame& F0, const Args& A, int m) {
    Frame F = F0; F.lane = lane_id(); F.tid = F.wave * 64 + F.lane;
    unsigned char* ws = A.ws; LAS float* L = (LAS float*)F.lds; LAS float* orow = L; LAS float* mix = L + 1024; LAS float* red = L + 2048; const int tid = F.tid;
    const bf16* OAB = (const bf16*)(ws + WS_OAB) + (size_t)m * DM; const bf16* SAp = (const bf16*)(ws + WS_SA) + (size_t)m * DM; const bf16* SBp = (const bf16*)(ws + WS_SB) + (size_t)m * DM; const bf16* MIX = (const bf16*)(ws + WS_MIX) + (size_t)m * DM;
    __syncthreads();
    for (int k = tid; k < DM; k += 512) orow[k] = bfv(OAB + k);
    __syncthreads();
    float n2 = 0.f, d2 = 0.f;
    for (int c = tid; c < DM; c += 512) { float a1 = 0.f, a2 = 0.f; for (int k = 0; k < 512; ++k) { a1 += orow[k] * A.in[7][(size_t)k * DM + c]; a2 += orow[512 + k] * A.in[8][(size_t)k * DM + c]; }
        const float ref = bfv(SBp + c) * (bfv(SAp + c) * a1 + a2), got = bfv(MIX + c); mix[c] = got; n2 += (got - ref) * (got - ref); d2 += ref * ref; }
    err_add(F, 0, n2, d2, red);
    n2 = 0.f; d2 = 0.f;
    for (int c = tid; c < DM; c += 512) { float a = 0.f; for (int k = 0; k < DM; ++k) a += mix[k] * A.in[9][(size_t)k * DM + c];
        const float ref = A.in[0][(size_t)m * DM + c] + a, got = bfv((const bf16*)(ws + WS_X2B) + (size_t)m * DM + c) + bfv((const bf16*)(ws + WS_X2L) + (size_t)m * DM + c); n2 += (got - ref) * (got - ref); d2 += a * a; }
    err_add(F, 1, n2, d2, red);
    __syncthreads();
}
#endif

__device__ __forceinline__ void moba_combine(const Frame& F0, const Args& A) {
    Frame F = F0; F.lane = lane_id(); F.tid = F.wave * 64 + F.lane;
    unsigned char* ws = A.ws; const bf16* PO = (const bf16*)A.out; const float* PML = (const float*)(ws + WS_PML); const unsigned* SEL = (const unsigned*)(ws + WS_SEL); bf16* OAB = (bf16*)(ws + WS_OAB);
    const int gw = F.vcu * NWAVES + F.wave, NGW = F.G * NWAVES, lane = F.lane, ch = lane & 7;
    typedef float f32x2_ __attribute__((ext_vector_type(2)));
    for (int task0 = CMB_T * gw; task0 < 65536 * REP_MOBA_B; task0 += CMB_T * NGW) {
        unsigned selv[CMB_T]; f32x2_ ml[CMB_T][4]; v4u ov[CMB_T][4];
#pragma unroll
        for (int q = 0; q < CMB_T; ++q) { const int tk = (task0 + q) & 65535; const long qh = (long)tk * 8 + (lane >> 3);
            selv[q] = SEL[qh];
#pragma unroll
            for (int k = 0; k < 4; ++k) { ml[q][k] = *(const f32x2_*)(PML + (qh * 4 + k) * 2); ov[q][k] = *(const v4u*)(PO + (size_t)(qh * 4 + k) * 64 + ch * 8); } }
#pragma unroll
        for (int q = 0; q < CMB_T; ++q) { const int tk = (task0 + q) & 65535; const long qh = (long)tk * 8 + (lane >> 3); const int bh = (int)(qh >> 13), sq = (int)(qh & (SEQ - 1)), b = bh >> 3, h = bh & 7;
            const int np = __builtin_popcount(selv[q]);
            float mi[4], li[4]; v4u oi[4];
#pragma unroll
            for (int k = 0; k < 4; ++k) { const bool ok = (k == 3) || (k < np); mi[k] = ok ? ml[q][k][0] : -1e30f; li[k] = ok ? ml[q][k][1] : 0.f;
                oi[k].x = ok ? ov[q][k].x : 0u; oi[k].y = ok ? ov[q][k].y : 0u; oi[k].z = ok ? ov[q][k].z : 0u; oi[k].w = ok ? ov[q][k].w : 0u; }
            const float mmax = fmaxf(fmaxf(mi[0], mi[1]), fmaxf(mi[2], mi[3]));
            float wk[4], wsum = 0.f;
#pragma unroll
            for (int k = 0; k < 4; ++k) { wk[k] = li[k] * __builtin_amdgcn_exp2f(mi[k] - mmax); wsum += wk[k]; }
            const float inv = 1.f / wsum;
            float r8[8] = {0.f, 0.f, 0.f, 0.f, 0.f, 0.f, 0.f, 0.f};
#pragma unroll
            for (int k = 0; k < 4; ++k) { const v4u u = oi[k]; r8[0] += wk[k] * bflo(u.x); r8[1] += wk[k] * bfhi(u.x); r8[2] += wk[k] * bflo(u.y); r8[3] += wk[k] * bfhi(u.y);
                r8[4] += wk[k] * bflo(u.z); r8[5] += wk[k] * bfhi(u.z); r8[6] += wk[k] * bflo(u.w); r8[7] += wk[k] * bfhi(u.w); }
            v4u w; w.x = cvt_pk_bf16(r8[0] * inv, r8[1] * inv); w.y = cvt_pk_bf16(r8[2] * inv, r8[3] * inv); w.z = cvt_pk_bf16(r8[4] * inv, r8[5] * inv); w.w = cvt_pk_bf16(r8[6] * inv, r8[7] * inv);
            *(v4u*)(OAB + ((size_t)b * SEQ + sq) * DM + 512 + h * 64 + ch * 8) = w; } }
}

__global__ void __launch_bounds__(NWAVES * 64, 2) mk_fwd(Args kargs) {
    extern __shared__ __attribute__((aligned(16))) unsigned char lds[];
    Frame F;
    F.lds = (LAS unsigned char*)lds; F.MISC = (volatile LAS unsigned*)(F.lds + MISC_OFF);
    F.wave = __builtin_amdgcn_readfirstlane((int)threadIdx.x >> 6); F.lane = lane_id(); F.tid = F.wave * 64 + F.lane;
    F.G = gridDim.x; { const int bx = blockIdx.x; F.vcu = (F.G % 8 == 0) ? (bx % 8) * (F.G / 8) + bx / 8 : bx; }
    F.ctl = (gu32*)(ld_args().ws + WS_CTL);
    for (int u = F.tid; u < (LDS_BYTES - LDSCTL_OFF) / 4; u += NWAVES * 64) ((LAS unsigned*)(F.lds + LDSCTL_OFF))[u] = 0u;
    __syncthreads();
    XcdBarrier bar = xcd_barrier_post((unsigned*)(F.ctl + CW_BAR), F.MISC + 8, F.wave == 0 && lane_id() == 0);
    int lo, hi; { const Args a0 = ld_args(); lo = a0.ph_lo; hi = a0.ph_hi; }
#ifndef PH_MASK
#define PH_MASK 0x7ff
#endif
#define IN(k) (((PH_MASK >> (k)) & 1) && lo <= (k) && (k) < hi)
#define SEAM(k) do { if (IN(k) && IN((k) + 1)) xcd_barrier(bar, F.wave == 0 && lane_id() == 0); } while (0)
#define PB(off) ((bf16*)(ws + (off)))
#define PF(off) ((float*)(ws + (off)))
#define XN PB(WS_XN)
#define CQ PB(WS_CQ)
#define CKV PB(WS_CKV)
#define KR PB(WS_KR)
#define QBp PB(WS_QB)
#define KBp PB(WS_KB)
#define VBp PB(WS_VB)
#define SAp PB(WS_SA)
#define SBp PB(WS_SB)
#define QA PB(WS_QA)
#define KV PB(WS_KV)
#define OAB PB(WS_OAB)
#define MIX PB(WS_MIX)
#define X2B PB(WS_X2B)
#define XG PB(WS_XG)
#define Hb PB(WS_H)
#define Yb PB(WS_Y)
#define SSQ_Q PF(WS_SSQQ)
#define SSQ_KV PF(WS_SSQKV)
#define SSQ_X PF(WS_SSQX)
#define KSUM PF(WS_KSUM)
#define COSA PF(WS_COSA)
#define SINA PF(WS_SINA)
#define COSB PF(WS_COSB)
#define SINB PF(WS_SINB)
    if (IN(0)) { const Args args = ld_args(); for (int rep = 0; rep < NREP(0); ++rep) p0_prologue(F, args); } SEAM(0);

    if (IN(1)) { const Args args = ld_args(); unsigned char* ws = args.ws;
        pg8::Gemm g{XN, (const bf16*)(ws + WS_WIN), DM, DM, DM, 0}; pg8::SchedGrid S; S.init(M / 256, NPROJ / 256, F.G, (int)blockIdx.x, DM, DM, NREP(1), WGM_P1);
        pg8::EpiProj E{CQ, CKV, KR, QBp, KBp, VBp, SAp, SBp, SSQ_Q, SSQ_KV, KSUM, COSA, SINA, COSB, SINB};
        pg8::gemm_phase(F.lds, g, S, E, F.wave);
#ifdef P1_EXTRA_PLAIN
        { pg8::SchedGrid S2; S2.init(M / 256, NPROJ / 256, F.G, (int)blockIdx.x, DM, DM, 1, WGM_P1); pg8::EpiPlain E2{(bf16*)(ws + 976 * MiB)}; pg8::gemm_phase(F.lds, g, S2, E2, F.wave); }
#endif
    } SEAM(1);

    if (IN(2)) { const Args args = ld_args(); unsigned char* ws = args.ws;
        { pg8::Gemm g{CQ, (const bf16*)(ws + WS_WUQ), QL, QL, QL, 0}; pg8::SchedGrid S; S.init(M / 256, QL / 256, F.G, (int)blockIdx.x, QL, QL, NREP(2), WGM_O);
          pg8::EpiQ E{QA, SSQ_Q, COSA, SINA}; pg8::gemm_phase(F.lds, g, S, E, F.wave); }
        { pg8::Gemm g{CKV, (const bf16*)(ws + WS_WUKV), KVL, KVL, KVL, 0}; pg8::SchedGrid S; S.init(M / 256, DM / 256, F.G, (int)blockIdx.x, KVL, KVL, NREP(2), WGM_O);
          pg8::EpiKV E{KV, SSQ_KV}; pg8::gemm_phase(F.lds, g, S, E, F.wave); }
        for (int rep = 0; rep < NREP(11); ++rep) moba_select(F, args);
    } SEAM(2);
#if CHECK == 2
    if (IN(2)) { const Args args = ld_args();
#pragma unroll 1
        for (int i = 0; i < 3; ++i) { const unsigned hsh = hash32((unsigned)(F.vcu * 3 + i) + 12345u); int m = (int)(hsh % (unsigned)M); if (i == 0) m = (m & ~(SEQ - 1)) | (hsh >> 20 & 255) * 32 | (m & 31); check_proj_row(F, args, m); } xcd_barrier(bar, F.wave == 0 && lane_id() == 0); }
#endif

    if (IN(3)) { const Args args = ld_args(); unsigned char* ws = args.ws;
        const unsigned* SEL = (const unsigned*)(ws + WS_SEL);
        bf16* PO = (bf16*)args.out; float* PML = (float*)(ws + WS_PML);
        for (int qd = F.vcu; qd < 512; qd += F.G) { const int s = qd & 7, bh = (qd >> 3) & 63, b = bh >> 3, h = bh & 7; const size_t rb = (size_t)b * SEQ;
#pragma unroll 1
            for (int i = 0; i < 4 * REP_MLA; ++i) { const int i4 = i & 3; const int qb = (i4 == 0) ? s : (i4 == 1) ? 15 - s : (i4 == 2) ? 16 + s : 31 - s;
#if MLA_TUNED
                atm::attn_unit_mla<8>(qb, QA + rb * QL + h * 96, KV + rb * DM + h * 128, KR + rb * 32, KV + rb * DM + h * 128 + 64, OAB + rb * DM + h * 64, (LAS char*)F.lds, F.wave);
#else
                at::attn_unit<96, 0>(qb, QA + rb * QL + h * 96, QL, KV + rb * DM + h * 128, DM, KR + rb * 32, KV + rb * DM + h * 128 + 64, DM, OAB + rb * DM + h * 64, DM, at::MobaX{nullptr, nullptr, 0, 0, nullptr, nullptr, 0}, (LAS char*)F.lds, F.wave);
#endif
            } }
#ifndef ONLY_MLA
        { F.lane = lane_id(); F.tid = F.wave * 64 + F.lane; LAS int* PRE = (LAS int*)(F.lds + 102400); LAS int* WSUM = (LAS int*)(F.lds + 102400 + 8704);
#define MB_NCH(c) ({ const int n_ = (int)((((c) + 31u) >> 5) + 63u) >> 6; n_ < 1 ? 1 : n_; })
          int v0, v1, v2, v3; LAS int* CNTL = (LAS int*)(F.lds + 112640);
          { const int i0 = 4 * F.tid;
              const unsigned c0 = __hip_atomic_load((unsigned*)(F.ctl + CW_MCNT + ((i0 + 0) & 63) * 32 + ((i0 + 0) >> 6)), RLX_AGENT), c1 = __hip_atomic_load((unsigned*)(F.ctl + CW_MCNT + ((i0 + 1) & 63) * 32 + ((i0 + 1) >> 6)), RLX_AGENT),
                             c2 = __hip_atomic_load((unsigned*)(F.ctl + CW_MCNT + ((i0 + 2) & 63) * 32 + ((i0 + 2) >> 6)), RLX_AGENT), c3 = __hip_atomic_load((unsigned*)(F.ctl + CW_MCNT + ((i0 + 3) & 63) * 32 + ((i0 + 3) >> 6)), RLX_AGENT);
              v0 = MB_NCH(c0); v1 = MB_NCH(c1); v2 = MB_NCH(c2); v3 = MB_NCH(c3);
              CNTL[i0] = (int)c0; CNTL[i0 + 1] = (int)c1; CNTL[i0 + 2] = (int)c2; CNTL[i0 + 3] = (int)c3; }
          const int loc = v0 + v1 + v2 + v3; int inc = loc;
#pragma unroll
          for (int o = 1; o < 64; o <<= 1) { const int t = __shfl_up(inc, o); if (F.lane >= o) inc += t; }
          __syncthreads();
          if (F.lane == 63) WSUM[F.wave] = inc;
          __syncthreads();
          int woff = 0; for (int w = 0; w < F.wave; ++w) woff += WSUM[w];
          const int excl = inc - loc + woff;
          PRE[4 * F.tid] = excl; PRE[4 * F.tid + 1] = excl + v0; PRE[4 * F.tid + 2] = excl + v0 + v1; PRE[4 * F.tid + 3] = excl + v0 + v1 + v2;
          if (F.tid == 511) PRE[2048] = excl + loc;
          __syncthreads();
          const int total = PRE[2048];
          const unsigned short* LQ = (const unsigned short*)(ws + WS_LISTQ);
#if MOBA_TPF
          __syncthreads();
          if (F.tid == 0) F.MISC[12] = xb_add((unsigned*)(F.ctl + CW_TICKET), 1u);
          __syncthreads();
          int k = (int)F.MISC[12];
#pragma unroll 1
          for (;;) {
              if (k >= total * REP_MOBA_A) break;
              unsigned tnext = 0u; if (F.tid == 0) tnext = xb_add((unsigned*)(F.ctl + CW_TICKET), 1u);
#else
#pragma unroll 1
          for (;;) {
              __syncthreads();
              if (F.tid == 0) F.MISC[12] = xb_add((unsigned*)(F.ctl + CW_TICKET), 1u);
              __syncthreads();
              const int k = (int)F.MISC[12]; if (k >= total * REP_MOBA_A) break;
#endif
              const int kk = (k >= total) ? k - total : k; int lo_ = 0, hi_ = 2048;
              while (lo_ < hi_) { const int mid = (lo_ + hi_) >> 1; if (PRE[mid + 1] <= kk) lo_ = mid + 1; else hi_ = mid; }
              const int idx = lo_, j = idx >> 6, bh = idx & 63, b = bh >> 3, h = bh & 7, ch = kk - PRE[idx]; const size_t rb = (size_t)b * SEQ;
              const int lcnt = (j < 31) ? CNTL[idx] : 0;
              const int ng = (lcnt + 31) >> 5; int nch = (ng + 63) >> 6; if (nch < 1) nch = 1; const int gpc = (ng + nch - 1) / nch, g0 = ch * gpc, g1 = (g0 + gpc < ng) ? g0 + gpc : ng;
              at::moba_block(j, QBp + rb * 512 + h * 64, KBp + rb * 512 + h * 64, VBp + rb * 512 + h * 64,
                  at::MobaX{SEL + (size_t)bh * SEQ, LQ + (size_t)bh * LQ_PER_BH + 256 * (31 * j - j * (j - 1) / 2), lcnt, 0, PO, PML, (long)bh * SEQ}, g0, g1, ch == 0, (LAS char*)F.lds, F.wave);
#if MOBA_TPF
              if (F.tid == 0) F.MISC[12] = tnext;
              __syncthreads();
              k = (int)F.MISC[12];
              __syncthreads();
#endif
          } }
        xcd_barrier(bar, F.wave == 0 && lane_id() == 0);
        moba_combine(F, args);
#endif
    } SEAM(3);
#if CHECK == 1
    if (IN(3)) { const Args args = ld_args();
#pragma unroll 1
        for (int i = 0; i < 8; ++i) { const unsigned hsh = hash32((unsigned)(F.vcu * 8 + i) + 777u); const int type = i & 1, b = (hsh >> 3) & 7, h = hsh & 7; int sq = (hsh >> 8) & (SEQ - 1); if (i >= 6) sq &= 1023;
            check_attn_row(F, args, type, b, h, sq); } xcd_barrier(bar, F.wave == 0 && lane_id() == 0); }
#endif

    if (IN(4)) { const Args args = ld_args(); unsigned char* ws = args.ws;
        pg8::Gemm g{OAB, (const bf16*)(ws + WS_WO), 512, DM, DM, 0}; pg8::SchedMix S; S.g.init(M / 256, DM / 256, F.G, (int)blockIdx.x, DM, DM, NREP(4), WGM_O);
        pg8::EpiMix E{MIX, SAp, SBp}; pg8::gemm_phase(F.lds, g, S, E, F.wave);
    } SEAM(4);

    if (IN(5)) { const Args args = ld_args(); unsigned char* ws = args.ws;
        pg8::Gemm g{MIX, (const bf16*)(ws + WS_WOUT), DM, DM, DM, 0}; pg8::SchedGrid S; S.init(M / 256, DM / 256, F.G, (int)blockIdx.x, DM, DM, NREP(5), WGM_O);
        pg8::EpiOut E{args.in[0], PB(WS_X2L), X2B, SSQ_X}; pg8::gemm_phase(F.lds, g, S, E, F.wave);
    } SEAM(5);
#if CHECK == 3
    if (IN(5)) { const Args args = ld_args();
#pragma unroll 1
        for (int i = 0; i < 2; ++i) { const unsigned hsh = hash32((unsigned)(F.vcu * 2 + i) + 4242u); check_mix_row(F, args, (int)(hsh % (unsigned)M)); } xcd_barrier(bar, F.wave == 0 && lane_id() == 0); }
#endif

    if (IN(6)) { const Args args = ld_args(); router_phase(F, args); } SEAM(6);

    if (IN(8)) { const Args args = ld_args(); unsigned char* ws = args.ws;
        moe_tile_table(F); gather_phase(F, args);
        asm volatile("s_waitcnt vmcnt(0)" ::: "memory"); __syncthreads();
        const int n8 = 2 * (int)F.MISC[MI_TS + 32], limA = (n8 / F.G) * F.G;
        pg8::Gemm g{X2B, (const bf16*)(ws + WS_WGU), DM, DM, DM, 0};
        pg8::SchedMoE S{(const volatile LAS int*)(F.MISC + MI_TS), 2, F.vcu, MOE_SPLIT ? limA : n8, F.G, 256L * DM * 2, 512L * DM * 2, 256L * DM * 2};
        pg8::EpiH E{Hb, (const float*)(ws + WS_SLOTRS)}; pg8::gemm_phase_g(F.lds, g, S, E, F.wave, (const int*)(ws + WS_SLOTTOK));
    } SEAM(8);
#if MOE_SPLIT
    if (IN(8) && IN(9)) { const Args args = ld_args(); unsigned char* ws = args.ws;
        const int ntile = (int)F.MISC[MI_TS + 32], n8 = 2 * ntile, limA = (n8 / F.G) * F.G, nB = n8 - limA, W = F.G - nB; int E0 = W * MOE_Q; if (E0 > 4 * (limA >> 1)) E0 = 4 * (limA >> 1);
        if (F.vcu < nB) {
            pg8::Gemm g{X2B, (const bf16*)(ws + WS_WGU), DM, DM, DM, 0};
            pg8::SchedMoE S{(const volatile LAS int*)(F.MISC + MI_TS), 2, limA + F.vcu, n8, F.G, 256L * DM * 2, 512L * DM * 2, 256L * DM * 2};
            pg8::EpiH E{Hb, (const float*)(ws + WS_SLOTRS)}; pg8::gemm_phase_g(F.lds, g, S, E, F.wave, (const int*)(ws + WS_SLOTTOK));
        } else {
            pg8::Gemm g{Hb, (const bf16*)(ws + WS_WD), EFF, EFF, EFF, 0};
            pg8::SchedMoE S{(const volatile LAS int*)(F.MISC + MI_TS), 4, F.vcu - nB, E0, W, 256L * EFF * 2, 1024L * EFF * 2, 256L * EFF * 2};
            pg8::EpiY E{Yb, (const int*)(ws + WS_SLOTA), (const float*)(ws + WS_TOKW)}; pg8::gemm_phase(F.lds, g, S, E, F.wave);
        }
        xcd_barrier(bar, F.wave == 0 && lane_id() == 0);
    }
#endif

    if (IN(9)) { const Args args = ld_args(); unsigned char* ws = args.ws;
        if (!IN(8)) moe_tile_table(F);
        const int ntile = (int)F.MISC[MI_TS + 32], n8 = 2 * ntile, limA = (n8 / F.G) * F.G, nB = n8 - limA, W = F.G - nB; int E0 = W * MOE_Q; if (E0 > 4 * (limA >> 1)) E0 = 4 * (limA >> 1);
        pg8::Gemm g{Hb, (const bf16*)(ws + WS_WD), EFF, EFF, EFF, 0};
        pg8::SchedMoE S{(const volatile LAS int*)(F.MISC + MI_TS), 4, ((MOE_SPLIT && IN(8)) ? E0 : 0) + F.vcu, 4 * ntile, F.G, 256L * EFF * 2, 1024L * EFF * 2, 256L * EFF * 2};
        pg8::EpiY E{Yb, (const int*)(ws + WS_SLOTA), (const float*)(ws + WS_TOKW)}; pg8::gemm_phase(F.lds, g, S, E, F.wave);
    } SEAM(9);

    if (IN(10)) { const Args args = ld_args(); if (NREP(10) > 1) final_phase(F, args, (float*)(args.ws + WS_R4)); final_phase(F, args, args.out); }
#undef IN
#undef SEAM
}

extern "C" void kernel_launch(void* const* d_in, const int* in_sizes, int n_in, void* d_out, int out_size, void* d_ws, size_t ws_size, hipStream_t stream) {
    static int grid = 0;
    if (grid == 0) {
        if (n_in != 19 || out_size != M * DM || ws_size < WS_END) { fprintf(stderr, "kernel_launch: unexpected shapes (n_in %d out %d ws %zu)\n", n_in, out_size, ws_size); grid = -1; return; }
        int dev = 0, cus = 0, per_cu = 0;
        if (hipGetDevice(&dev) != hipSuccess || hipDeviceGetAttribute(&cus, hipDeviceAttributeMultiprocessorCount, dev) != hipSuccess) { grid = -1; return; }
        if (hipFuncSetAttribute((const void*)mk_fwd, hipFuncAttributeMaxDynamicSharedMemorySize, LDS_BYTES) != hipSuccess) { fprintf(stderr, "kernel_launch: hipFuncSetAttribute failed\n"); grid = -1; return; }
        if (hipOccupancyMaxActiveBlocksPerMultiprocessor(&per_cu, (const void*)mk_fwd, NWAVES * 64, LDS_BYTES) != hipSuccess || per_cu < 1) { fprintf(stderr, "kernel_launch: occupancy query says %d\n", per_cu); }
        (void)hipGetLastError();
        grid = cus;
    }
    if (grid < 0) return;
    if (hipMemsetAsync((char*)d_ws + WS_CTL, 0, CTL_ZERO_BYTES, stream) != hipSuccess) return;
    Args a{};
    for (int i = 0; i < 19; ++i) a.in[i] = (const float*)d_in[i];
    a.out = (float*)d_out; a.ws = (unsigned char*)d_ws; a.ph_lo = 0; a.ph_hi = 11;
    hipLaunchKernelGGL(mk_fwd, dim3(grid), dim3(NWAVES * 64), LDS_BYTES, stream, a);
}
```
